# Optimizing an MI355X kernel written in HIP

```python
import math
import jax, jax.numpy as jnp
from jax import lax
import numpy as np

D_MODEL = 1024
BATCH = 8
SEQ = 2048
DEPTH = 1
DEC_BATCH = 128
DEC_SEQ = 1
PAST_LEN = 16384
PAGE_SIZE = 128

MIX_WIDTH = D_MODEL
M_HEADS = 4
M_HEAD_DIM = MIX_WIDTH // 2 // M_HEADS
M_WIDTH = M_HEADS * M_HEAD_DIM
R_HEADS = 4
R_HEAD_DIM = MIX_WIDTH // 2 // R_HEADS
R_WIDTH = R_HEADS * R_HEAD_DIM
CONV_W = 4
CHUNK = 128
N_MEM = 256
X_HEADS = 4
X_HEAD_DIM = D_MODEL // X_HEADS
D_FF = -(-8 * D_MODEL // (3 * 256)) * 256
ROPE_THETA = 10000.0
EPS = 1e-6
IN_COLS = 4 * M_WIDTH + 2 * M_HEADS + 4 * R_WIDTH

kernel_name = "hymba_mlstm_retention_decoder_step"


def rmsnorm(x, g):
    xf = x.astype(jnp.float32)
    xf = xf * lax.rsqrt(jnp.mean(xf * xf, axis=-1, keepdims=True) + EPS)
    return (xf * g.astype(jnp.float32)).astype(x.dtype)


def head_rmsnorm(h, g):
    B, T, H, D = h.shape
    h = h * lax.rsqrt(jnp.mean(h * h, axis=-1, keepdims=True) + EPS)
    return h.reshape(B, T, H * D) * g.astype(jnp.float32)


def short_conv(u, buf, w, b):
    T = u.shape[1]
    full = jnp.concatenate([buf.astype(u.dtype), u], axis=1)
    out = b + sum(full[:, j:j + T] * w[j] for j in range(CONV_W))
    return jax.nn.silu(out), full[:, T:]


def rope(x, pos):
    half = x.shape[-1] // 2
    inv = ROPE_THETA ** (-jnp.arange(half, dtype=jnp.float32) / half)
    ang = pos[:, None] * inv[None, :]
    cos = jnp.cos(ang)[None, :, None, :]
    sin = jnp.sin(ang)[None, :, None, :]
    x1, x2 = x[..., :half], x[..., half:]
    return jnp.concatenate([x1 * cos - x2 * sin, x2 * cos + x1 * sin], axis=-1)


def chunk_len(T):
    return CHUNK if T % CHUNK == 0 else T


def to_chunks(a, L):
    B, T, H, D = a.shape
    return a.reshape(B, T // L, L, H, D).transpose(1, 0, 3, 2, 4)


def gate_chunks(a, L):
    B, T, H = a.shape
    return a.reshape(B, T // L, L, H).transpose(1, 0, 3, 2)


def from_chunks(o):
    NC, B, H, L, D = o.shape
    return o.transpose(1, 0, 3, 2, 4).reshape(B, NC * L, H, D)


def mlstm_scan(q, k, v, ig, lf, C0, n0, m0):
    T = q.shape[1]
    L = chunk_len(T)
    tril = jnp.tril(jnp.ones((L, L), dtype=bool))

    def step(carry, xs):
        C, n, m = carry
        qc, kc, vc, ic, fc = xs
        b = jnp.cumsum(fc, axis=-1)
        dmat = b[..., :, None] - b[..., None, :] + ic[..., None, :]
        dmat = jnp.where(tril, dmat, -jnp.inf)
        inter = b + m[..., None]
        m_t = jnp.maximum(inter, jnp.max(dmat, axis=-1))
        wts = jnp.exp(dmat - m_t[..., None]) * jnp.einsum('bhtd,bhsd->bhts', qc, kc)
        w_in = jnp.exp(inter - m_t)
        num = jnp.einsum('bhts,bhsd->bhtd', wts, vc) + w_in[..., None] * jnp.einsum('bhvk,bhtk->bhtv', C, qc)
        den = jnp.sum(wts, axis=-1) + w_in * jnp.einsum('bhk,bhtk->bht', n, qc)
        h = num / jnp.maximum(jnp.abs(den), jnp.exp(-m_t))[..., None]
        bL = b[..., -1]
        g = bL[..., None] - b + ic
        m_new = jnp.maximum(bL + m, jnp.max(g, axis=-1))
        ws = jnp.exp(g - m_new[..., None])
        carry_scale = jnp.exp(bL + m - m_new)
        C_new = carry_scale[..., None, None] * C + jnp.einsum('bhsv,bhsk->bhvk', vc * ws[..., None], kc)
        n_new = carry_scale[..., None] * n + jnp.einsum('bhs,bhsk->bhk', ws, kc)
        return (C_new, n_new, m_new), h

    (C, n, m), h = lax.scan(step, (C0, n0, m0),
                            (to_chunks(q, L), to_chunks(k, L), to_chunks(v, L),
                             gate_chunks(ig, L), gate_chunks(lf, L)))
    return from_chunks(h), C, n, m


def retention_scan(q, k, v, S0):
    T = q.shape[1]
    L = chunk_len(T)
    lg = jnp.log1p(-jnp.exp2(-5.0 - jnp.arange(R_HEADS, dtype=jnp.float32)))
    t = jnp.arange(L, dtype=jnp.float32)
    diff = t[:, None] - t[None, :]
    decay = jnp.where(diff >= 0, jnp.exp(lg[:, None, None] * jnp.maximum(diff, 0.0)), 0.0)
    q_dec = jnp.exp(lg[:, None] * (t + 1.0))
    k_dec = jnp.exp(lg[:, None] * (L - 1.0 - t))
    chunk_dec = jnp.exp(lg * L)

    def step(S, xs):
        qc, kc, vc = xs
        o = (jnp.einsum('bhts,bhsv->bhtv', jnp.einsum('bhtd,bhsd->bhts', qc, kc) * decay, vc)
             + q_dec[..., None] * jnp.einsum('bhtk,bhkv->bhtv', qc, S))
        S = chunk_dec[:, None, None] * S + jnp.einsum('bhsk,bhsv->bhkv', kc * k_dec[..., None], vc)
        return S, o

    S, o = lax.scan(step, S0, (to_chunks(q, L), to_chunks(k, L), to_chunks(v, L)))
    return from_chunks(o), S


def mem_kv(mem, g_mem, w_ck, w_cv):
    B = mem.shape[0]
    mn = rmsnorm(mem, g_mem)
    k = (mn @ w_ck).reshape(B, N_MEM, X_HEADS, X_HEAD_DIM)
    v = (mn @ w_cv).reshape(B, N_MEM, X_HEADS, X_HEAD_DIM)
    return k, v


def cross_attn(x, mk, mv, w_cq, w_co):
    B, T, _ = x.shape
    q = (x @ w_cq).reshape(B, T, X_HEADS, X_HEAD_DIM).astype(jnp.float32)
    s = jnp.einsum('bthd,bmhd->bhtm', q, mk.astype(jnp.float32)) * (X_HEAD_DIM ** -0.5)
    p = jax.nn.softmax(s, axis=-1)
    o = jnp.einsum('bhtm,bmhd->bthd', p, mv.astype(jnp.float32)).reshape(B, T, D_MODEL)
    return o.astype(x.dtype) @ w_co


def layer(x, pos, conv_buf, C0, n0, m0, S0, mk_mem, mv_mem,
          w_in, b_gate, w_conv, b_conv, g_mix, g_mhead, g_rhead, w_out,
          g_xattn, w_cq, w_co, g_ffn, w_gate, w_up, w_down):
    f32 = jnp.float32
    B, T, _ = x.shape
    M, R, G0 = M_WIDTH, R_WIDTH, 4 * M_WIDTH
    u = rmsnorm(x, g_mix) @ w_in
    qk, conv_new = short_conv(u[..., :2 * M], conv_buf, w_conv, b_conv)
    mq = qk[..., :M].reshape(B, T, M_HEADS, M_HEAD_DIM).astype(f32)
    mk = qk[..., M:].reshape(B, T, M_HEADS, M_HEAD_DIM).astype(f32) * (M_HEAD_DIM ** -0.5)
    mv = u[..., 2 * M:3 * M].reshape(B, T, M_HEADS, M_HEAD_DIM).astype(f32)
    mo = u[..., 3 * M:4 * M].astype(f32)
    gates = u[..., G0:G0 + 2 * M_HEADS].astype(f32) + b_gate.astype(f32)
    ig = gates[..., :M_HEADS]
    lf = jax.nn.log_sigmoid(gates[..., M_HEADS:])
    hm, C, n, m = mlstm_scan(mq, mk, mv, ig, lf, C0.astype(f32), n0.astype(f32), m0.astype(f32))
    hm = head_rmsnorm(hm, g_mhead) * jax.nn.sigmoid(mo)
    r = u[..., G0 + 2 * M_HEADS:]
    rq = rope(r[..., :R].reshape(B, T, R_HEADS, R_HEAD_DIM).astype(f32), pos)
    rk = rope(r[..., R:2 * R].reshape(B, T, R_HEADS, R_HEAD_DIM).astype(f32), pos) * (R_HEAD_DIM ** -0.5)
    rv = r[..., 2 * R:3 * R].reshape(B, T, R_HEADS, R_HEAD_DIM).astype(f32)
    rg = r[..., 3 * R:].astype(f32)
    hr, S = retention_scan(rq, rk, rv, S0.astype(f32))
    hr = head_rmsnorm(hr, g_rhead) * jax.nn.silu(rg)
    x = x + jnp.concatenate([hm, hr], axis=-1).astype(x.dtype) @ w_out
    x = x + cross_attn(rmsnorm(x, g_xattn), mk_mem, mv_mem, w_cq, w_co)
    hf = rmsnorm(x, g_ffn)
    x = x + (jax.nn.silu(hf @ w_gate) * (hf @ w_up)) @ w_down
    return x, conv_new, C, n, m, S


def setup_inputs(seed: int = 0) -> dict:
    key = jax.random.key(seed)
    ks = jax.random.split(key, 32)
    f32 = jnp.float32
    nrm = lambda k, shape, s: jax.random.normal(k, shape, f32) * s
    gain = lambda k, shape: 1.0 + 0.01 * jax.random.normal(k, shape, f32)
    b_i = 0.01 * jax.random.normal(ks[10], (DEPTH, M_HEADS), f32)
    b_f = jnp.linspace(3.0, 6.0, M_HEADS, dtype=f32)[None, :] + 0.01 * jax.random.normal(ks[11], (DEPTH, M_HEADS), f32)
    return {
        "x_prompt": nrm(ks[0], (BATCH, SEQ, D_MODEL), 1.0),
        "x_sample": nrm(ks[1], (DEC_BATCH, DEC_SEQ, D_MODEL), 1.0),
        "cache_mem_k": nrm(ks[2], (DEPTH, DEC_BATCH, N_MEM, X_HEADS, X_HEAD_DIM), 1.0),
        "cache_mem_v": nrm(ks[3], (DEPTH, DEC_BATCH, N_MEM, X_HEADS, X_HEAD_DIM), 1.0),
        "state_mlstm_conv": nrm(ks[4], (DEPTH, DEC_BATCH, CONV_W - 1, 2 * M_WIDTH), 1.0),
        "state_mlstm_C": nrm(ks[5], (DEPTH, DEC_BATCH, M_HEADS, M_HEAD_DIM, M_HEAD_DIM), 0.1),
        "state_mlstm_n": nrm(ks[6], (DEPTH, DEC_BATCH, M_HEADS, M_HEAD_DIM), 0.1),
        "state_mlstm_m": nrm(ks[7], (DEPTH, DEC_BATCH, M_HEADS), 1.0),
        "state_ret_S": nrm(ks[8], (DEPTH, DEC_BATCH, R_HEADS, R_HEAD_DIM, R_HEAD_DIM), 0.5),
        "mem_prompt": nrm(ks[9], (BATCH, N_MEM, D_MODEL), 1.0),
        "w_in": nrm(ks[12], (DEPTH, D_MODEL, IN_COLS), D_MODEL ** -0.5),
        "b_gate": jnp.concatenate([b_i, b_f], axis=-1),
        "w_conv": nrm(ks[13], (DEPTH, CONV_W, 2 * M_WIDTH), CONV_W ** -0.5),
        "b_conv": nrm(ks[14], (DEPTH, 2 * M_WIDTH), 0.01),
        "g_mix": gain(ks[15], (DEPTH, D_MODEL)),
        "g_mhead": gain(ks[16], (DEPTH, M_WIDTH)),
        "g_rhead": gain(ks[17], (DEPTH, R_WIDTH)),
        "w_out": nrm(ks[18], (DEPTH, MIX_WIDTH, D_MODEL), MIX_WIDTH ** -0.5),
        "g_xattn": gain(ks[19], (DEPTH, D_MODEL)),
        "g_mem": gain(ks[20], (DEPTH, D_MODEL)),
        "w_ck": nrm(ks[21], (DEPTH, D_MODEL, D_MODEL), D_MODEL ** -0.5),
        "w_cv": nrm(ks[22], (DEPTH, D_MODEL, D_MODEL), D_MODEL ** -0.5),
        "w_cq": nrm(ks[23], (DEPTH, D_MODEL, D_MODEL), D_MODEL ** -0.5),
        "w_co": nrm(ks[24], (DEPTH, D_MODEL, D_MODEL), D_MODEL ** -0.5),
        "g_ffn": gain(ks[25], (DEPTH, D_MODEL)),
        "w_gate": nrm(ks[26], (DEPTH, D_MODEL, D_FF), D_MODEL ** -0.5),
        "w_up": nrm(ks[27], (DEPTH, D_MODEL, D_FF), D_MODEL ** -0.5),
        "w_down": nrm(ks[28], (DEPTH, D_FF, D_MODEL), D_FF ** -0.5),
        "g_final": gain(ks[29], (D_MODEL,)),
    }


def reference(x_prompt, x_sample, cache_mem_k, cache_mem_v, state_mlstm_conv, state_mlstm_C,
              state_mlstm_n, state_mlstm_m, state_ret_S, mem_prompt,
              w_in, b_gate, w_conv, b_conv, g_mix, g_mhead, g_rhead, w_out, g_xattn, g_mem,
              w_ck, w_cv, w_cq, w_co, g_ffn, w_gate, w_up, w_down, g_final):
    f32 = jnp.float32
    Bp, Tp, _ = x_prompt.shape
    Ts = x_sample.shape[1]
    pos_p = jnp.arange(Tp, dtype=f32)
    pos_s = PAST_LEN + jnp.arange(Ts, dtype=f32)
    h_p, h_s = x_prompt, x_sample
    mkp_l, mvp_l, convp_l, Cp_l, np_l, mp_l, Sp_l = [], [], [], [], [], [], []
    convs_l, Cs_l, ns_l, ms_l, Ss_l = [], [], [], [], []
    for l in range(DEPTH):
        lw = (w_in[l], b_gate[l], w_conv[l], b_conv[l], g_mix[l], g_mhead[l], g_rhead[l], w_out[l],
              g_xattn[l], w_cq[l], w_co[l], g_ffn[l], w_gate[l], w_up[l], w_down[l])
        mk_p, mv_p = mem_kv(mem_prompt, g_mem[l], w_ck[l], w_cv[l])
        h_p, conv_p, C_p, n_p, m_p, S_p = layer(
            h_p, pos_p,
            jnp.zeros((Bp, CONV_W - 1, 2 * M_WIDTH), h_p.dtype),
            jnp.zeros((Bp, M_HEADS, M_HEAD_DIM, M_HEAD_DIM), f32),
            jnp.zeros((Bp, M_HEADS, M_HEAD_DIM), f32),
            jnp.zeros((Bp, M_HEADS), f32),
            jnp.zeros((Bp, R_HEADS, R_HEAD_DIM, R_HEAD_DIM), f32),
            mk_p, mv_p, *lw)
        h_s, conv_s, C_s, n_s, m_s, S_s = layer(
            h_s, pos_s, state_mlstm_conv[l], state_mlstm_C[l], state_mlstm_n[l], state_mlstm_m[l],
            state_ret_S[l], cache_mem_k[l], cache_mem_v[l], *lw)
        mkp_l.append(mk_p); mvp_l.append(mv_p); convp_l.append(conv_p)
        Cp_l.append(C_p); np_l.append(n_p); mp_l.append(m_p); Sp_l.append(S_p)
        convs_l.append(conv_s); Cs_l.append(C_s); ns_l.append(n_s); ms_l.append(m_s); Ss_l.append(S_s)
    y_prompt = rmsnorm(h_p, g_final)
    y_sample = rmsnorm(h_s, g_final)
    return (y_prompt, y_sample,
            jnp.stack(mkp_l), jnp.stack(mvp_l), jnp.stack(convp_l), jnp.stack(Cp_l),
            jnp.stack(np_l), jnp.stack(mp_l), jnp.stack(Sp_l),
            jnp.stack(convs_l), jnp.stack(Cs_l), jnp.stack(ns_l), jnp.stack(ms_l), jnp.stack(Ss_l))
```

```cpp
#include <hip/hip_runtime.h>
#include <hip/hip_cooperative_groups.h>
#include <cstdio>
#include <cstdint>
namespace cg = cooperative_groups;
namespace pg8 {
#define PG8_LAS __attribute__((address_space(3)))
typedef unsigned short bf16_t;
typedef short bf16x8 __attribute__((ext_vector_type(8)));
typedef float f32x4 __attribute__((ext_vector_type(4)));
typedef unsigned u32x4 __attribute__((ext_vector_type(4)));
constexpr int BM = 256, BK = 64, HALF = 128, HTB = HALF * BK * 2  , STAGE_BYTES = 8 * HTB, NXCD = 8, WGM = 8;

__host__ __device__ __forceinline__ int lds_byte(int r, int c) { const int st = (r >> 4) * 2 + (c >> 5), rr = r & 15, cc = c & 31, ob = rr * 64 + cc * 2; return st * 1024 + (ob ^ (((ob >> 9) & 1) << 5)); }
__host__ __device__ __forceinline__ void stage_rc(int b, int& R, int& C) { const int st = b / 1024, sb = b % 1024, swz = sb ^ (((sb >> 9) & 1) << 5); R = (st >> 1) * 16 + swz / 64; C = (st & 1) * 32 + (swz % 64) / 2; }
__host__ __device__ __forceinline__ int perm32(int rho) { const int n = rho >> 4, i = rho & 15; return 8 * (i >> 2) + 4 * n + (i & 3); }

struct Unit { int pm, pn; };
struct Gemm { const bf16_t* A; const bf16_t* Bt; int M, N, K; };

struct StaticOrder {
    int nM, nN, nwg, G, c;
    __host__ __device__ void init(int M, int N, int G_, int c_) { nM = M / BM; nN = N / BM; nwg = nM * nN; G = G_; c = c_; }
    __host__ __device__ bool next(int i, Unit& u) const {
        const long L = (long)i * G + c; if (L >= nwg) return false;
        int wgid = (int)L; { const int q = nwg / NXCD, r = nwg % NXCD, xcd = wgid % NXCD, off = wgid / NXCD; wgid = (xcd < r ? xcd * (q + 1) : r * (q + 1) + (xcd - r) * q) + off; }
        const int nig = WGM * nN, gid = wgid / nig, fm = gid * WGM, gsz = (nM - fm) < WGM ? (nM - fm) : WGM;
        u.pm = fm + ((wgid % nig) % gsz); u.pn = (wgid % nig) / gsz; return true;
    }
    __device__ __forceinline__ void a_ready(const Unit&) const {}
    __device__ __forceinline__ void done(const Unit&) const {}
};

__device__ __forceinline__ unsigned cvt_pk_bf16(float lo, float hi) { unsigned r; asm volatile("v_cvt_pk_bf16_f32 %0, %1, %2" : "=v"(r) : "v"(lo), "v"(hi)); return r; }
typedef unsigned u32x2v __attribute__((ext_vector_type(2)));
constexpr float NORM_EPS = 1e-6f;
struct SubOrder {
    int idx, n, nN;
    __device__ bool next(int i, Unit& u) const { if (i != 0 || idx < 0 || idx >= n) return false; u.pm = idx / nN; u.pn = idx % nN; return true; }
    __device__ __forceinline__ void a_ready(const Unit&) const {}
    __device__ __forceinline__ void done(const Unit&) const {}
};
struct EpiScaleBf16 {
    static constexpr bool PERM = true, AFTER_DRAIN = false;
    bf16_t* O; int ldc; const float* ss; float post;
    __device__ __forceinline__ void operator()(const f32x4 (&acc)[2][2][4][2], const Unit& u, int wr, int wc, int fr, int fq) const {
        const int row0 = u.pm * BM + wr * 64 + fr, col0 = u.pn * BM + wc * 32 + 8 * fq;
#pragma unroll
        for (int ai = 0; ai < 2; ++ai)
#pragma unroll
            for (int m = 0; m < 4; ++m) { const int r = row0 + ai * HALF + m * 16; const float sc = rsqrtf(ss[r] * (1.0f / 1024.0f) + NORM_EPS) * post;
                bf16_t* rowp = O + (size_t)r * ldc + col0;
#pragma unroll
                for (int bj = 0; bj < 2; ++bj) { const f32x4 v0 = acc[ai][bj][m][0] * sc, v1 = acc[ai][bj][m][1] * sc;
                    u32x4 w; w.x = cvt_pk_bf16(v0[0], v0[1]); w.y = cvt_pk_bf16(v0[2], v0[3]); w.z = cvt_pk_bf16(v1[0], v1[1]); w.w = cvt_pk_bf16(v1[2], v1[3]);
                    *(u32x4*)(rowp + bj * HALF) = w; } }
    }
};
struct EpiRes {
    static constexpr bool PERM = false, AFTER_DRAIN = false;
    const float* res0; const float* res1; int split, nvalid; float* outf; bf16_t* outb; float* rs;
    __device__ __forceinline__ void operator()(const f32x4 (&acc)[2][2][4][2], const Unit& u, int wr, int wc, int fr, int fq) const {
        const int row0 = u.pm * BM + wr * 64 + fr, col0 = u.pn * BM + wc * 32 + 4 * fq;
#pragma unroll
        for (int ai = 0; ai < 2; ++ai)
#pragma unroll
            for (int m = 0; m < 4; ++m) { const int r = row0 + ai * HALF + m * 16;
                const float* rp = (r < split) ? res0 + (size_t)r * 1024 : ((r < nvalid) ? res1 + (size_t)(r - split) * 1024 : nullptr);
                float s = 0.f;
#pragma unroll
                for (int bj = 0; bj < 2; ++bj)
#pragma unroll
                    for (int n = 0; n < 2; ++n) { const int c = col0 + bj * HALF + n * 16;
                        f32x4 v = acc[ai][bj][m][n]; if (rp) v += *(const f32x4*)(rp + c);
                        *(f32x4*)(outf + (size_t)r * 1024 + c) = v;
                        if (outb) { u32x2v w; w.x = cvt_pk_bf16(v[0], v[1]); w.y = cvt_pk_bf16(v[2], v[3]); *(u32x2v*)(outb + (size_t)r * 1024 + c) = w; }
                        s += (v[0] * v[0] + v[1] * v[1]) + (v[2] * v[2] + v[3] * v[3]); }
                s += __shfl_xor(s, 16); s += __shfl_xor(s, 32);
                if (rs && fq == 0) atomicAdd(rs + r, s); }
    }
};
template <bool RES_F32> struct EpiResB {
    static constexpr bool PERM = true, AFTER_DRAIN = false;
    const float* resf; const bf16_t* resb; bf16_t* outb; float* rs;
    __device__ __forceinline__ void operator()(const f32x4 (&acc)[2][2][4][2], const Unit& u, int wr, int wc, int fr, int fq) const {
        const int row0 = u.pm * BM + wr * 64 + fr, col0 = u.pn * BM + wc * 32 + 8 * fq;
#pragma unroll
        for (int ai = 0; ai < 2; ++ai)
#pragma unroll
            for (int m = 0; m < 4; ++m) { const int r = row0 + ai * HALF + m * 16; float s = 0.f;
#pragma unroll
                for (int bj = 0; bj < 2; ++bj) { const size_t o = (size_t)r * 1024 + col0 + bj * HALF;
                    f32x4 v0 = acc[ai][bj][m][0], v1 = acc[ai][bj][m][1];
                    if (RES_F32) { v0 += *(const f32x4*)(resf + o); v1 += *(const f32x4*)(resf + o + 4); }
                    else { const u32x4 w = *(const u32x4*)(resb + o);
                        v0[0] += __builtin_bit_cast(float, w.x << 16); v0[1] += __builtin_bit_cast(float, w.x & 0xffff0000u); v0[2] += __builtin_bit_cast(float, w.y << 16); v0[3] += __builtin_bit_cast(float, w.y & 0xffff0000u);
                        v1[0] += __builtin_bit_cast(float, w.z << 16); v1[1] += __builtin_bit_cast(float, w.z & 0xffff0000u); v1[2] += __builtin_bit_cast(float, w.w << 16); v1[3] += __builtin_bit_cast(float, w.w & 0xffff0000u); }
                    u32x4 w2; w2.x = cvt_pk_bf16(v0[0], v0[1]); w2.y = cvt_pk_bf16(v0[2], v0[3]); w2.z = cvt_pk_bf16(v1[0], v1[1]); w2.w = cvt_pk_bf16(v1[2], v1[3]);
                    *(u32x4*)(outb + o) = w2;
                    s += ((v0[0] * v0[0] + v0[1] * v0[1]) + (v0[2] * v0[2] + v0[3] * v0[3])) + ((v1[0] * v1[0] + v1[1] * v1[1]) + (v1[2] * v1[2] + v1[3] * v1[3])); }
                s += __shfl_xor(s, 16); s += __shfl_xor(s, 32);
                if (rs && fq == 0) atomicAdd(rs + r, s); }
    }
};
struct EpiKV {
    static constexpr bool PERM = false, AFTER_DRAIN = false;
    const float* ss; float* outk; float* outv; bf16_t* kp; bf16_t* vp;
    __device__ __forceinline__ void operator()(const f32x4 (&acc)[2][2][4][2], const Unit& u, int wr, int wc, int fr, int fq) const {
        const int row0 = u.pm * BM + wr * 64 + fr, col0 = u.pn * BM + wc * 32 + 4 * fq;
#pragma unroll
        for (int ai = 0; ai < 2; ++ai)
#pragma unroll
            for (int m = 0; m < 4; ++m) { const int r = row0 + ai * HALF + m * 16; const float sc = rsqrtf(ss[r] * (1.0f / 1024.0f) + NORM_EPS);
                const int b = r >> 8, key = r & 255;
#pragma unroll
                for (int bj = 0; bj < 2; ++bj)
#pragma unroll
                    for (int n = 0; n < 2; ++n) { const int c = col0 + bj * HALF + n * 16; const f32x4 v = acc[ai][bj][m][n] * sc;
                        const int cc = c & 1023, hd = cc >> 8, dim = cc & 255; const bool isv = c >= 1024;
                        *(f32x4*)((isv ? outv : outk) + (size_t)r * 1024 + cc) = v;
                        u32x2v w; w.x = cvt_pk_bf16(v[0], v[1]); w.y = cvt_pk_bf16(v[2], v[3]);
                        *(u32x2v*)((isv ? vp : kp) + ((size_t)((b * 4 + hd) * 256 + key)) * 256 + dim) = w; } }
    }
};
struct EpiGU {
    static constexpr bool PERM = true, AFTER_DRAIN = false;
    bf16_t* O; const float* ss;
    __device__ __forceinline__ void operator()(const f32x4 (&acc)[2][2][4][2], const Unit& u, int wr, int wc, int fr, int fq) const {
        const int row0 = u.pm * BM + wr * 64 + fr, col0 = u.pn * HALF + wc * 32 + 8 * fq;
#pragma unroll
        for (int ai = 0; ai < 2; ++ai)
#pragma unroll
            for (int m = 0; m < 4; ++m) { const int r = row0 + ai * HALF + m * 16; const float sc = rsqrtf(ss[r] * (1.0f / 1024.0f) + NORM_EPS);
                float a[8];
#pragma unroll
                for (int n = 0; n < 2; ++n)
#pragma unroll
                    for (int e = 0; e < 4; ++e) { const float g = acc[ai][0][m][n][e] * sc, up = acc[ai][1][m][n][e] * sc; a[4 * n + e] = g * __builtin_amdgcn_rcpf(1.0f + __expf(-g)) * up; }
                u32x4 w; w.x = cvt_pk_bf16(a[0], a[1]); w.y = cvt_pk_bf16(a[2], a[3]); w.z = cvt_pk_bf16(a[4], a[5]); w.w = cvt_pk_bf16(a[6], a[7]);
                *(u32x4*)(O + (size_t)r * 2816 + col0) = w; }
    }
};
template <class Epi, class Sched, bool ALIGN_EPI = false, bool SP2 = false>
__device__ __forceinline__ void gemm_phase(PG8_LAS unsigned char* lds, const Gemm g, const Sched& S, const Epi& E) {
    const int tid = threadIdx.x, wid = __builtin_amdgcn_readfirstlane(tid >> 6), lane = tid & 63, wr = wid >> 2, wc = wid & 3, fr = lane & 15, fq = lane >> 4;
    const int K = g.K, nt = K / BK;
    unsigned voffA[2], voffB[2];
#pragma unroll
    for (int i = 0; i < 2; ++i) { int R, C; stage_rc(tid * 16 + i * 8192, R, C); const int Rb = Epi::PERM ? ((R & ~31) + perm32(R & 31)) : R;
        voffA[i] = (unsigned)(R * K + C) * 2u; voffB[i] = (unsigned)(Rb * K + C) * 2u; }
    const size_t kstep = (size_t)(BK * 2);
    const size_t hstep = (size_t)HALF * K * 2;
    const size_t tstep = 2 * hstep;
    const unsigned ldsw = (unsigned)wid * 1024u;
    const int aoff = lds_byte(wr * 64 + fr, fq * 8), boff = lds_byte(wc * 32 + fr, fq * 8);
#define PG8_SA(b, h) (((b) * 2 + (h)) * HTB)
#define PG8_SB(b, h) ((4 + (b) * 2 + (h)) * HTB)
#define PG8_STAGE(bufoff, gbase, voff) do { _Pragma("unroll") for (int _i = 0; _i < 2; ++_i) \
        __builtin_amdgcn_global_load_lds((const unsigned*)((const char*)(gbase) + (voff)[_i]), (PG8_LAS unsigned*)(lds + (bufoff) + ldsw + _i * 8192), 16, 0, 0); } while (0)
#define PG8_LDA(dst, b, h) do { _Pragma("unroll") for (int m = 0; m < 4; ++m) _Pragma("unroll") for (int k = 0; k < 2; ++k) dst[m][k] = *(const PG8_LAS bf16x8*)(lds + PG8_SA(b, h) + aoff + m * 2048 + k * 1024); } while (0)
#define PG8_LDB(dst, b, h) do { _Pragma("unroll") for (int n = 0; n < 2; ++n) _Pragma("unroll") for (int k = 0; k < 2; ++k) dst[n][k] = *(const PG8_LAS bf16x8*)(lds + PG8_SB(b, h) + boff + n * 2048 + k * 1024); } while (0)
#define PG8_MMA(ai, bj, At, Bt) do { __builtin_amdgcn_s_setprio(1); _Pragma("unroll") for (int m = 0; m < 4; ++m) _Pragma("unroll") for (int n = 0; n < 2; ++n) _Pragma("unroll") for (int k = 0; k < 2; ++k) \
        acc[ai][bj][m][n] = __builtin_amdgcn_mfma_f32_16x16x32_bf16(Bt[n][k], At[m][k], acc[ai][bj][m][n], 0, 0, 0); __builtin_amdgcn_s_setprio(0); } while (0)
#define PG8_WAIT_V(n) asm volatile("s_waitcnt vmcnt(" #n ")" ::: "memory")
#define PG8_WAIT_L(n) asm volatile("s_waitcnt lgkmcnt(" #n ")" ::: "memory")
#define PG8_BAR __builtin_amdgcn_s_barrier()
#define PG8_SCHED __builtin_amdgcn_sched_barrier(0)
    Unit cur, nxt; int ui = 0;
    if (!S.next(0, cur)) return;
    f32x4 acc[2][2][4][2];
#pragma unroll
    for (int a = 0; a < 2; ++a)
#pragma unroll
        for (int b = 0; b < 2; ++b)
#pragma unroll
            for (int m = 0; m < 4; ++m)
#pragma unroll
                for (int n = 0; n < 2; ++n) acc[a][b][m][n] = (f32x4){0.f, 0.f, 0.f, 0.f};
    bf16x8 At[4][2], B0[2][2], B1[2][2];
    const char* cA = (const char*)g.A + (size_t)cur.pm * tstep; const char* cB = (const char*)g.Bt + (size_t)cur.pn * tstep;
    S.a_ready(cur);
    if constexpr (SP2) {
        PG8_STAGE(PG8_SB(0, 0), cB, voffB); PG8_STAGE(PG8_SB(0, 1), cB + hstep, voffB); PG8_STAGE(PG8_SA(0, 0), cA, voffA); PG8_STAGE(PG8_SA(0, 1), cA + hstep, voffA);
        if (wr == 1) PG8_BAR;
        PG8_WAIT_V(2); PG8_BAR;
        PG8_STAGE(PG8_SB(1, 0), cB + kstep, voffB); PG8_STAGE(PG8_SA(1, 0), cA + kstep, voffA); PG8_STAGE(PG8_SB(1, 1), cB + hstep + kstep, voffB);
        PG8_WAIT_V(6); PG8_BAR;
    } else {
        PG8_STAGE(PG8_SB(0, 0), cB, voffB); PG8_STAGE(PG8_SA(0, 0), cA, voffA); PG8_STAGE(PG8_SB(0, 1), cB + hstep, voffB); PG8_STAGE(PG8_SA(0, 1), cA + hstep, voffA);
        if (wr == 1) PG8_BAR;
        PG8_WAIT_V(4); PG8_BAR;
        PG8_STAGE(PG8_SB(1, 0), cB + kstep, voffB); PG8_STAGE(PG8_SA(1, 0), cA + kstep, voffA); PG8_STAGE(PG8_SB(1, 1), cB + hstep + kstep, voffB);
        PG8_WAIT_V(6); PG8_BAR;
    }
    for (;;) {
        const bool has_next = S.next(ui + 1, nxt);
        const char* nA = has_next ? (const char*)g.A + (size_t)nxt.pm * tstep : cA; const char* nB = has_next ? (const char*)g.Bt + (size_t)nxt.pn * tstep : cB;
        for (int t = 0; t < nt; t += 2) {
            const bool last = (t == nt - 2);
            const char* a1 = cA + (size_t)(t + 1) * kstep;
            const char* a2 = last ? nA : cA + (size_t)(t + 2) * kstep; const char* b2 = last ? nB : cB + (size_t)(t + 2) * kstep;
            const char* a3 = a2 + kstep; const char* b3 = b2 + kstep;
            if (last && has_next) S.a_ready(nxt);
            if constexpr (SP2) {
            PG8_LDB(B0, 0, 0); PG8_LDB(B1, 0, 1); PG8_SCHED; PG8_LDA(At, 0, 0); PG8_STAGE(PG8_SA(1, 1), a1 + hstep, voffA);
            PG8_WAIT_V(8); PG8_WAIT_L(0); PG8_BAR; PG8_MMA(0, 0, At, B0); PG8_MMA(0, 1, At, B1); PG8_BAR; PG8_SCHED;
            PG8_LDA(At, 0, 1); PG8_STAGE(PG8_SB(0, 0), b2, voffB); PG8_STAGE(PG8_SB(0, 1), b2 + hstep, voffB); PG8_STAGE(PG8_SA(0, 0), a2, voffA);
            PG8_WAIT_V(8); PG8_WAIT_L(0); PG8_BAR; PG8_MMA(1, 0, At, B0); PG8_MMA(1, 1, At, B1); PG8_BAR; PG8_SCHED;
            PG8_LDB(B0, 1, 0); PG8_LDB(B1, 1, 1); PG8_SCHED; PG8_LDA(At, 1, 0); PG8_STAGE(PG8_SA(0, 1), a2 + hstep, voffA);
            PG8_WAIT_V(8); PG8_WAIT_L(0); PG8_BAR; PG8_MMA(0, 0, At, B0); PG8_MMA(0, 1, At, B1); PG8_BAR; PG8_SCHED;
            PG8_LDA(At, 1, 1); PG8_STAGE(PG8_SB(1, 0), b3, voffB); PG8_STAGE(PG8_SB(1, 1), b3 + hstep, voffB); PG8_STAGE(PG8_SA(1, 0), a3, voffA);
            PG8_WAIT_V(8); PG8_WAIT_L(0); PG8_BAR; PG8_MMA(1, 0, At, B0); PG8_MMA(1, 1, At, B1); PG8_BAR; PG8_SCHED;
            } else {
            PG8_LDB(B0, 0, 0); PG8_SCHED; PG8_LDA(At, 0, 0); PG8_STAGE(PG8_SA(1, 1), a1 + hstep, voffA);
            PG8_WAIT_L(8); PG8_BAR; PG8_WAIT_L(0); PG8_MMA(0, 0, At, B0); PG8_BAR; PG8_SCHED;
            PG8_LDB(B1, 0, 1); PG8_STAGE(PG8_SB(0, 0), b2, voffB);
            PG8_BAR; PG8_WAIT_L(0); PG8_MMA(0, 1, At, B1); PG8_BAR;
            PG8_LDA(At, 0, 1); PG8_STAGE(PG8_SA(0, 0), a2, voffA);
            PG8_BAR; PG8_WAIT_L(0); PG8_MMA(1, 0, At, B0); PG8_BAR; PG8_SCHED;
            PG8_STAGE(PG8_SB(0, 1), b2 + hstep, voffB);
            PG8_WAIT_V(6); PG8_BAR; PG8_MMA(1, 1, At, B1); PG8_BAR;
            PG8_LDB(B0, 1, 0); PG8_SCHED; PG8_LDA(At, 1, 0); PG8_STAGE(PG8_SA(0, 1), a2 + hstep, voffA);
            PG8_WAIT_L(8); PG8_BAR; PG8_WAIT_L(0); PG8_MMA(0, 0, At, B0); PG8_BAR; PG8_SCHED;
            PG8_LDB(B1, 1, 1); PG8_STAGE(PG8_SB(1, 0), b3, voffB);
            PG8_BAR; PG8_WAIT_L(0); PG8_MMA(0, 1, At, B1); PG8_BAR;
            PG8_LDA(At, 1, 1); PG8_STAGE(PG8_SA(1, 0), a3, voffA);
            PG8_BAR; PG8_WAIT_L(0); PG8_MMA(1, 0, At, B0); PG8_BAR; PG8_SCHED;
            PG8_STAGE(PG8_SB(1, 1), b3 + hstep, voffB);
            PG8_WAIT_V(6); PG8_BAR; PG8_MMA(1, 1, At, B1); PG8_BAR;
            }
        }
        if constexpr (ALIGN_EPI) { if (wr == 0) PG8_BAR; }
        if constexpr (!Epi::AFTER_DRAIN) { E(acc, cur, wr, wc, fr, fq); S.done(cur); }
        if (!has_next) break;
#pragma unroll
        for (int a = 0; a < 2; ++a)
#pragma unroll
            for (int b = 0; b < 2; ++b)
#pragma unroll
                for (int m = 0; m < 4; ++m)
#pragma unroll
                    for (int n = 0; n < 2; ++n) acc[a][b][m][n] = (f32x4){0.f, 0.f, 0.f, 0.f};
        cur = nxt; cA = nA; cB = nB; ++ui;
        if constexpr (ALIGN_EPI) { if (wr == 1) PG8_BAR; }
    }
    PG8_WAIT_V(0);
    if constexpr (!ALIGN_EPI) { if (wr == 0) PG8_BAR; }
    PG8_BAR;
    if constexpr (Epi::AFTER_DRAIN) { E.fused(acc, cur, wr, wc, fr, fq, lds, wid, lane); S.done(cur); }
#undef PG8_SA
#undef PG8_SB
#undef PG8_STAGE
#undef PG8_LDA
#undef PG8_LDB
#undef PG8_MMA
#undef PG8_WAIT_V
#undef PG8_WAIT_L
#undef PG8_BAR
#undef PG8_SCHED
}
}
#define LAS __attribute__((address_space(3)))
#define DI __device__ __forceinline__
typedef unsigned short bf16_t;
typedef short bf16x8 __attribute__((ext_vector_type(8)));
typedef short s16x4 __attribute__((ext_vector_type(4)));
typedef float f32x2 __attribute__((ext_vector_type(2)));
typedef float f32x4 __attribute__((ext_vector_type(4)));
typedef float f32x16 __attribute__((ext_vector_type(16)));
typedef unsigned u32x4 __attribute__((ext_vector_type(4)));
typedef unsigned u32x2 __attribute__((ext_vector_type(2)));
#define MFMA32(a, b, c) __builtin_amdgcn_mfma_f32_32x32x16_bf16((a), (b), (c), 0, 0, 0)

constexpr int NPROMPT = 16384, NSAMP = 128, NVALID = NPROMPT + NSAMP, MP = 16640;
constexpr int DM = 1024, UC = 4096, DFF = 2816, INC = 4104;
constexpr float EPS = 1e-6f;
constexpr int LDS_BYTES = 147456;

constexpr size_t MiB = 1u << 20;
constexpr size_t WS_WIN = 0;
constexpr size_t WS_WOUT = 8 * MiB;
constexpr size_t WS_WCKV = 10 * MiB;
constexpr size_t WS_WCQ = 14 * MiB;
constexpr size_t WS_WCO = 16 * MiB;
constexpr size_t WS_WGU = 18 * MiB;
constexpr size_t WS_WDN = 29 * MiB;
constexpr size_t WS_MEMB = 35 * MiB;
constexpr size_t WS_KP = 39 * MiB;
constexpr size_t WS_VP = 43 * MiB;
constexpr size_t WS_SMALL = 47 * MiB; constexpr size_t WS_BAR = WS_SMALL + 896 * 1024;
constexpr size_t WS_BFA = 48 * MiB;
constexpr size_t WS_BFB = 81 * MiB;
constexpr size_t WS_BFC = 114 * MiB;
constexpr size_t WS_FA = 147 * MiB;
constexpr size_t WS_FB = 212 * MiB;
constexpr size_t WS_U = 277 * MiB;
constexpr size_t WS_END = 408 * MiB;
constexpr int SM_SS0 = 0, SM_RS1 = MP, SM_RS2 = 2 * MP, SM_RS3 = 3 * MP, SM_SSM = 4 * MP, SM_GATES = 4 * MP + 2048;

constexpr size_t O_YP = 0, O_YS = 16777216, O_MK = 16908288, O_MV = 19005440, O_CONVP = 21102592, O_CP = 21127168, O_NP = 21651456, O_MP = 21655552, O_SP = 21655584,
                 O_CONVS = 22179872, O_CS = 22573088, O_NS = 30961696, O_MS = 31027232, O_SS = 31027744, O_END = 39416352;

struct Params { const float* in[29]; float* out; unsigned char* ws; int ph_lo, ph_hi; };

DI unsigned f2bf(float f) { unsigned u = __builtin_bit_cast(unsigned, f); return (u + 0x7fffu + ((u >> 16) & 1u)) >> 16; }
DI unsigned pk2(float lo, float hi) { return f2bf(lo) | (f2bf(hi) << 16); }
DI float bf2f(unsigned h) { return __builtin_bit_cast(float, h << 16); }
DI float bflo(unsigned w) { return __builtin_bit_cast(float, w << 16); }
DI float bfhi(unsigned w) { return __builtin_bit_cast(float, w & 0xffff0000u); }
DI void unpack8(u32x4 w, float (&f)[8]) { f[0] = bflo(w.x); f[1] = bfhi(w.x); f[2] = bflo(w.y); f[3] = bfhi(w.y); f[4] = bflo(w.z); f[5] = bfhi(w.z); f[6] = bflo(w.w); f[7] = bfhi(w.w); }
DI u32x4 pack8(const float (&f)[8]) { u32x4 w; w.x = pk2(f[0], f[1]); w.y = pk2(f[2], f[3]); w.z = pk2(f[4], f[5]); w.w = pk2(f[6], f[7]); return w; }
DI float wave_sum(float v) {
#pragma unroll
    for (int o = 1; o < 64; o <<= 1) v += __shfl_xor(v, o);
    return v;
}
DI float wave_max(float v) {
#pragma unroll
    for (int o = 1; o < 64; o <<= 1) v = fmaxf(v, __shfl_xor(v, o));
    return v;
}
DI unsigned off_b(unsigned row, unsigned ch) { return 256u * row + 16u * (ch ^ (((row & 3u) << 2) | ((row >> 2) & 3u))); }
DI int crow(int i, int h) { return (i & 3) + 8 * (i >> 2) + 4 * h; }
DI void tr_read4(unsigned a0, unsigned a1, unsigned a2, unsigned a3, s16x4& r0, s16x4& r1, s16x4& r2, s16x4& r3) {
    asm volatile("ds_read_b64_tr_b16 %0, %4\n\tds_read_b64_tr_b16 %1, %5\n\tds_read_b64_tr_b16 %2, %6\n\tds_read_b64_tr_b16 %3, %7\n\ts_waitcnt lgkmcnt(0)"
                 : "=&v"(r0), "=&v"(r1), "=&v"(r2), "=&v"(r3) : "v"(a0), "v"(a1), "v"(a2), "v"(a3) : "memory");
}
DI bf16x8 cat4(s16x4 lo, s16x4 hi) { return __builtin_shufflevector(lo, hi, 0, 1, 2, 3, 4, 5, 6, 7); }
DI float sigmoidf_(float x) { return __builtin_amdgcn_rcpf(1.0f + __expf(-x)); }
DI float logsigmoidf_(float x) { return fminf(x, 0.f) - log1pf(__expf(-fabsf(x))); }
DI void sincos_red(float a, float& s, float& c) {
    const float n = rintf(a * 0.15915494309189535f);
    float r = fmaf(-n, 6.28125f, a); r = fmaf(-n, 1.9353071795864769e-3f, r);
    s = __sinf(r); c = __cosf(r);
}

struct TItem { const float* W; int ldw, K, c0, k0; bf16_t* WT; int r0; const float* gs; };
DI TItem p0_decode(const Params& p, int it) {
    unsigned char* ws = p.ws; TItem t;
    constexpr int I_IN = 16 * 64, I_SQ = 16 * 32, I_FF = 16 * 88;
    int r = it;
    if (r < 2 * I_IN) { const int half = r / I_IN; r -= half * I_IN; const int kb = r / 64, nb = r % 64;
        t.W = p.in[10]; t.ldw = INC; t.K = 1024; t.c0 = (half ? 2056 : 0) + 32 * nb; t.k0 = 64 * kb; t.WT = (bf16_t*)(ws + WS_WIN); t.r0 = half * 2048 + 32 * nb; t.gs = p.in[14]; return t; }
    r -= 2 * I_IN;
    if (r < 5 * I_SQ) { const int which = r / I_SQ; r -= which * I_SQ; const int kb = r / 32, nb = r % 32;
        t.ldw = 1024; t.K = 1024; t.c0 = 32 * nb; t.k0 = 64 * kb; t.r0 = 32 * nb;
        if (which == 0) { t.W = p.in[17]; t.WT = (bf16_t*)(ws + WS_WOUT); t.gs = nullptr; }
        else if (which == 1) { t.W = p.in[20]; t.WT = (bf16_t*)(ws + WS_WCKV); t.gs = p.in[19]; }
        else if (which == 2) { t.W = p.in[21]; t.WT = (bf16_t*)(ws + WS_WCKV); t.gs = p.in[19]; t.r0 += 1024; }
        else if (which == 3) { t.W = p.in[22]; t.WT = (bf16_t*)(ws + WS_WCQ); t.gs = p.in[18]; }
        else { t.W = p.in[23]; t.WT = (bf16_t*)(ws + WS_WCO); t.gs = nullptr; }
        return t; }
    r -= 5 * I_SQ;
    if (r < 2 * I_FF) { const int which = r / I_FF; r -= which * I_FF; const int kb = r / 88, nb = r % 88; const int n0 = 32 * nb;
        t.W = which ? p.in[26] : p.in[25]; t.ldw = DFF; t.K = 1024; t.c0 = n0; t.k0 = 64 * kb; t.WT = (bf16_t*)(ws + WS_WGU); t.r0 = 256 * (n0 >> 7) + (n0 & 127) + (which ? 128 : 0); t.gs = p.in[24]; return t; }
    r -= 2 * I_FF;
    { const int kb = r / 32, nb = r % 32; t.W = p.in[27]; t.ldw = 1024; t.K = DFF; t.c0 = 32 * nb; t.k0 = 64 * kb; t.WT = (bf16_t*)(ws + WS_WDN); t.r0 = 32 * nb; t.gs = nullptr; }
    return t;
}
DI void p0_item_load(const TItem& t, float (&v)[32], int lane) {
#pragma unroll
    for (int i = 0; i < 32; ++i) { const int kk = 2 * i + (lane >> 5); v[i] = t.W[(size_t)(t.k0 + kk) * t.ldw + t.c0 + (lane & 31)]; }
}
DI void p0_item_finish(const TItem& t, const float (&v)[32], LAS float* scr, int lane) {
#pragma unroll
    for (int i = 0; i < 32; ++i) { const int kk = 2 * i + (lane >> 5); float x = v[i]; if (t.gs) x *= t.gs[t.k0 + kk]; scr[kk * 33 + (lane & 31)] = x; }
    asm volatile("s_waitcnt lgkmcnt(0)" ::: "memory");
    const int c = lane & 7;
#pragma unroll
    for (int j = 0; j < 4; ++j) { const int n = (lane >> 3) + 8 * j; const LAS float* s = scr + (8 * c) * 33 + n;
        u32x4 o; o.x = pk2(s[0 * 33], s[1 * 33]); o.y = pk2(s[2 * 33], s[3 * 33]); o.z = pk2(s[4 * 33], s[5 * 33]); o.w = pk2(s[6 * 33], s[7 * 33]);
        *(u32x4*)(t.WT + (size_t)(t.r0 + n) * t.K + t.k0 + 8 * c) = o; }
    asm volatile("s_waitcnt lgkmcnt(0)" ::: "memory");
}
DI void p0_prologue(const Params& p, LAS unsigned char* lds) {
    const int tid = threadIdx.x, lane = tid & 63, wave = tid >> 6;
    unsigned char* ws = p.ws;
    float* sm = (float*)(ws + WS_SMALL);
    const float* w_in = p.in[10];
    const float* g_mix = p.in[14];
    LAS float* GW = (LAS float*)(lds + 69632);
    for (int i = blockIdx.x * 512 + tid; i < 3 * MP; i += gridDim.x * 512) sm[SM_RS1 + i] = 0.f;
    const int gw = blockIdx.x * 8 + wave, NGW = gridDim.x * 8;
    LAS float* scr = (LAS float*)(lds + wave * 8448);
    constexpr int NITEMS = 2 * (16 * 64) + 5 * (16 * 32) + 2 * (16 * 88) + 44 * 32;
#pragma unroll 1
    for (int it = gw; it < NITEMS; it += 2 * NGW) {
        const bool hasB = it + NGW < NITEMS;
        const TItem ta = p0_decode(p, it), tb = p0_decode(p, hasB ? it + NGW : it);
        float va[32], vb[32];
        p0_item_load(ta, va, lane); p0_item_load(tb, vb, lane);
        p0_item_finish(ta, va, scr, lane);
        if (hasB) p0_item_finish(tb, vb, scr, lane);
    }
    for (int i = tid; i < 8192; i += 512) { const int k = i >> 3, j = i & 7; GW[i] = g_mix[k] * w_in[(size_t)k * INC + 2048 + j]; }
    __syncthreads();
    const float* b_gate = p.in[11];
    constexpr int RB = 5, NROWS = NVALID + 2048, NGRP = (NROWS + RB - 1) / RB;
#pragma unroll 1
    for (int gi = gw; gi < NGRP; gi += NGW) {
        f32x4 v[RB][4];
#pragma unroll
        for (int r = 0; r < RB; ++r) { int m = gi * RB + r; if (m >= NROWS) m = NROWS - 1;
            const float* xr = (m >= NVALID) ? p.in[9] + (size_t)(m - NVALID) * DM : (m < NPROMPT ? p.in[0] + (size_t)m * DM : p.in[1] + (size_t)(m - NPROMPT) * DM);
#pragma unroll
            for (int j = 0; j < 4; ++j) v[r][j] = ((const f32x4*)xr)[64 * j + lane]; }
#pragma unroll
        for (int r = 0; r < RB; ++r) { const int m = gi * RB + r; if (m >= NROWS) continue;
            const bool ismem = m >= NVALID;
            bf16_t* orow = ismem ? (bf16_t*)(ws + WS_MEMB) + (size_t)(m - NVALID) * DM : (bf16_t*)(ws + WS_BFA) + (size_t)m * DM;
            float s = 0.f;
#pragma unroll
            for (int j = 0; j < 4; ++j) { s += (v[r][j].x * v[r][j].x + v[r][j].y * v[r][j].y) + (v[r][j].z * v[r][j].z + v[r][j].w * v[r][j].w);
                u32x2 w; w.x = pk2(v[r][j].x, v[r][j].y); w.y = pk2(v[r][j].z, v[r][j].w); ((u32x2*)orow)[64 * j + lane] = w; }
            s = wave_sum(s);
            if (ismem) { if (lane == 0) sm[SM_SSM + (m - NVALID)] = s; continue; }
            float g[8];
#pragma unroll
            for (int e = 0; e < 8; ++e) g[e] = 0.f;
#pragma unroll
            for (int j = 0; j < 4; ++j)
#pragma unroll
                for (int e = 0; e < 4; ++e) { const int k = 4 * (64 * j + lane) + e; const f32x4 a = *(const LAS f32x4*)(GW + 8 * k), bq = *(const LAS f32x4*)(GW + 8 * k + 4); const float xv = v[r][j][e];
                    g[0] += xv * a.x; g[1] += xv * a.y; g[2] += xv * a.z; g[3] += xv * a.w; g[4] += xv * bq.x; g[5] += xv * bq.y; g[6] += xv * bq.z; g[7] += xv * bq.w; }
#pragma unroll
            for (int e = 0; e < 8; ++e) g[e] = wave_sum(g[e]);
            const float rr = rsqrtf(s * (1.0f / 1024.0f) + EPS);
            if (lane == 0) { sm[SM_SS0 + m] = s;
#pragma unroll
                for (int e = 0; e < 8; ++e) sm[SM_GATES + (size_t)m * 8 + e] = g[e] * rr + b_gate[e]; }
        }
    }
}
#define LDS_BARRIER() do { asm volatile("s_waitcnt lgkmcnt(0)" ::: "memory"); __builtin_amdgcn_s_barrier(); asm volatile("" ::: "memory"); } while (0)
template <int PASS> DI void scan_prompt(const Params& p, LAS unsigned char* lds, int bh, int seg) {
    const int tid0 = threadIdx.x, wid = __builtin_amdgcn_readfirstlane(tid0 >> 6), wr = wid >> 1, wc = wid & 1;
    int tid = tid0, lane = tid & 63, hh = lane >> 5, l31 = lane & 31;
    const int b = bh >> 3, head8 = bh & 7, hd = head8 & 3; const bool ret = head8 >= 4;
    unsigned char* ws = p.ws;
    const bf16_t* U = (const bf16_t*)(ws + WS_U);
    bf16_t* HM = (bf16_t*)(ws + WS_BFB);
    const float* gates = (const float*)(ws + WS_SMALL) + SM_GATES;
    const int qcol = (ret ? 2048 : 0) + hd * 128, kcol = qcol + 512, vcol = qcol + 1024, gcol = qcol + 1536, ocol = head8 * 128;
    const float* ghead = (ret ? p.in[16] : p.in[15]) + hd * 128;
    LAS unsigned char* T0 = lds; LAS unsigned char* T1 = lds + 32768; LAS unsigned char* T2 = lds + 65536; LAS unsigned char* T3 = lds + 98304;
    LAS float* sb = (LAS float*)(lds + 131072);
    LAS float* sa = sb + 128;
    LAS float* sbm = sb + 256;
    LAS float* swin = sb + 384;
    LAS float* sem = sb + 512;
    LAS float* snq = sb + 640;
    LAS float* sws = sb + 768;
    LAS float* sn = sb + 896;
    LAS float* sinv = sb + 1024;
    LAS float* smisc = sb + 1152;
    const unsigned t1a = (unsigned)(uintptr_t)T1, t2a = (unsigned)(uintptr_t)T2;
    const float lg = log1pf(-exp2f(-5.0f - (float)hd));
    int blk = (lane >> 4) & 1, q4 = (lane & 15) >> 2, pp = lane & 3;
    for (int i = tid; i < 8192; i += 512) ((LAS unsigned*)T3)[i] = 0u;
    if (tid < 128) sn[tid] = 0.f;
    LAS float* scw = sb + 1344;
    if (!ret) for (int i = tid; i < 1280; i += 512) { const int which = i / 640, r = i % 640, j = r >> 7, c = r & 127, ci = which * 512 + hd * 128 + c; scw[i] = (j < 4) ? p.in[12][j * 1024 + ci] : p.in[13][ci]; }
    f32x16 accC[2];
#pragma unroll
    for (int c = 0; c < 2; ++c)
#pragma unroll
        for (int i = 0; i < 16; ++i) accC[c][i] = 0.f;
    float m_state = 0.f;
    LAS float* sbl = sb + 1280; LAS float* spm = sb + 1296; LAS float* smq = sb + 1312; LAS float* scf = sb + 1336;
    float* Lws = (float*)(ws + WS_FA); float* NLws = Lws + (size_t)64 * 3 * 16384;
    if (!ret) {
        for (int c = wid; c < 16; c += 8) { const float* gp = gates + ((size_t)b * 2048 + c * 128 + 2 * lane) * 8;
            const float i0 = gp[hd], i1 = gp[8 + hd], lf0 = logsigmoidf_(gp[4 + hd]), lf1 = logsigmoidf_(gp[12 + hd]);
            float incl = lf0 + lf1;
#pragma unroll
            for (int o = 1; o < 64; o <<= 1) { const float t = __shfl_up(incl, o); if (lane >= o) incl += t; }
            const float b1 = incl, b0 = incl - lf1, a0 = i0 - b0, a1 = i1 - b1;
            float pin = fmaxf(a0, a1);
#pragma unroll
            for (int o = 1; o < 64; o <<= 1) { const float t = __shfl_up(pin, o); if (lane >= o) pin = fmaxf(pin, t); }
            if (lane == 63) { sbl[c] = incl; spm[c] = pin; } }
    } else if (tid < 16) { sbl[tid] = 128.0f * lg; spm[tid] = 0.f; }
    __syncthreads();
    if (tid == 0) {
        float m = 0.f; smq[0] = 0.f;
        for (int c = 0; c < 16; ++c) { m = ret ? 0.f : sbl[c] + fmaxf(m, spm[c]); smq[c + 1] = m; }
        float run = 1.f;
        for (int i = seg - 1; i >= 0; --i) { scf[i] = run; const float sB = ret ? 512.0f * lg : (sbl[4 * i] + sbl[4 * i + 1]) + (sbl[4 * i + 2] + sbl[4 * i + 3]); run *= __expf(sB + smq[4 * i] - smq[4 * i + 4]); }
    }
    __syncthreads();
    m_state = smq[4 * seg];
    if constexpr (PASS == 2) {
        for (int i = 0; i < seg; ++i) { const float cf = scf[i]; const float* L = Lws + (size_t)(bh * 3 + i) * 16384;
#pragma unroll
            for (int c = 0; c < 2; ++c)
#pragma unroll
                for (int ii = 0; ii < 16; ++ii) accC[c][ii] += cf * L[(32 * wr + crow(ii, hh)) * 128 + 64 * wc + 32 * c + l31];
            if (tid < 128) sn[tid] += cf * NLws[(size_t)(bh * 3 + i) * 128 + tid]; }
#pragma unroll
        for (int c = 0; c < 2; ++c) { const int k_idx = 64 * wc + 32 * c + l31;
#pragma unroll
            for (int i = 0; i < 16; ++i) { const int v = 32 * wr + crow(i, hh); *(LAS unsigned short*)(T3 + off_b(v, k_idx >> 3) + 2 * (k_idx & 7)) = (unsigned short)f2bf(accC[c][i]); } }
    }
    __syncthreads();
    for (int ch = 4 * seg; ch < 4 * seg + 4; ++ch) {
        const int t0 = ch * 128; const size_t m0 = (size_t)b * 2048 + t0;
        tid = tid0; asm volatile("" : "+v"(tid)); lane = tid & 63; hh = lane >> 5; l31 = lane & 31; blk = (lane >> 4) & 1; q4 = (lane & 15) >> 2; pp = lane & 3;
        if (wid == 0) {
            float lf0, lf1, i0, i1;
            if (!ret) { const float* gp = gates + (m0 + 2 * lane) * 8; i0 = gp[hd]; i1 = gp[8 + hd]; lf0 = logsigmoidf_(gp[4 + hd]); lf1 = logsigmoidf_(gp[12 + hd]); }
            else { lf0 = lg; lf1 = lg; i0 = 0.f; i1 = 0.f; }
            float incl = lf0 + lf1;
#pragma unroll
            for (int o = 1; o < 64; o <<= 1) { const float t = __shfl_up(incl, o); if (lane >= o) incl += t; }
            const float b1 = incl, b0 = incl - lf1, a0 = i0 - b0, a1 = i1 - b1;
            float pin = fmaxf(a0, a1);
#pragma unroll
            for (int o = 1; o < 64; o <<= 1) { const float t = __shfl_up(pin, o); if (lane >= o) pin = fmaxf(pin, t); }
            float pex = __shfl_up(pin, 1); if (lane == 0) pex = -INFINITY;
            const float pm0 = fmaxf(pex, a0), pm1 = pin;
            const float mt0 = ret ? 0.f : b0 + fmaxf(m_state, pm0), mt1 = ret ? 0.f : b1 + fmaxf(m_state, pm1);
            const float bL = __shfl(incl, 63), pmL = __shfl(pin, 63);
            const float m_new = ret ? 0.f : bL + fmaxf(m_state, pmL);
            sb[2 * lane] = b0; sb[2 * lane + 1] = b1; sa[2 * lane] = a0; sa[2 * lane + 1] = a1;
            sbm[2 * lane] = b0 - mt0; sbm[2 * lane + 1] = b1 - mt1;
            swin[2 * lane] = __expf(b0 + m_state - mt0); swin[2 * lane + 1] = __expf(b1 + m_state - mt1);
            sem[2 * lane] = __expf(-mt0); sem[2 * lane + 1] = __expf(-mt1);
            sws[2 * lane] = __expf(bL + a0 - m_new); sws[2 * lane + 1] = __expf(bL + a1 - m_new);
            if (lane == 0) { smisc[0] = m_new; smisc[1] = __expf(bL + m_state - m_new); }
        }
        u32x4 vv[4];
#pragma unroll
        for (int i = 0; i < 4; ++i) { const int idx = tid + 512 * i, t = idx >> 4, c8 = idx & 15; vv[i] = *(const u32x4*)(U + (m0 + t) * UC + vcol + 8 * c8); }
        if (!ret) {
            const int c8 = tid & 15, tq = tid >> 4;
            u32x4 xq[7], xk[7];
#pragma unroll
            for (int j = 0; j < 7; ++j) { const int rr = 4 * tq - 3 + j; const size_t row = (t0 + rr >= 0) ? (m0 + rr) : m0;
                if constexpr (PASS == 2) xq[j] = *(const u32x4*)(U + row * UC + qcol + 8 * c8);
                xk[j] = *(const u32x4*)(U + row * UC + kcol + 8 * c8); }
#pragma unroll
            for (int which = (PASS == 1 ? 1 : 0); which < 2; ++which) {
                const float scl = which ? 0.08838834764831845f : 1.0f; LAS unsigned char* T = which ? T1 : T0;
                const LAS float* cw = scw + which * 640 + 8 * c8;
                float wv[4][8], bc[8];
#pragma unroll
                for (int j = 0; j < 4; ++j) { const f32x4 a = *(const LAS f32x4*)(cw + j * 128), bq = *(const LAS f32x4*)(cw + j * 128 + 4);
                    wv[j][0] = a.x; wv[j][1] = a.y; wv[j][2] = a.z; wv[j][3] = a.w; wv[j][4] = bq.x; wv[j][5] = bq.y; wv[j][6] = bq.z; wv[j][7] = bq.w; }
                { const f32x4 a = *(const LAS f32x4*)(cw + 512), bq = *(const LAS f32x4*)(cw + 516); bc[0] = a.x; bc[1] = a.y; bc[2] = a.z; bc[3] = a.w; bc[4] = bq.x; bc[5] = bq.y; bc[6] = bq.z; bc[7] = bq.w; }
#pragma unroll
                for (int i = 0; i < 4; ++i) { const int t = 4 * tq + i;
                    float o[8];
#pragma unroll
                    for (int e = 0; e < 8; ++e) o[e] = bc[e];
#pragma unroll
                    for (int j = 0; j < 4; ++j) { const float msk = (t0 + t - 3 + j >= 0) ? 1.0f : 0.0f; float x[8]; unpack8(which ? xk[i + j] : xq[i + j], x);
#pragma unroll
                        for (int e = 0; e < 8; ++e) o[e] += (wv[j][e] * msk) * x[e]; }
#pragma unroll
                    for (int e = 0; e < 8; ++e) o[e] = o[e] * sigmoidf_(o[e]) * scl;
                    *(LAS u32x4*)(T + off_b(t, c8)) = pack8(o); }
            }
        } else {
            u32x4 rl[2][2], rh[2][2];
#pragma unroll
            for (int which = (PASS == 1 ? 1 : 0); which < 2; ++which)
#pragma unroll
                for (int i = 0; i < 2; ++i) { const int idx = tid + 512 * i, t = idx >> 3, c8 = idx & 7; const int ucol = which ? kcol : qcol;
                    rl[which][i] = *(const u32x4*)(U + (m0 + t) * UC + ucol + 8 * c8); rh[which][i] = *(const u32x4*)(U + (m0 + t) * UC + ucol + 64 + 8 * c8); }
#pragma unroll
            for (int which = (PASS == 1 ? 1 : 0); which < 2; ++which) {
                const float scl = which ? 0.08838834764831845f : 1.0f; LAS unsigned char* T = which ? T1 : T0;
#pragma unroll
                for (int i = 0; i < 2; ++i) { const int idx = tid + 512 * i, t = idx >> 3, c8 = idx & 7;
                    float x1[8], x2[8], o1[8], o2[8]; unpack8(rl[which][i], x1); unpack8(rh[which][i], x2); const float pos = (float)(t0 + t);
#pragma unroll
                    for (int e = 0; e < 8; ++e) { const float inv = exp2f(-(float)(8 * c8 + e) * 0.20762050593046014f); float sn_, cs_; sincos_red(pos * inv, sn_, cs_);
                        o1[e] = (x1[e] * cs_ - x2[e] * sn_) * scl; o2[e] = (x2[e] * cs_ + x1[e] * sn_) * scl; }
                    *(LAS u32x4*)(T + off_b(t, c8)) = pack8(o1); *(LAS u32x4*)(T + off_b(t, c8 + 8)) = pack8(o2); }
            }
        }
#pragma unroll
        for (int i = 0; i < 4; ++i) { const int idx = tid + 512 * i, t = idx >> 4, c8 = idx & 15; *(LAS u32x4*)(T2 + off_b(t, c8)) = vv[i]; }
        LDS_BARRIER();
        const float m_new = smisc[0], carry = smisc[1];
        if constexpr (PASS == 2) {
        { const int t = tid >> 2, part = tid & 3; float d = 0.f;
#pragma unroll
            for (int cc = 0; cc < 4; ++cc) { const int c8 = 4 * part + cc; float x[8]; unpack8(*(const LAS u32x4*)(T0 + off_b(t, c8)), x);
#pragma unroll
                for (int e = 0; e < 8; ++e) d += x[e] * sn[8 * c8 + e]; }
            d += __shfl_xor(d, 1); d += __shfl_xor(d, 2); if (part == 0) snq[t] = d; }
        f32x16 aS[2], aN[2];
#pragma unroll
        for (int c = 0; c < 2; ++c)
#pragma unroll
            for (int i = 0; i < 16; ++i) { aS[c][i] = 0.f; aN[c][i] = 0.f; }
#pragma unroll
        for (int s = 0; s < 8; ++s) { const bf16x8 A = *(const LAS bf16x8*)(T0 + off_b(32 * wr + l31, 2 * s + hh));
#pragma unroll
            for (int c = 0; c < 2; ++c) { const bf16x8 B = *(const LAS bf16x8*)(T1 + off_b(64 * wc + 32 * c + l31, 2 * s + hh)); aS[c] = MFMA32(A, B, aS[c]);
                const bf16x8 B2 = *(const LAS bf16x8*)(T3 + off_b(64 * wc + 32 * c + l31, 2 * s + hh)); aN[c] = MFMA32(A, B2, aN[c]); } }
#pragma unroll
        for (int c = 0; c < 2; ++c) { const int s_idx = 64 * wc + 32 * c + l31; const float a_s = sa[s_idx];
#pragma unroll
            for (int i = 0; i < 16; ++i) { const int t = 32 * wr + crow(i, hh); const float w = __expf(fminf(sbm[t] + a_s, 0.f)) * aS[c][i]; aS[c][i] = (s_idx <= t) ? w : 0.f; aN[c][i] *= swin[t]; } }
        LDS_BARRIER();
#pragma unroll
        for (int c = 0; c < 2; ++c) { const int s_idx = 64 * wc + 32 * c + l31;
#pragma unroll
            for (int i = 0; i < 16; ++i) { const int t = 32 * wr + crow(i, hh); *(LAS unsigned short*)(T0 + off_b(t, s_idx >> 3) + 2 * (s_idx & 7)) = (unsigned short)f2bf(aS[c][i]); } }
        LDS_BARRIER();
#pragma unroll
        for (int ks = 0; ks < 8; ++ks) { const bf16x8 A = *(const LAS bf16x8*)(T0 + off_b(32 * wr + l31, 2 * ks + hh));
            s16x4 r0, r1, r2, r3; const int rowb = 16 * ks + 8 * hh + q4; const int cg0 = 2 * wc, cg1 = 2 * wc + 1;
            tr_read4(t2a + off_b(rowb, 4 * cg0 + 2 * blk + (pp >> 1)) + 8 * (pp & 1), t2a + off_b(rowb + 4, 4 * cg0 + 2 * blk + (pp >> 1)) + 8 * (pp & 1),
                     t2a + off_b(rowb, 4 * cg1 + 2 * blk + (pp >> 1)) + 8 * (pp & 1), t2a + off_b(rowb + 4, 4 * cg1 + 2 * blk + (pp >> 1)) + 8 * (pp & 1), r0, r1, r2, r3);
            aN[0] = MFMA32(A, cat4(r0, r1), aN[0]); aN[1] = MFMA32(A, cat4(r2, r3), aN[1]); }
        { const int t = tid >> 2, part = tid & 3; float d = 0.f;
#pragma unroll
            for (int cc = 0; cc < 4; ++cc) { float x[8]; unpack8(*(const LAS u32x4*)(T0 + off_b(t, 4 * part + cc)), x);
#pragma unroll
                for (int e = 0; e < 8; ++e) d += x[e]; }
            d += __shfl_xor(d, 1); d += __shfl_xor(d, 2);
            if (part == 0) { const float den = d + swin[t] * snq[t]; sinv[t] = ret ? 1.0f : __builtin_amdgcn_rcpf(fmaxf(fabsf(den), sem[t])); } }
        LDS_BARRIER();
#pragma unroll
        for (int c = 0; c < 2; ++c) { const int v_idx = 64 * wc + 32 * c + l31;
#pragma unroll
            for (int i = 0; i < 16; ++i) { const int t = 32 * wr + crow(i, hh); *(LAS unsigned short*)(T0 + off_b(t, v_idx >> 3) + 2 * (v_idx & 7)) = (unsigned short)f2bf(aN[c][i] * sinv[t]); } }
        LDS_BARRIER();
        { const int t = tid >> 2, part = tid & 3; float ss = 0.f;
#pragma unroll
            for (int cc = 0; cc < 4; ++cc) { float x[8]; unpack8(*(const LAS u32x4*)(T0 + off_b(t, 4 * part + cc)), x);
#pragma unroll
                for (int e = 0; e < 8; ++e) ss += x[e] * x[e]; }
            ss += __shfl_xor(ss, 1); ss += __shfl_xor(ss, 2);
            const float rn = rsqrtf(ss * (1.0f / 128.0f) + EPS);
#pragma unroll
            for (int cc = 0; cc < 4; ++cc) { const int c8 = 4 * part + cc; float x[8], gt[8], o[8]; unpack8(*(const LAS u32x4*)(T0 + off_b(t, c8)), x);
                unpack8(*(const u32x4*)(U + (m0 + t) * UC + gcol + 8 * c8), gt);
#pragma unroll
                for (int e = 0; e < 8; ++e) { const float sg = sigmoidf_(gt[e]); o[e] = x[e] * rn * ghead[8 * c8 + e] * (ret ? gt[e] * sg : sg); }
                *(u32x4*)(HM + (m0 + t) * DM + ocol + 8 * c8) = pack8(o); } }
        }
        { const int s = tid >> 2, part = tid & 3; const float w = sws[s];
#pragma unroll
            for (int cc = 0; cc < 4; ++cc) { LAS u32x4* ptr = (LAS u32x4*)(T1 + off_b(s, 4 * part + cc)); float x[8]; unpack8(*ptr, x);
#pragma unroll
                for (int e = 0; e < 8; ++e) x[e] *= w;
                *ptr = pack8(x); } }
        if (!ret && tid < 128) sn[tid] *= carry;
        LDS_BARRIER();
#pragma unroll
        for (int c = 0; c < 2; ++c)
#pragma unroll
            for (int i = 0; i < 16; ++i) accC[c][i] *= carry;
#pragma unroll
        for (int ks = 0; ks < 8; ++ks) { const int rowb = 16 * ks + 8 * hh + q4; const int cg0 = 2 * wc, cg1 = 2 * wc + 1;
            s16x4 a0, a1, d0, d1, r0, r1, r2, r3;
            tr_read4(t2a + off_b(rowb, 4 * wr + 2 * blk + (pp >> 1)) + 8 * (pp & 1), t2a + off_b(rowb + 4, 4 * wr + 2 * blk + (pp >> 1)) + 8 * (pp & 1),
                     t1a + off_b(rowb, 4 * cg0 + 2 * blk + (pp >> 1)) + 8 * (pp & 1), t1a + off_b(rowb + 4, 4 * cg0 + 2 * blk + (pp >> 1)) + 8 * (pp & 1), a0, a1, r0, r1);
            tr_read4(t1a + off_b(rowb, 4 * cg1 + 2 * blk + (pp >> 1)) + 8 * (pp & 1), t1a + off_b(rowb + 4, 4 * cg1 + 2 * blk + (pp >> 1)) + 8 * (pp & 1),
                     t1a + off_b(rowb, 4 * cg1 + 2 * blk + (pp >> 1)) + 8 * (pp & 1), t1a + off_b(rowb + 4, 4 * cg1 + 2 * blk + (pp >> 1)) + 8 * (pp & 1), r2, r3, d0, d1);
            const bf16x8 A = cat4(a0, a1);
            accC[0] = MFMA32(A, cat4(r0, r1), accC[0]); accC[1] = MFMA32(A, cat4(r2, r3), accC[1]); }
        if (!ret) { const int kcol_ = tid & 127, r0 = 32 * (tid >> 7); float s = 0.f;
#pragma unroll 8
            for (int r = 0; r < 32; ++r) s += bf2f(*(const LAS unsigned short*)(T1 + off_b(r0 + r, kcol_ >> 3) + 2 * (kcol_ & 7)));
            atomicAdd((float*)(sn + kcol_), s); }
        if constexpr (PASS == 2) {
#pragma unroll
        for (int c = 0; c < 2; ++c) { const int k_idx = 64 * wc + 32 * c + l31;
#pragma unroll
            for (int i = 0; i < 16; ++i) { const int v = 32 * wr + crow(i, hh); *(LAS unsigned short*)(T3 + off_b(v, k_idx >> 3) + 2 * (k_idx & 7)) = (unsigned short)f2bf(accC[c][i]); } }
        }
        m_state = m_new;
        LDS_BARRIER();
    }
    float* out = p.out;
    if constexpr (PASS == 1) {
        float* L = Lws + (size_t)(bh * 3 + seg) * 16384;
#pragma unroll
        for (int c = 0; c < 2; ++c)
#pragma unroll
            for (int ii = 0; ii < 16; ++ii) L[(32 * wr + crow(ii, hh)) * 128 + 64 * wc + 32 * c + l31] = accC[c][ii];
        if (tid < 128) NLws[(size_t)(bh * 3 + seg) * 128 + tid] = sn[tid];
        __syncthreads();
        return;
    }
    if (seg != 3) { __syncthreads(); return; }
#pragma unroll
    for (int c = 0; c < 2; ++c) { const int k_idx = 64 * wc + 32 * c + l31;
#pragma unroll
        for (int i = 0; i < 16; ++i) { const int v = 32 * wr + crow(i, hh);
            if (!ret) out[O_CP + ((size_t)(b * 4 + hd) * 128 + v) * 128 + k_idx] = accC[c][i];
            else out[O_SP + ((size_t)(b * 4 + hd) * 128 + k_idx) * 128 + v] = accC[c][i]; } }
    if (!ret) { if (tid < 128) out[O_NP + (size_t)(b * 4 + hd) * 128 + tid] = sn[tid]; if (tid == 0) out[O_MP + b * 4 + hd] = m_state; }
    __syncthreads();
}
DI void scan_sample_block(const Params& p, LAS unsigned char* lds, int item) {
    const int tid = threadIdx.x, lane = tid & 63, wid = tid >> 6;
    const int b = item >> 3, head8 = item & 7, hd = head8 & 3; const bool ret = head8 >= 4;
    unsigned char* ws = p.ws; float* out = p.out;
    const size_t m = (size_t)NPROMPT + b;
    const bf16_t* ur = (const bf16_t*)(ws + WS_U) + m * UC;
    bf16_t* HM = (bf16_t*)(ws + WS_BFB) + m * DM;
    const float* gates = (const float*)(ws + WS_SMALL) + SM_GATES + m * 8;
    LAS float* sq = (LAS float*)lds; LAS float* sk = sq + 128; LAS float* sv = sq + 256; LAS float* sred = sq + 384; LAS float* spart = sq + 1024;
    const int part = tid & 3;
    if (!ret) {
        const float* C0 = p.in[5] + (size_t)(b * 4 + hd) * 16384 + (tid >> 2) * 128 + 32 * part;
        f32x4 cr[8];
#pragma unroll
        for (int j = 0; j < 8; ++j) cr[j] = ((const f32x4*)C0)[j];
        if (tid < 128) { const float* w_conv = p.in[12]; const float* b_conv = p.in[13]; const float* cst = p.in[4] + (size_t)b * 3 * 1024;
            const int cq = hd * 128 + tid, ck = 512 + cq;
            const float aq = b_conv[cq] + w_conv[cq] * cst[cq] + w_conv[1024 + cq] * cst[1024 + cq] + w_conv[2048 + cq] * cst[2048 + cq] + w_conv[3072 + cq] * bf2f(ur[cq]);
            const float ak = b_conv[ck] + w_conv[ck] * cst[ck] + w_conv[1024 + ck] * cst[1024 + ck] + w_conv[2048 + ck] * cst[2048 + ck] + w_conv[3072 + ck] * bf2f(ur[ck]);
            sq[tid] = aq * sigmoidf_(aq); sk[tid] = ak * sigmoidf_(ak) * 0.08838834764831845f; sv[tid] = bf2f(ur[1024 + hd * 128 + tid]); }
        __syncthreads();
        const int v = tid >> 2;
        float* C1 = out + O_CS + (size_t)(b * 4 + hd) * 16384 + v * 128 + 32 * part;
        const float* n0 = p.in[6] + (size_t)(b * 4 + hd) * 128;
        float qk = 0.f, nq = 0.f, cq = 0.f;
        f32x4 qv[8], kv[8];
#pragma unroll
        for (int j = 0; j < 8; ++j) { qv[j] = *(const LAS f32x4*)(sq + 32 * part + 4 * j); kv[j] = *(const LAS f32x4*)(sk + 32 * part + 4 * j); const f32x4 nn = *(const f32x4*)(n0 + 32 * part + 4 * j);
            qk += (qv[j].x * kv[j].x + qv[j].y * kv[j].y) + (qv[j].z * kv[j].z + qv[j].w * kv[j].w); nq += (qv[j].x * nn.x + qv[j].y * nn.y) + (qv[j].z * nn.z + qv[j].w * nn.w);
            cq += (qv[j].x * cr[j].x + qv[j].y * cr[j].y) + (qv[j].z * cr[j].z + qv[j].w * cr[j].w); }
        qk += __shfl_xor(qk, 1); qk += __shfl_xor(qk, 2); nq += __shfl_xor(nq, 1); nq += __shfl_xor(nq, 2); cq += __shfl_xor(cq, 1); cq += __shfl_xor(cq, 2);
        const float ig = gates[hd], lf = logsigmoidf_(gates[4 + hd]), m0s = p.in[7][b * 4 + hd];
        const float mt = fmaxf(lf + m0s, ig), wts_e = __expf(ig - mt), win = __expf(lf + m0s - mt);
        const float wts = wts_e * qk, den = wts + win * nq, dinv = 1.0f / fmaxf(fabsf(den), __expf(-mt));
        const float vv = sv[v], hv = (wts * vv + win * cq) * dinv, wv = wts_e * vv;
#pragma unroll
        for (int j = 0; j < 8; ++j) ((f32x4*)C1)[j] = cr[j] * win + kv[j] * wv;
        if (tid < 128) out[O_NS + (size_t)(b * 4 + hd) * 128 + tid] = win * n0[tid] + wts_e * sk[tid];
        if (tid == 0) out[O_MS + b * 4 + hd] = mt;
        float ss = (part == 0) ? hv * hv : 0.f; ss = wave_sum(ss);
        if (lane == 0) sred[wid] = ss;
        __syncthreads();
        const float tot = ((sred[0] + sred[1]) + (sred[2] + sred[3])) + ((sred[4] + sred[5]) + (sred[6] + sred[7]));
        const float rn = rsqrtf(tot * (1.0f / 128.0f) + EPS);
        if (part == 0) HM[hd * 128 + v] = (bf16_t)f2bf(hv * rn * p.in[15][hd * 128 + v] * sigmoidf_(bf2f(ur[1536 + hd * 128 + v])));
    } else {
        const int qc = 2048 + hd * 128;
        const float* S0 = p.in[8] + (size_t)(b * 4 + hd) * 16384 + (8 * (tid >> 5)) * 128 + 4 * (tid & 31);
        f32x4 sr[8];
#pragma unroll
        for (int j = 0; j < 8; ++j) sr[j] = *(const f32x4*)(S0 + j * 128);
        if (tid < 64) { float sn_, cs_; const float inv = exp2f(-(float)tid * 0.20762050593046014f); sincos_red(16384.0f * inv, sn_, cs_);
            const float xq1 = bf2f(ur[qc + tid]), xq2 = bf2f(ur[qc + 64 + tid]), xk1 = bf2f(ur[qc + 512 + tid]), xk2 = bf2f(ur[qc + 576 + tid]);
            sq[tid] = xq1 * cs_ - xq2 * sn_; sq[tid + 64] = xq2 * cs_ + xq1 * sn_;
            sk[tid] = (xk1 * cs_ - xk2 * sn_) * 0.08838834764831845f; sk[tid + 64] = (xk2 * cs_ + xk1 * sn_) * 0.08838834764831845f; }
        else if (tid < 192) sv[tid - 64] = bf2f(ur[qc + 1024 + tid - 64]);
        __syncthreads();
        const int kg = tid >> 5, v4 = tid & 31;
        float* S1 = out + O_SS + (size_t)(b * 4 + hd) * 16384 + (8 * kg) * 128 + 4 * v4;
        float qk = 0.f;
#pragma unroll
        for (int j = 0; j < 32; ++j) qk += sq[32 * part + j] * sk[32 * part + j];
        qk += __shfl_xor(qk, 1); qk += __shfl_xor(qk, 2);
        const float gamma = 1.0f - exp2f(-5.0f - (float)hd);
        const f32x4 vv4 = *(const LAS f32x4*)(sv + 4 * v4);
        f32x4 a4 = {0.f, 0.f, 0.f, 0.f};
#pragma unroll
        for (int j = 0; j < 8; ++j) { const float qj = sq[8 * kg + j], kj = sk[8 * kg + j]; a4 += sr[j] * qj; *(f32x4*)(S1 + j * 128) = sr[j] * gamma + vv4 * kj; }
        *(LAS f32x4*)(spart + kg * 128 + 4 * v4) = a4;
        __syncthreads();
        float o = 0.f, ss = 0.f;
        if (tid < 128) { float a = 0.f;
#pragma unroll
            for (int g = 0; g < 16; ++g) a += spart[g * 128 + tid];
            o = qk * sv[tid] + gamma * a; ss = o * o; }
        ss = wave_sum(ss);
        if (lane == 0) sred[wid] = ss;
        __syncthreads();
        const float rn = rsqrtf((sred[0] + sred[1]) * (1.0f / 128.0f) + EPS);
        if (tid < 128) { const float g0 = bf2f(ur[qc + 1536 + tid]); HM[512 + hd * 128 + tid] = (bf16_t)f2bf(o * rn * p.in[16][hd * 128 + tid] * g0 * sigmoidf_(g0)); }
    }
    __syncthreads();
}
DI void scan_sample_two(const Params& p, LAS unsigned char* lds, int item0) {
    constexpr int NI = 2;
    const int tid = threadIdx.x, lane = tid & 63, wid = tid >> 6, part = tid & 3;
    const int head8 = item0 & 7, hd = head8 & 3; const bool ret = head8 >= 4;
    unsigned char* ws = p.ws; float* out = p.out;
    LAS float* fb = (LAS float*)lds;
    int bb[NI]; const bf16_t* ur[NI]; bf16_t* HM[NI];
#pragma unroll
    for (int i = 0; i < NI; ++i) { bb[i] = (item0 >> 3) + 32 * i; const size_t m = (size_t)NPROMPT + bb[i]; ur[i] = (const bf16_t*)(ws + WS_U) + m * UC; HM[i] = (bf16_t*)(ws + WS_BFB) + m * DM; }
    if (!ret) {
        f32x4 cr[NI][8]; float g_i[NI], g_f[NI], m0s[NI], n0t[NI], mov[NI];
        float cin[NI][9];
        const int cq = hd * 128 + (tid & 127), ck = 512 + cq;
#pragma unroll
        for (int i = 0; i < NI; ++i) { const float* C0 = p.in[5] + (size_t)(bb[i] * 4 + hd) * 16384 + (tid >> 2) * 128 + 32 * part;
#pragma unroll
            for (int j = 0; j < 8; ++j) cr[i][j] = ((const f32x4*)C0)[j];
            const float* gates = (const float*)(ws + WS_SMALL) + SM_GATES + ((size_t)NPROMPT + bb[i]) * 8;
            g_i[i] = gates[hd]; g_f[i] = gates[4 + hd]; m0s[i] = p.in[7][bb[i] * 4 + hd]; n0t[i] = p.in[6][(size_t)(bb[i] * 4 + hd) * 128 + (tid & 127)];
            mov[i] = bf2f(ur[i][1536 + hd * 128 + (tid >> 2)]);
            const float* cst = p.in[4] + (size_t)bb[i] * 3 * 1024;
            cin[i][0] = cst[cq]; cin[i][1] = cst[1024 + cq]; cin[i][2] = cst[2048 + cq]; cin[i][3] = bf2f(ur[i][cq]);
            cin[i][4] = cst[ck]; cin[i][5] = cst[1024 + ck]; cin[i][6] = cst[2048 + ck]; cin[i][7] = bf2f(ur[i][ck]); cin[i][8] = bf2f(ur[i][1024 + hd * 128 + (tid & 127)]); }
        const float* w_conv = p.in[12]; const float* b_conv = p.in[13];
        const float wq0 = w_conv[cq], wq1 = w_conv[1024 + cq], wq2 = w_conv[2048 + cq], wq3 = w_conv[3072 + cq], bq_ = b_conv[cq];
        const float wk0 = w_conv[ck], wk1 = w_conv[1024 + ck], wk2 = w_conv[2048 + ck], wk3 = w_conv[3072 + ck], bk_ = b_conv[ck];
        const float ghv = p.in[15][hd * 128 + (tid >> 2)];
        if (tid < 128) {
#pragma unroll
            for (int i = 0; i < NI; ++i) { LAS float* f = fb + 512 * i;
                const float aq = bq_ + wq0 * cin[i][0] + wq1 * cin[i][1] + wq2 * cin[i][2] + wq3 * cin[i][3];
                const float ak = bk_ + wk0 * cin[i][4] + wk1 * cin[i][5] + wk2 * cin[i][6] + wk3 * cin[i][7];
                f[tid] = aq * sigmoidf_(aq); f[128 + tid] = ak * sigmoidf_(ak) * 0.08838834764831845f; f[256 + tid] = cin[i][8]; f[384 + tid] = n0t[i]; } }
        LDS_BARRIER();
        const int v = tid >> 2; float hv[NI];
#pragma unroll
        for (int i = 0; i < NI; ++i) { const LAS float* f = fb + 512 * i;
            float* C1 = out + O_CS + (size_t)(bb[i] * 4 + hd) * 16384 + v * 128 + 32 * part;
            float qk = 0.f, nq = 0.f, cqs = 0.f; f32x4 kv[8];
#pragma unroll
            for (int j = 0; j < 8; ++j) { const f32x4 qv = *(const LAS f32x4*)(f + 32 * part + 4 * j); kv[j] = *(const LAS f32x4*)(f + 128 + 32 * part + 4 * j); const f32x4 nn = *(const LAS f32x4*)(f + 384 + 32 * part + 4 * j);
                qk += (qv.x * kv[j].x + qv.y * kv[j].y) + (qv.z * kv[j].z + qv.w * kv[j].w); nq += (qv.x * nn.x + qv.y * nn.y) + (qv.z * nn.z + qv.w * nn.w);
                cqs += (qv.x * cr[i][j].x + qv.y * cr[i][j].y) + (qv.z * cr[i][j].z + qv.w * cr[i][j].w); }
            qk += __shfl_xor(qk, 1); qk += __shfl_xor(qk, 2); nq += __shfl_xor(nq, 1); nq += __shfl_xor(nq, 2); cqs += __shfl_xor(cqs, 1); cqs += __shfl_xor(cqs, 2);
            const float ig = g_i[i], lf = logsigmoidf_(g_f[i]);
            const float mt = fmaxf(lf + m0s[i], ig), wts_e = __expf(ig - mt), win = __expf(lf + m0s[i] - mt);
            const float wts = wts_e * qk, den = wts + win * nq, dinv = 1.0f / fmaxf(fabsf(den), __expf(-mt));
            const float vv = f[256 + v], wv = wts_e * vv; hv[i] = (wts * vv + win * cqs) * dinv;
#pragma unroll
            for (int j = 0; j < 8; ++j) ((f32x4*)C1)[j] = cr[i][j] * win + kv[j] * wv;
            if (tid < 128) out[O_NS + (size_t)(bb[i] * 4 + hd) * 128 + tid] = win * n0t[i] + wts_e * f[128 + tid];
            if (tid == 0) out[O_MS + bb[i] * 4 + hd] = mt;
            float ss = (part == 0) ? hv[i] * hv[i] : 0.f; ss = wave_sum(ss);
            if (lane == 0) fb[1024 + 8 * i + wid] = ss; }
        LDS_BARRIER();
#pragma unroll
        for (int i = 0; i < NI; ++i) { const LAS float* sr_ = fb + 1024 + 8 * i;
            const float tot = ((sr_[0] + sr_[1]) + (sr_[2] + sr_[3])) + ((sr_[4] + sr_[5]) + (sr_[6] + sr_[7]));
            const float rn = rsqrtf(tot * (1.0f / 128.0f) + EPS);
            if (part == 0) HM[i][hd * 128 + v] = (bf16_t)f2bf(hv[i] * rn * ghv * sigmoidf_(mov[i])); }
    } else {
        const int qc = 2048 + hd * 128, kg = tid >> 5, v4 = tid & 31;
        f32x4 sr[NI][8]; float rin[NI][5], rgv[NI];
#pragma unroll
        for (int i = 0; i < NI; ++i) { const float* S0 = p.in[8] + (size_t)(bb[i] * 4 + hd) * 16384 + (8 * kg) * 128 + 4 * v4;
#pragma unroll
            for (int j = 0; j < 8; ++j) sr[i][j] = *(const f32x4*)(S0 + j * 128);
            rgv[i] = bf2f(ur[i][qc + 1536 + (tid & 127)]);
            const int l6 = tid & 63;
            rin[i][0] = bf2f(ur[i][qc + l6]); rin[i][1] = bf2f(ur[i][qc + 64 + l6]); rin[i][2] = bf2f(ur[i][qc + 512 + l6]); rin[i][3] = bf2f(ur[i][qc + 576 + l6]); rin[i][4] = bf2f(ur[i][qc + 1024 + (tid & 127)]); }
        const float ghr = p.in[16][hd * 128 + (tid & 127)];
        if (tid < 64) { float sn_, cs_; const float inv = exp2f(-(float)tid * 0.20762050593046014f); sincos_red(16384.0f * inv, sn_, cs_);
#pragma unroll
            for (int i = 0; i < NI; ++i) { LAS float* f = fb + 512 * i;
                f[tid] = rin[i][0] * cs_ - rin[i][1] * sn_; f[tid + 64] = rin[i][1] * cs_ + rin[i][0] * sn_;
                f[128 + tid] = (rin[i][2] * cs_ - rin[i][3] * sn_) * 0.08838834764831845f; f[128 + tid + 64] = (rin[i][3] * cs_ + rin[i][2] * sn_) * 0.08838834764831845f; } }
        if (tid >= 128 && tid < 256) {
#pragma unroll
            for (int i = 0; i < NI; ++i) fb[512 * i + 256 + (tid & 127)] = rin[i][4]; }
        LDS_BARRIER();
        const float gamma = 1.0f - exp2f(-5.0f - (float)hd);
        float qk[NI];
#pragma unroll
        for (int i = 0; i < NI; ++i) { const LAS float* f = fb + 512 * i;
            float* S1 = out + O_SS + (size_t)(bb[i] * 4 + hd) * 16384 + (8 * kg) * 128 + 4 * v4;
            float q_ = 0.f;
#pragma unroll
            for (int j = 0; j < 32; ++j) q_ += f[32 * part + j] * f[128 + 32 * part + j];
            q_ += __shfl_xor(q_, 1); q_ += __shfl_xor(q_, 2); qk[i] = q_;
            const f32x4 vv4 = *(const LAS f32x4*)(f + 256 + 4 * v4);
            f32x4 a4 = {0.f, 0.f, 0.f, 0.f};
#pragma unroll
            for (int j = 0; j < 8; ++j) { const float qj = f[8 * kg + j], kj = f[128 + 8 * kg + j]; a4 += sr[i][j] * qj; *(f32x4*)(S1 + j * 128) = sr[i][j] * gamma + vv4 * kj; }
            *(LAS f32x4*)(fb + 2048 + 2048 * i + kg * 128 + 4 * v4) = a4; }
        LDS_BARRIER();
        float o[NI];
#pragma unroll
        for (int i = 0; i < NI; ++i) { float ss = 0.f; o[i] = 0.f;
            if (tid < 128) { float a = 0.f;
#pragma unroll
                for (int g = 0; g < 16; ++g) a += fb[2048 + 2048 * i + g * 128 + tid];
                o[i] = qk[i] * fb[512 * i + 256 + tid] + gamma * a; ss = o[i] * o[i]; }
            ss = wave_sum(ss);
            if (lane == 0) fb[1024 + 8 * i + wid] = ss; }
        LDS_BARRIER();
#pragma unroll
        for (int i = 0; i < NI; ++i) { const float rn = rsqrtf((fb[1024 + 8 * i] + fb[1024 + 8 * i + 1]) * (1.0f / 128.0f) + EPS);
            if (tid < 128) { const float g0 = rgv[i]; HM[i][512 + hd * 128 + tid] = (bf16_t)f2bf(o[i] * rn * ghr * g0 * sigmoidf_(g0)); } }
    }
    LDS_BARRIER();
}
DI void conv_outputs(const Params& p, int idx0, int stride) {
    const bf16_t* U = (const bf16_t*)(p.ws + WS_U); float* out = p.out;
    for (int i = idx0; i < 8 * 3 * 1024; i += stride) { const int b = i / 3072, j = (i / 1024) % 3, c = i & 1023; out[O_CONVP + i] = bf2f(U[((size_t)b * 2048 + 2045 + j) * UC + c]); }
    for (int i = idx0; i < 128 * 3 * 1024; i += stride) { const int b = i / 3072, j = (i / 1024) % 3, c = i & 1023;
        out[O_CONVS + i] = (j < 2) ? p.in[4][(size_t)b * 3072 + (j + 1) * 1024 + c] : bf2f(U[((size_t)NPROMPT + b) * UC + c]); }
}

DI void attn_prompt_unit(const Params& p, LAS unsigned char* lds, int u) {
    const int tid = threadIdx.x, wid = __builtin_amdgcn_readfirstlane(tid >> 6);
    int lane = tid & 63, hh = lane >> 5, l31 = lane & 31;
    const int b = u >> 5, h = (u >> 3) & 3, qt = u & 7;
    unsigned char* ws = p.ws;
    const bf16_t* Q = (const bf16_t*)(ws + WS_BFA); bf16_t* O = (bf16_t*)(ws + WS_BFB);
    const bf16_t* KP = (const bf16_t*)(ws + WS_KP) + (size_t)(b * 4 + h) * 65536; const bf16_t* VP = (const bf16_t*)(ws + WS_VP) + (size_t)(b * 4 + h) * 65536;
    const size_t mrow = (size_t)b * 2048 + qt * 256 + 32 * wid;
    const unsigned la = (unsigned)(uintptr_t)lds;
    int blk = (lane >> 4) & 1, q4 = (lane & 15) >> 2, pp = lane & 3;
#pragma unroll
    for (int i = 0; i < 16; ++i) { const int idx = tid + 512 * i, row = idx >> 5, c8 = idx & 31; *(LAS u32x4*)(lds + (c8 >> 4) * 65536 + off_b(row, c8 & 15)) = *(const u32x4*)(KP + row * 256 + 8 * c8); }
    __syncthreads();
    f32x16 acc[8];
#pragma unroll
    for (int c = 0; c < 8; ++c)
#pragma unroll
        for (int i = 0; i < 16; ++i) acc[c][i] = 0.f;
#pragma unroll 1
    for (int sh = 0; sh < 4; ++sh) {
        lane = tid & 63; asm volatile("" : "+v"(lane)); hh = lane >> 5; l31 = lane & 31;
        bf16x8 bq[4];
#pragma unroll
        for (int s = 0; s < 4; ++s) bq[s] = *(const bf16x8*)(Q + (mrow + l31) * DM + h * 256 + 16 * (4 * sh + s) + 8 * hh);
#pragma unroll
        for (int s = 0; s < 4; ++s) { const int c16 = 2 * (4 * sh + s) + hh;
#pragma unroll
            for (int c = 0; c < 8; ++c) { const bf16x8 A = *(const LAS bf16x8*)(lds + (c16 >> 4) * 65536 + off_b(32 * c + l31, c16 & 15)); acc[c] = MFMA32(A, bq[s], acc[c]); } }
    }
    float mx = -INFINITY;
#pragma unroll
    for (int c = 0; c < 8; ++c)
#pragma unroll
        for (int i = 0; i < 16; ++i) mx = fmaxf(mx, acc[c][i]);
    mx = fmaxf(mx, __shfl_xor(mx, 32));
    float sum = 0.f;
    bf16x8 pf[8][2];
#pragma unroll
    for (int c = 0; c < 8; ++c) {
        float e[16];
#pragma unroll
        for (int i = 0; i < 16; ++i) { e[i] = __expf(acc[c][i] - mx); sum += e[i]; }
#pragma unroll
        for (int s2 = 0; s2 < 2; ++s2) { u32x4 w; w.x = pk2(e[8 * s2], e[8 * s2 + 1]); w.y = pk2(e[8 * s2 + 2], e[8 * s2 + 3]); w.z = pk2(e[8 * s2 + 4], e[8 * s2 + 5]); w.w = pk2(e[8 * s2 + 6], e[8 * s2 + 7]);
            pf[c][s2] = __builtin_bit_cast(bf16x8, w); }
    }
    sum += __shfl_xor(sum, 32);
    float rinv[16];
#pragma unroll
    for (int i = 0; i < 16; ++i) rinv[i] = 1.0f / __shfl(sum, crow(i, hh));
    __syncthreads();
#pragma unroll
    for (int i = 0; i < 16; ++i) { const int idx = tid + 512 * i, row = idx >> 5, c8 = idx & 31; *(LAS u32x4*)(lds + (c8 >> 4) * 65536 + off_b(row, c8 & 15)) = *(const u32x4*)(VP + row * 256 + 8 * c8); }
    __syncthreads();
#pragma unroll 1
    for (int dt = 0; dt < 8; ++dt) {
        lane = tid & 63; asm volatile("" : "+v"(lane)); hh = lane >> 5; l31 = lane & 31; blk = (lane >> 4) & 1; q4 = (lane & 15) >> 2; pp = lane & 3;
        f32x16 o;
#pragma unroll
        for (int i = 0; i < 16; ++i) o[i] = 0.f;
        const unsigned base = la + (dt >> 2) * 65536; const int chk = 4 * (dt & 3) + 2 * blk + (pp >> 1); const unsigned sub8 = 8 * (pp & 1);
#pragma unroll
        for (int c = 0; c < 8; ++c) {
            const int r0 = 32 * c + 4 * hh + q4; s16x4 x0, x1, x2, x3;
            tr_read4(base + off_b(r0, chk) + sub8, base + off_b(r0 + 8, chk) + sub8, base + off_b(r0 + 16, chk) + sub8, base + off_b(r0 + 24, chk) + sub8, x0, x1, x2, x3);
            o = MFMA32(pf[c][0], cat4(x0, x1), o); o = MFMA32(pf[c][1], cat4(x2, x3), o); }
#pragma unroll
        for (int i = 0; i < 16; ++i) O[(mrow + crow(i, hh)) * DM + h * 256 + 32 * dt + l31] = (bf16_t)f2bf(o[i] * rinv[i]);
    }
    __syncthreads();
}
DI void attn_sample_pair(const Params& p, LAS unsigned char* lds, int it0) {
    const int tid = threadIdx.x, lane = tid & 63, wid = tid >> 6, sub = wid >> 2, w4 = wid & 3, g = lane >> 4, i16 = lane & 15;
    const int it = it0 + sub, b = it >> 2, h = it & 3;
    const bf16_t* Q = (const bf16_t*)(p.ws + WS_BFA) + ((size_t)NPROMPT + b) * DM + h * 256;
    LAS float* xm = (LAS float*)(lds + 131072); LAS float* xs = xm + 8; LAS float* part = xm + 16;
    f32x4 q[4];
#pragma unroll
    for (int j = 0; j < 4; ++j) { const u32x2 qw = *(const u32x2*)(Q + 4 * (i16 + 16 * j)); q[j].x = bflo(qw.x); q[j].y = bfhi(qw.x); q[j].z = bflo(qw.y); q[j].w = bfhi(qw.y); }
    const float* ck = p.in[2] + (((size_t)b * 256 + 64 * w4 + g) * 4 + h) * 256 + 4 * i16; const float* cv = p.in[3] + (((size_t)b * 256 + 64 * w4 + g) * 4 + h) * 256 + 4 * i16;
    float sc[16];
#pragma unroll
    for (int s = 0; s < 16; ++s) { float d = 0.f;
#pragma unroll
        for (int j = 0; j < 4; ++j) { const f32x4 kr = *(const f32x4*)(ck + (size_t)s * 4096 + 64 * j); d += (kr.x * q[j].x + kr.y * q[j].y) + (kr.z * q[j].z + kr.w * q[j].w); }
        d += __shfl_xor(d, 1); d += __shfl_xor(d, 2); d += __shfl_xor(d, 4); d += __shfl_xor(d, 8); sc[s] = d; }
    float lm = sc[0];
#pragma unroll
    for (int s = 1; s < 16; ++s) lm = fmaxf(lm, sc[s]);
    lm = fmaxf(lm, __shfl_xor(lm, 16)); lm = fmaxf(lm, __shfl_xor(lm, 32));
    if (lane == 0) xm[sub * 4 + w4] = lm;
    __syncthreads();
    const float gm = fmaxf(fmaxf(xm[sub * 4], xm[sub * 4 + 1]), fmaxf(xm[sub * 4 + 2], xm[sub * 4 + 3]));
    float ls = 0.f;
#pragma unroll
    for (int s = 0; s < 16; ++s) { sc[s] = __expf(sc[s] - gm); ls += sc[s]; }
    ls += __shfl_xor(ls, 16); ls += __shfl_xor(ls, 32);
    if (lane == 0) xs[sub * 4 + w4] = ls;
    f32x4 o[4];
#pragma unroll
    for (int j = 0; j < 4; ++j) o[j] = (f32x4){0.f, 0.f, 0.f, 0.f};
#pragma unroll
    for (int s = 0; s < 16; ++s)
#pragma unroll
        for (int j = 0; j < 4; ++j) { const f32x4 vr = *(const f32x4*)(cv + (size_t)s * 4096 + 64 * j); o[j] += vr * sc[s]; }
#pragma unroll
    for (int j = 0; j < 4; ++j)
#pragma unroll
        for (int e = 0; e < 4; ++e) { float t = o[j][e]; t += __shfl_xor(t, 16); t += __shfl_xor(t, 32); o[j][e] = t; }
    if (g == 0) {
#pragma unroll
        for (int j = 0; j < 4; ++j) *(LAS f32x4*)(part + (sub * 4 + w4) * 256 + 4 * (i16 + 16 * j)) = o[j]; }
    __syncthreads();
    { const int d = tid & 255, s2 = tid >> 8; const float gs = (xs[s2 * 4] + xs[s2 * 4 + 1]) + (xs[s2 * 4 + 2] + xs[s2 * 4 + 3]);
      const float v = (part[(s2 * 4) * 256 + d] + part[(s2 * 4 + 1) * 256 + d]) + (part[(s2 * 4 + 2) * 256 + d] + part[(s2 * 4 + 3) * 256 + d]);
      const int it2 = it0 + s2; bf16_t* O2 = (bf16_t*)(p.ws + WS_BFB) + ((size_t)NPROMPT + (it2 >> 2)) * DM + (it2 & 3) * 256; O2[d] = (bf16_t)f2bf(v / gs); }
    __syncthreads();
}
DI void final_norm(const Params& p) {
    const int lane = threadIdx.x & 63, gw = blockIdx.x * 8 + (threadIdx.x >> 6), NGW = gridDim.x * 8;
    const bf16_t* X3 = (const bf16_t*)(p.ws + WS_BFA); const float* rs3 = (const float*)(p.ws + WS_SMALL) + SM_RS3; const float* gf = p.in[28];
    f32x4 g[4];
#pragma unroll
    for (int j = 0; j < 4; ++j) g[j] = ((const f32x4*)gf)[4 * lane + j];
    constexpr int RB = 9, NGRP = (NVALID + RB - 1) / RB;
#pragma unroll 1
    for (int gi = gw; gi < NGRP; gi += NGW) {
        u32x4 w0[RB], w1[RB]; float rr[RB];
#pragma unroll
        for (int r = 0; r < RB; ++r) { int m = gi * RB + r; if (m >= NVALID) m = NVALID - 1; const u32x4* xr = (const u32x4*)(X3 + (size_t)m * DM) + 2 * lane; w0[r] = xr[0]; w1[r] = xr[1]; rr[r] = rs3[m]; }
#pragma unroll
        for (int r = 0; r < RB; ++r) { const int m = gi * RB + r; if (m >= NVALID) continue;
            const float sc = rsqrtf(rr[r] * (1.0f / 1024.0f) + EPS);
            f32x4* orow = (f32x4*)(p.out + (m < NPROMPT ? O_YP + (size_t)m * DM : O_YS + (size_t)(m - NPROMPT) * DM)) + 4 * lane;
            float x[16]; { float t[8]; unpack8(w0[r], t);
#pragma unroll
                for (int e = 0; e < 8; ++e) x[e] = t[e]; unpack8(w1[r], t);
#pragma unroll
                for (int e = 0; e < 8; ++e) x[8 + e] = t[e]; }
#pragma unroll
            for (int j = 0; j < 4; ++j) { f32x4 o; o.x = x[4 * j] * sc * g[j].x; o.y = x[4 * j + 1] * sc * g[j].y; o.z = x[4 * j + 2] * sc * g[j].z; o.w = x[4 * j + 3] * sc * g[j].w; orow[j] = o; } }
    }
}
struct SkScale { bf16_t* O; int ldc; const float* ss; float post;
    DI void operator()(float v0, float v1, int r, int c, int lane) const { const float sc = rsqrtf(ss[r] * (1.0f / 1024.0f) + EPS) * post; *(unsigned*)(O + (size_t)r * ldc + c) = pk2(v0 * sc, v1 * sc); } };
struct SkRes { const float* resf; const bf16_t* resb; bf16_t* outb; float* rs;
    DI void operator()(float v0, float v1, int r, int c, int lane) const { const size_t o = (size_t)r * 1024 + c;
        if (resf) { v0 += resf[o]; v1 += resf[o + 1]; } else { const unsigned w = *(const unsigned*)(resb + o); v0 += bflo(w); v1 += bfhi(w); }
        *(unsigned*)(outb + o) = pk2(v0, v1);
        float q = v0 * v0 + v1 * v1; q += __shfl_xor(q, 1); q += __shfl_xor(q, 2); q += __shfl_xor(q, 4); q += __shfl_xor(q, 8);
        if ((lane & 15) == 0) atomicAdd(rs + r, q); } };
template <class Epi> DI void skinny_gemm(LAS unsigned char* lds, const bf16_t* A, int lda, const bf16_t* Bt, int K, int N, const Epi& E) {
    const int tid = threadIdx.x, lane = tid & 63, wid = tid >> 6, l31 = lane & 31, hh = lane >> 5, G = gridDim.x;
    const int njobs = 4 * (N / 32), kw = K / 8;
    LAS float* part = (LAS float*)lds;
    for (int j = blockIdx.x; j < njobs; j += G) {
        const int rt = j & 3, ct = j >> 2;
        const bf16_t* ap = A + (size_t)(32 * rt + l31) * lda + wid * kw + 8 * hh; const bf16_t* bp = Bt + (size_t)(32 * ct + l31) * K + wid * kw + 8 * hh;
        f32x16 acc;
#pragma unroll
        for (int i = 0; i < 16; ++i) acc[i] = 0.f;
        int k = 0;
#pragma unroll 1
        for (; k + 128 <= kw; k += 128) { bf16x8 a[8], bb[8];
#pragma unroll
            for (int u = 0; u < 8; ++u) { a[u] = *(const bf16x8*)(ap + k + 16 * u); bb[u] = *(const bf16x8*)(bp + k + 16 * u); }
#pragma unroll
            for (int u = 0; u < 8; ++u) acc = MFMA32(a[u], bb[u], acc); }
#pragma unroll 1
        for (; k < kw; k += 16) { const bf16x8 a = *(const bf16x8*)(ap + k), bb = *(const bf16x8*)(bp + k); acc = MFMA32(a, bb, acc); }
#pragma unroll
        for (int i = 0; i < 16; ++i) part[wid * 1024 + crow(i, hh) * 32 + l31] = acc[i];
        __syncthreads();
        { const int e0 = 2 * tid, r = e0 >> 5, c = e0 & 31; float v0 = 0.f, v1 = 0.f;
#pragma unroll
            for (int w = 0; w < 8; ++w) { const f32x2 t = *(const LAS f32x2*)(part + w * 1024 + e0); v0 += t.x; v1 += t.y; }
            E(v0, v1, 32 * rt + r, 32 * ct + c, lane); }
        __syncthreads();
    }
}
#define XB_TMO      128
#define XB_XCNT(j)  (256  + 64 * (j))
#define XB_XSUB(j)  (1280 + 64 * (j))
#define XB_XGEN(j)  (2304 + 64 * (j))
#define XB_TOP      3328
#define XB_TOPGEN   3392
#define XCD_BAR_WORDS 3456
#define XB_SPIN_CAP (1u << 18)

__device__ __forceinline__ unsigned xb_ld(unsigned* p)              { return __hip_atomic_load(p, __ATOMIC_RELAXED, __HIP_MEMORY_SCOPE_AGENT); }
__device__ __forceinline__ unsigned xb_add(unsigned* p, unsigned v) { return __hip_atomic_fetch_add(p, v, __ATOMIC_RELAXED, __HIP_MEMORY_SCOPE_AGENT); }
__device__ __forceinline__ unsigned xb_xcc_id() { return (unsigned)__builtin_amdgcn_s_getreg((3 << 11) | 20) & 0xFu; }
#define XB_SPIN(cond, bar) do { unsigned _sp = 0; while (cond) { __builtin_amdgcn_s_sleep(1); \
    if ((++_sp & 255u) == 0u) { if (xb_ld(&(bar)[XB_TMO])) break; if (_sp > XB_SPIN_CAP) { atomicAdd(&(bar)[XB_TMO], 1u); break; } } } } while (0)

struct XcdBarrier {
    unsigned* bar; unsigned x;
    volatile LAS unsigned* st;
};

__device__ __forceinline__ XcdBarrier xcd_barrier_post(unsigned* bar, volatile LAS unsigned* st) {
    XcdBarrier b; b.bar = bar; b.x = xb_xcc_id(); b.st = st;
    if (threadIdx.x == 0) (void)xb_add(&bar[XB_XCNT(b.x)], 1u);
    return b;
}
__device__ __forceinline__ void xcd_barrier_complete(unsigned* bar, unsigned x, unsigned& nloc, unsigned& nx) {
    const unsigned G = gridDim.x * gridDim.y * gridDim.z;
    unsigned sum, cnt, mine, sp = 0u;
    for (;;) {
        sum = 0u; cnt = 0u; mine = 0u;
#pragma unroll
        for (unsigned j = 0; j < 16; ++j) { const unsigned c = xb_ld(&bar[XB_XCNT(j)]); sum += c; cnt += (c > 0u) ? 1u : 0u; mine = (j == x) ? c : mine; }
        if (sum == G) break;
        __builtin_amdgcn_s_sleep(1);
        if ((++sp & 255u) == 0u) { if (xb_ld(&bar[XB_TMO])) break; if (sp > XB_SPIN_CAP) { atomicAdd(&bar[XB_TMO], 1u); break; } }
    }
    nloc = mine > 0u ? mine : 1u; nx = cnt > 0u ? cnt : 1u;
}

__device__ __forceinline__ void xcd_barrier(const XcdBarrier& b) {
    asm volatile("s_waitcnt vmcnt(0)" ::: "memory");
    __syncthreads();
    if (threadIdx.x == 0) {
        unsigned* bar = b.bar;
        __builtin_amdgcn_s_waitcnt(0);
        unsigned nloc = b.st[0], nx = b.st[1];
        if (nloc == 0u) { xcd_barrier_complete(bar, b.x, nloc, nx); b.st[0] = nloc; b.st[1] = nx; }
        const unsigned old = xb_add(&bar[XB_XSUB(b.x)], 1u);
        const unsigned gen = old / nloc;
        if (old + 1u == (gen + 1u) * nloc) {
            __builtin_amdgcn_fence(__ATOMIC_RELEASE, "agent");
            asm volatile("s_waitcnt vmcnt(0)" ::: "memory");
            const unsigned og = xb_add(&bar[XB_TOP], 1u);
            const unsigned tg = og / nx;
            if (og + 1u == (tg + 1u) * nx) xb_add(&bar[XB_TOPGEN], 1u);
            else XB_SPIN(xb_ld(&bar[XB_TOPGEN]) == tg, bar);
            __builtin_amdgcn_fence(__ATOMIC_ACQUIRE, "agent");
            xb_add(&bar[XB_XGEN(b.x)], 1u);
            asm volatile("s_waitcnt vmcnt(0)" ::: "memory");
        } else {
            XB_SPIN(xb_ld(&bar[XB_XGEN(b.x)]) == gen, bar);
            __builtin_amdgcn_fence(__ATOMIC_ACQUIRE, "agent");
            asm volatile("s_waitcnt vmcnt(0)" ::: "memory");
        }
    }
    __syncthreads();
}

__global__ void __launch_bounds__(512, 2) fwd_megakernel(Params p) {
    extern __shared__ __attribute__((aligned(16))) unsigned char lds_raw[];
    LAS unsigned char* lds = (LAS unsigned char*)lds_raw;
    cg::grid_group grid = cg::this_grid();
    unsigned char* ws = p.ws;
    float* sm = (float*)(ws + WS_SMALL);
    const int lo = p.ph_lo, hi = p.ph_hi;
    volatile LAS unsigned* bst = (volatile LAS unsigned*)(lds + LDS_BYTES - 64);
    if (threadIdx.x < 2) bst[threadIdx.x] = 0u;
    __syncthreads();
    const XcdBarrier bar = xcd_barrier_post((unsigned*)(ws + WS_BAR), bst);
    if (lo < 0) grid.sync();
#ifndef PHMASK
#define PHMASK 0x7ff
#endif
#define IN(k) (((PHMASK >> (k)) & 1) && lo <= (k) && (k) < hi)
#define SEAM(k) do { if (IN(k) && IN((k) + 1)) xcd_barrier(bar); } while (0)
#ifndef RPT
#define RPT 0
#endif
#define NREP(k) (((RPT >> (k)) & 1) ? 2 : 1)
    const int G = gridDim.x, bx = blockIdx.x;
    if (IN(0)) for (int rep = 0; rep < NREP(0); ++rep) { p0_prologue(p, lds); __syncthreads(); } SEAM(0);
    if (IN(1)) for (int rep = 0; rep < NREP(1); ++rep) {
        pg8::Gemm g{(const bf16_t*)(ws + WS_BFA), (const bf16_t*)(ws + WS_WIN), NPROMPT, UC, DM}; pg8::StaticOrder S; S.init(NPROMPT, UC, G, bx);
        pg8::EpiScaleBf16 E{(bf16_t*)(ws + WS_U), UC, sm + SM_SS0, 1.0f};
        pg8::gemm_phase<pg8::EpiScaleBf16, pg8::StaticOrder, true, true>(lds, g, S, E);
        skinny_gemm(lds, (const bf16_t*)(ws + WS_BFA) + (size_t)NPROMPT * DM, DM, (const bf16_t*)(ws + WS_WIN), DM, UC, SkScale{(bf16_t*)(ws + WS_U) + (size_t)NPROMPT * UC, UC, sm + SM_SS0 + NPROMPT, 1.0f});
    } SEAM(1);
    if (IN(2)) {
        const bool items_first = (G == 256) && (bx < 192) && (((bx >> 3) & 1) != 0);
        if (items_first) { scan_sample_two(p, lds, bx); scan_sample_two(p, lds, bx + 512); }
        if (bx < 192) { scan_prompt<1>(p, lds, bx & 63, bx >> 6); if (RPT & 0x2000) scan_prompt<1>(p, lds, bx & 63, bx >> 6); }
        else {
            pg8::Gemm g{(const bf16_t*)(ws + WS_MEMB), (const bf16_t*)(ws + WS_WCKV), 2048, 2048, DM}; pg8::SubOrder S{bx - 192, 64, 8};
            pg8::EpiKV E{sm + SM_SSM, p.out + O_MK, p.out + O_MV, (bf16_t*)(ws + WS_KP), (bf16_t*)(ws + WS_VP)};
            pg8::gemm_phase<pg8::EpiKV, pg8::SubOrder, false, true>(lds, g, S, E);
        }
        if (items_first) { }
        else if (G == 256) { scan_sample_two(p, lds, bx); scan_sample_two(p, lds, bx + 512); }
        else for (int item = bx; item < 1024; item += G) scan_sample_block(p, lds, item);
        conv_outputs(p, bx * 512 + threadIdx.x, G * 512);
    } SEAM(2);
    if (IN(3)) { scan_prompt<2>(p, lds, bx & 63, bx >> 6); if (RPT & 0x1000) scan_prompt<2>(p, lds, bx & 63, bx >> 6); } SEAM(3);
    if (IN(4)) for (int rep = 0; rep < NREP(4); ++rep) {
        pg8::Gemm g{(const bf16_t*)(ws + WS_BFB), (const bf16_t*)(ws + WS_WOUT), NPROMPT, DM, DM}; pg8::StaticOrder S; S.init(NPROMPT, DM, G, bx);
        pg8::EpiResB<true> E{p.in[0], nullptr, (bf16_t*)(ws + WS_BFC), rep ? nullptr : sm + SM_RS1};
        pg8::gemm_phase<pg8::EpiResB<true>, pg8::StaticOrder, true, true>(lds, g, S, E);
        if (rep == 0) skinny_gemm(lds, (const bf16_t*)(ws + WS_BFB) + (size_t)NPROMPT * DM, DM, (const bf16_t*)(ws + WS_WOUT), DM, DM, SkRes{p.in[1], nullptr, (bf16_t*)(ws + WS_BFC) + (size_t)NPROMPT * DM, sm + SM_RS1 + NPROMPT});
    } SEAM(4);
    if (IN(5)) for (int rep = 0; rep < NREP(5); ++rep) {
        pg8::Gemm g{(const bf16_t*)(ws + WS_BFC), (const bf16_t*)(ws + WS_WCQ), NPROMPT, DM, DM}; pg8::StaticOrder S; S.init(NPROMPT, DM, G, bx);
        pg8::EpiScaleBf16 E{(bf16_t*)(ws + WS_BFA), DM, sm + SM_RS1, 0.0625f};
        pg8::gemm_phase<pg8::EpiScaleBf16, pg8::StaticOrder, true, true>(lds, g, S, E);
        skinny_gemm(lds, (const bf16_t*)(ws + WS_BFC) + (size_t)NPROMPT * DM, DM, (const bf16_t*)(ws + WS_WCQ), DM, DM, SkScale{(bf16_t*)(ws + WS_BFA) + (size_t)NPROMPT * DM, DM, sm + SM_RS1 + NPROMPT, 0.0625f});
    } SEAM(5);
    if (IN(6)) for (int rep = 0; rep < NREP(6); ++rep) {
        const bool early = ((bx >> 3) & 1) != 0;
        if (early) { for (int it0 = bx * 2; it0 < 512; it0 += G * 2) attn_sample_pair(p, lds, it0); }
        for (int u = bx; u < 256; u += G) attn_prompt_unit(p, lds, u);
        if (!early) { for (int it0 = bx * 2; it0 < 512; it0 += G * 2) attn_sample_pair(p, lds, it0); }
    } SEAM(6);
    if (IN(7)) for (int rep = 0; rep < NREP(7); ++rep) {
        pg8::Gemm g{(const bf16_t*)(ws + WS_BFB), (const bf16_t*)(ws + WS_WCO), NPROMPT, DM, DM}; pg8::StaticOrder S; S.init(NPROMPT, DM, G, bx);
        pg8::EpiResB<false> E{nullptr, (const bf16_t*)(ws + WS_BFC), (bf16_t*)(ws + WS_BFC), sm + SM_RS2};
        pg8::gemm_phase<pg8::EpiResB<false>, pg8::StaticOrder, true, true>(lds, g, S, E);
        if (rep == 0) skinny_gemm(lds, (const bf16_t*)(ws + WS_BFB) + (size_t)NPROMPT * DM, DM, (const bf16_t*)(ws + WS_WCO), DM, DM, SkRes{nullptr, (const bf16_t*)(ws + WS_BFC) + (size_t)NPROMPT * DM, (bf16_t*)(ws + WS_BFC) + (size_t)NPROMPT * DM, sm + SM_RS2 + NPROMPT});
    } SEAM(7);
    if (IN(8)) for (int rep = 0; rep < NREP(8); ++rep) {
        pg8::Gemm g{(const bf16_t*)(ws + WS_BFC), (const bf16_t*)(ws + WS_WGU), MP, 2 * DFF, DM}; pg8::StaticOrder S; S.init(MP, 2 * DFF, G, bx);
        pg8::EpiGU E{(bf16_t*)(ws + WS_U), sm + SM_RS2};
        pg8::gemm_phase<pg8::EpiGU, pg8::StaticOrder, true, true>(lds, g, S, E);
    } SEAM(8);
    if (IN(9)) for (int rep = 0; rep < NREP(9); ++rep) {
        pg8::Gemm g{(const bf16_t*)(ws + WS_U), (const bf16_t*)(ws + WS_WDN), NPROMPT, DM, DFF}; pg8::StaticOrder S; S.init(NPROMPT, DM, G, bx);
        pg8::EpiResB<false> E{nullptr, (const bf16_t*)(ws + WS_BFC), (bf16_t*)(ws + WS_BFA), rep ? nullptr : sm + SM_RS3};
        pg8::gemm_phase<pg8::EpiResB<false>, pg8::StaticOrder, true, true>(lds, g, S, E);
        if (rep == 0) skinny_gemm(lds, (const bf16_t*)(ws + WS_U) + (size_t)NPROMPT * DFF, DFF, (const bf16_t*)(ws + WS_WDN), DFF, DM, SkRes{nullptr, (const bf16_t*)(ws + WS_BFC) + (size_t)NPROMPT * DM, (bf16_t*)(ws + WS_BFA) + (size_t)NPROMPT * DM, sm + SM_RS3 + NPROMPT});
    } SEAM(9);
    if (IN(10)) for (int rep = 0; rep < NREP(10); ++rep) final_norm(p);
#ifdef XSYNC
    for (int i = 0; i < XSYNC; ++i) xcd_barrier(bar);
#endif
#undef IN
#undef SEAM
}

#ifndef N_LAUNCHES
#define N_LAUNCHES 1
#endif
extern "C" void kernel_launch(void* const* d_in, const int* in_sizes, int n_in, void* d_out, int out_size, void* d_ws, size_t ws_size, hipStream_t stream) {
    static int grid = 0;
    if (grid == 0) {
        if (n_in != 29 || out_size != (int)O_END || ws_size < WS_END) { fprintf(stderr, "kernel_launch: unexpected shapes (n_in %d, out %d, ws %zu)\n", n_in, out_size, ws_size); grid = -1; return; }
        int dev = 0, cus = 0, per_cu = 0;
        hipGetDevice(&dev); hipDeviceGetAttribute(&cus, hipDeviceAttributeMultiprocessorCount, dev);
        if (hipFuncSetAttribute((const void*)fwd_megakernel, hipFuncAttributeMaxDynamicSharedMemorySize, LDS_BYTES) != hipSuccess) { fprintf(stderr, "kernel_launch: hipFuncSetAttribute failed\n"); }
        if (hipOccupancyMaxActiveBlocksPerMultiprocessor(&per_cu, (const void*)fwd_megakernel, 512, LDS_BYTES) != hipSuccess) per_cu = 0;
        (void)hipGetLastError();
        fprintf(stderr, "kernel_launch: %d CUs, %d blocks/CU\n", cus, per_cu);
        if (cus * per_cu < 256) { fprintf(stderr, "kernel_launch: resident capacity %d < 256 blocks\n", cus * per_cu); grid = -1; return; }
        grid = 256;
    }
    if (grid < 0) return;
    if (hipMemsetAsync((char*)d_ws + WS_BAR, 0, XCD_BAR_WORDS * 4, stream) != hipSuccess) { fprintf(stderr, "kernel_launch: memset failed\n"); return; }
    Params p{};
    for (int i = 0; i < 29; ++i) p.in[i] = (const float*)d_in[i];
    p.out = (float*)d_out; p.ws = (unsigned char*)d_ws;
#if N_LAUNCHES == 1
    p.ph_lo = 0; p.ph_hi = 11;
    { void* args[] = {&p}; hipError_t e = hipLaunchCooperativeKernel((const void*)fwd_megakernel, dim3(grid), dim3(512), args, LDS_BYTES, stream);
      if (e != hipSuccess) fprintf(stderr, "cooperative launch failed: %s\n", hipGetErrorString(e)); }
#else
    for (int ph = 0; ph < 11; ++ph) { p.ph_lo = ph; p.ph_hi = ph + 1; void* args[] = {&p};
        hipError_t e = hipLaunchCooperativeKernel((const void*)fwd_megakernel, dim3(grid), dim3(512), args, LDS_BYTES, stream);
        if (e != hipSuccess) fprintf(stderr, "cooperative launch %d failed: %s\n", ph, hipGetErrorString(e)); }
#endif
}
```

```cpp
#include <hip/hip_runtime.h>
#include <hip/hip_cooperative_groups.h>
#include <cstdio>
#include <cstdint>
namespace cg = cooperative_groups;
namespace pg8 {
#define PG8_LAS __attribute__((address_space(3)))
typedef unsigned short bf16_t;
typedef short bf16x8 __attribute__((ext_vector_type(8)));
typedef float f32x4 __attribute__((ext_vector_type(4)));
typedef unsigned u32x4 __attribute__((ext_vector_type(4)));
constexpr int BM = 256, BK = 64, HALF = 128, HTB = HALF * BK * 2  , STAGE_BYTES = 8 * HTB, NXCD = 8, WGM = 8;

__host__ __device__ __forceinline__ int lds_byte(int r, int c) { const int st = (r >> 4) * 2 + (c >> 5), rr = r & 15, cc = c & 31, ob = rr * 64 + cc * 2; return st * 1024 + (ob ^ (((ob >> 9) & 1) << 5)); }
__host__ __device__ __forceinline__ void stage_rc(int b, int& R, int& C) { const int st = b / 1024, sb = b % 1024, swz = sb ^ (((sb >> 9) & 1) << 5); R = (st >> 1) * 16 + swz / 64; C = (st & 1) * 32 + (swz % 64) / 2; }
__host__ __device__ __forceinline__ int perm32(int rho) { const int n = rho >> 4, i = rho & 15; return 8 * (i >> 2) + 4 * n + (i & 3); }

struct Unit { int pm, pn; };
struct Gemm { const bf16_t* A; const bf16_t* Bt; int M, N, K; };

struct StaticOrder {
    int nM, nN, nwg, G, c;
    __host__ __device__ void init(int M, int N, int G_, int c_) { nM = M / BM; nN = N / BM; nwg = nM * nN; G = G_; c = c_; }
    __host__ __device__ bool next(int i, Unit& u) const {
        const long L = (long)i * G + c; if (L >= nwg) return false;
        int wgid = (int)L; { const int q = nwg / NXCD, r = nwg % NXCD, xcd = wgid % NXCD, off = wgid / NXCD; wgid = (xcd < r ? xcd * (q + 1) : r * (q + 1) + (xcd - r) * q) + off; }
        const int nig = WGM * nN, gid = wgid / nig, fm = gid * WGM, gsz = (nM - fm) < WGM ? (nM - fm) : WGM;
        u.pm = fm + ((wgid % nig) % gsz); u.pn = (wgid % nig) / gsz; return true;
    }
    __device__ __forceinline__ void a_ready(const Unit&) const {}
    __device__ __forceinline__ void done(const Unit&) const {}
};

__device__ __forceinline__ unsigned cvt_pk_bf16(float lo, float hi) { unsigned r; asm volatile("v_cvt_pk_bf16_f32 %0, %1, %2" : "=v"(r) : "v"(lo), "v"(hi)); return r; }
typedef unsigned u32x2v __attribute__((ext_vector_type(2)));
constexpr float NORM_EPS = 1e-6f;
struct SubOrder {
    int idx, n, nN;
    __device__ bool next(int i, Unit& u) const { if (i != 0 || idx < 0 || idx >= n) return false; u.pm = idx / nN; u.pn = idx % nN; return true; }
    __device__ __forceinline__ void a_ready(const Unit&) const {}
    __device__ __forceinline__ void done(const Unit&) const {}
};
struct EpiScaleBf16 {
    static constexpr bool PERM = true, AFTER_DRAIN = false;
    bf16_t* O; int ldc; const float* ss; float post;
    __device__ __forceinline__ void operator()(const f32x4 (&acc)[2][2][4][2], const Unit& u, int wr, int wc, int fr, int fq) const {
        const int row0 = u.pm * BM + wr * 64 + fr, col0 = u.pn * BM + wc * 32 + 8 * fq;
#pragma unroll
        for (int ai = 0; ai < 2; ++ai)
#pragma unroll
            for (int m = 0; m < 4; ++m) { const int r = row0 + ai * HALF + m * 16; const float sc = rsqrtf(ss[r] * (1.0f / 1024.0f) + NORM_EPS) * post;
                bf16_t* rowp = O + (size_t)r * ldc + col0;
#pragma unroll
                for (int bj = 0; bj < 2; ++bj) { const f32x4 v0 = acc[ai][bj][m][0] * sc, v1 = acc[ai][bj][m][1] * sc;
                    u32x4 w; w.x = cvt_pk_bf16(v0[0], v0[1]); w.y = cvt_pk_bf16(v0[2], v0[3]); w.z = cvt_pk_bf16(v1[0], v1[1]); w.w = cvt_pk_bf16(v1[2], v1[3]);
                    *(u32x4*)(rowp + bj * HALF) = w; } }
    }
};
struct EpiRes {
    static constexpr bool PERM = false, AFTER_DRAIN = false;
    const float* res0; const float* res1; int split, nvalid; float* outf; bf16_t* outb; float* rs;
    __device__ __forceinline__ void operator()(const f32x4 (&acc)[2][2][4][2], const Unit& u, int wr, int wc, int fr, int fq) const {
        const int row0 = u.pm * BM + wr * 64 + fr, col0 = u.pn * BM + wc * 32 + 4 * fq;
#pragma unroll
        for (int ai = 0; ai < 2; ++ai)
#pragma unroll
            for (int m = 0; m < 4; ++m) { const int r = row0 + ai * HALF + m * 16;
                const float* rp = (r < split) ? res0 + (size_t)r * 1024 : ((r < nvalid) ? res1 + (size_t)(r - split) * 1024 : nullptr);
                float s = 0.f;
#pragma unroll
                for (int bj = 0; bj < 2; ++bj)
#pragma unroll
                    for (int n = 0; n < 2; ++n) { const int c = col0 + bj * HALF + n * 16;
                        f32x4 v = acc[ai][bj][m][n]; if (rp) v += *(const f32x4*)(rp + c);
                        *(f32x4*)(outf + (size_t)r * 1024 + c) = v;
                        if (outb) { u32x2v w; w.x = cvt_pk_bf16(v[0], v[1]); w.y = cvt_pk_bf16(v[2], v[3]); *(u32x2v*)(outb + (size_t)r * 1024 + c) = w; }
                        s += (v[0] * v[0] + v[1] * v[1]) + (v[2] * v[2] + v[3] * v[3]); }
                s += __shfl_xor(s, 16); s += __shfl_xor(s, 32);
                if (rs && fq == 0) atomicAdd(rs + r, s); }
    }
};
template <bool RES_F32> struct EpiResB {
    static constexpr bool PERM = true, AFTER_DRAIN = false;
    const float* resf; const bf16_t* resb; bf16_t* outb; float* rs;
    __device__ __forceinline__ void operator()(const f32x4 (&acc)[2][2][4][2], const Unit& u, int wr, int wc, int fr, int fq) const {
        const int row0 = u.pm * BM + wr * 64 + fr, col0 = u.pn * BM + wc * 32 + 8 * fq;
#pragma unroll
        for (int ai = 0; ai < 2; ++ai)
#pragma unroll
            for (int m = 0; m < 4; ++m) { const int r = row0 + ai * HALF + m * 16; float s = 0.f;
#pragma unroll
                for (int bj = 0; bj < 2; ++bj) { const size_t o = (size_t)r * 1024 + col0 + bj * HALF;
                    f32x4 v0 = acc[ai][bj][m][0], v1 = acc[ai][bj][m][1];
                    if (RES_F32) { v0 += *(const f32x4*)(resf + o); v1 += *(const f32x4*)(resf + o + 4); }
                    else { const u32x4 w = *(const u32x4*)(resb + o);
                        v0[0] += __builtin_bit_cast(float, w.x << 16); v0[1] += __builtin_bit_cast(float, w.x & 0xffff0000u); v0[2] += __builtin_bit_cast(float, w.y << 16); v0[3] += __builtin_bit_cast(float, w.y & 0xffff0000u);
                        v1[0] += __builtin_bit_cast(float, w.z << 16); v1[1] += __builtin_bit_cast(float, w.z & 0xffff0000u); v1[2] += __builtin_bit_cast(float, w.w << 16); v1[3] += __builtin_bit_cast(float, w.w & 0xffff0000u); }
                    u32x4 w2; w2.x = cvt_pk_bf16(v0[0], v0[1]); w2.y = cvt_pk_bf16(v0[2], v0[3]); w2.z = cvt_pk_bf16(v1[0], v1[1]); w2.w = cvt_pk_bf16(v1[2], v1[3]);
                    *(u32x4*)(outb + o) = w2;
                    s += ((v0[0] * v0[0] + v0[1] * v0[1]) + (v0[2] * v0[2] + v0[3] * v0[3])) + ((v1[0] * v1[0] + v1[1] * v1[1]) + (v1[2] * v1[2] + v1[3] * v1[3])); }
                s += __shfl_xor(s, 16); s += __shfl_xor(s, 32);
                if (rs && fq == 0) atomicAdd(rs + r, s); }
    }
};
struct EpiKV {
    static constexpr bool PERM = false, AFTER_DRAIN = false;
    const float* ss; float* outk; float* outv; bf16_t* kp; bf16_t* vp;
    __device__ __forceinline__ void operator()(const f32x4 (&acc)[2][2][4][2], const Unit& u, int wr, int wc, int fr, int fq) const {
        const int row0 = u.pm * BM + wr * 64 + fr, col0 = u.pn * BM + wc * 32 + 4 * fq;
#pragma unroll
        for (int ai = 0; ai < 2; ++ai)
#pragma unroll
            for (int m = 0; m < 4; ++m) { const int r = row0 + ai * HALF + m * 16; const float sc = rsqrtf(ss[r] * (1.0f / 1024.0f) + NORM_EPS);
                const int b = r >> 8, key = r & 255;
#pragma unroll
                for (int bj = 0; bj < 2; ++bj)
#pragma unroll
                    for (int n = 0; n < 2; ++n) { const int c = col0 + bj * HALF + n * 16; const f32x4 v = acc[ai][bj][m][n] * sc;
                        const int cc = c & 1023, hd = cc >> 8, dim = cc & 255; const bool isv = c >= 1024;
                        *(f32x4*)((isv ? outv : outk) + (size_t)r * 1024 + cc) = v;
                        u32x2v w; w.x = cvt_pk_bf16(v[0], v[1]); w.y = cvt_pk_bf16(v[2], v[3]);
                        *(u32x2v*)((isv ? vp : kp) + ((size_t)((b * 4 + hd) * 256 + key)) * 256 + dim) = w; } }
    }
};
struct EpiGU {
    static constexpr bool PERM = true, AFTER_DRAIN = false;
    bf16_t* O; const float* ss;
    __device__ __forceinline__ void operator()(const f32x4 (&acc)[2][2][4][2], const Unit& u, int wr, int wc, int fr, int fq) const {
        const int row0 = u.pm * BM + wr * 64 + fr, col0 = u.pn * HALF + wc * 32 + 8 * fq;
#pragma unroll
        for (int ai = 0; ai < 2; ++ai)
#pragma unroll
            for (int m = 0; m < 4; ++m) { const int r = row0 + ai * HALF + m * 16; const float sc = rsqrtf(ss[r] * (1.0f / 1024.0f) + NORM_EPS);
                float a[8];
#pragma unroll
                for (int n = 0; n < 2; ++n)
#pragma unroll
                    for (int e = 0; e < 4; ++e) { const float g = acc[ai][0][m][n][e] * sc, up = acc[ai][1][m][n][e] * sc; a[4 * n + e] = g * __builtin_amdgcn_rcpf(1.0f + __expf(-g)) * up; }
                u32x4 w; w.x = cvt_pk_bf16(a[0], a[1]); w.y = cvt_pk_bf16(a[2], a[3]); w.z = cvt_pk_bf16(a[4], a[5]); w.w = cvt_pk_bf16(a[6], a[7]);
                *(u32x4*)(O + (size_t)r * 2816 + col0) = w; }
    }
};
template <class Epi, class Sched, bool ALIGN_EPI = false, bool SP2 = false>
__device__ __forceinline__ void gemm_phase(PG8_LAS unsigned char* lds, const Gemm g, const Sched& S, const Epi& E) {
    const int tid = threadIdx.x, wid = __builtin_amdgcn_readfirstlane(tid >> 6), lane = tid & 63, wr = wid >> 2, wc = wid & 3, fr = lane & 15, fq = lane >> 4;
    const int K = g.K, nt = K / BK;
    unsigned voffA[2], voffB[2];
#pragma unroll
    for (int i = 0; i < 2; ++i) { int R, C; stage_rc(tid * 16 + i * 8192, R, C); const int Rb = Epi::PERM ? ((R & ~31) + perm32(R & 31)) : R;
        voffA[i] = (unsigned)(R * K + C) * 2u; voffB[i] = (unsigned)(Rb * K + C) * 2u; }
    const size_t kstep = (size_t)(BK * 2);
    const size_t hstep = (size_t)HALF * K * 2;
    const size_t tstep = 2 * hstep;
    const unsigned ldsw = (unsigned)wid * 1024u;
    const int aoff = lds_byte(wr * 64 + fr, fq * 8), boff = lds_byte(wc * 32 + fr, fq * 8);
#define PG8_SA(b, h) (((b) * 2 + (h)) * HTB)
#define PG8_SB(b, h) ((4 + (b) * 2 + (h)) * HTB)
#define PG8_STAGE(bufoff, gbase, voff) do { _Pragma("unroll") for (int _i = 0; _i < 2; ++_i) \
        __builtin_amdgcn_global_load_lds((const unsigned*)((const char*)(gbase) + (voff)[_i]), (PG8_LAS unsigned*)(lds + (bufoff) + ldsw + _i * 8192), 16, 0, 0); } while (0)
#define PG8_LDA(dst, b, h) do { _Pragma("unroll") for (int m = 0; m < 4; ++m) _Pragma("unroll") for (int k = 0; k < 2; ++k) dst[m][k] = *(const PG8_LAS bf16x8*)(lds + PG8_SA(b, h) + aoff + m * 2048 + k * 1024); } while (0)
#define PG8_LDB(dst, b, h) do { _Pragma("unroll") for (int n = 0; n < 2; ++n) _Pragma("unroll") for (int k = 0; k < 2; ++k) dst[n][k] = *(const PG8_LAS bf16x8*)(lds + PG8_SB(b, h) + boff + n * 2048 + k * 1024); } while (0)
#define PG8_MMA(ai, bj, At, Bt) do { __builtin_amdgcn_s_setprio(1); _Pragma("unroll") for (int m = 0; m < 4; ++m) _Pragma("unroll") for (int n = 0; n < 2; ++n) _Pragma("unroll") for (int k = 0; k < 2; ++k) \
        acc[ai][bj][m][n] = __builtin_amdgcn_mfma_f32_16x16x32_bf16(Bt[n][k], At[m][k], acc[ai][bj][m][n], 0, 0, 0); __builtin_amdgcn_s_setprio(0); } while (0)
#define PG8_WAIT_V(n) asm volatile("s_waitcnt vmcnt(" #n ")" ::: "memory")
#define PG8_WAIT_L(n) asm volatile("s_waitcnt lgkmcnt(" #n ")" ::: "memory")
#define PG8_BAR __builtin_amdgcn_s_barrier()
#define PG8_SCHED __builtin_amdgcn_sched_barrier(0)
    Unit cur, nxt; int ui = 0;
    if (!S.next(0, cur)) return;
    f32x4 acc[2][2][4][2];
#pragma unroll
    for (int a = 0; a < 2; ++a)
#pragma unroll
        for (int b = 0; b < 2; ++b)
#pragma unroll
            for (int m = 0; m < 4; ++m)
#pragma unroll
                for (int n = 0; n < 2; ++n) acc[a][b][m][n] = (f32x4){0.f, 0.f, 0.f, 0.f};
    bf16x8 At[4][2], B0[2][2], B1[2][2];
    const char* cA = (const char*)g.A + (size_t)cur.pm * tstep; const char* cB = (const char*)g.Bt + (size_t)cur.pn * tstep;
    S.a_ready(cur);
    if constexpr (SP2) {
        PG8_STAGE(PG8_SB(0, 0), cB, voffB); PG8_STAGE(PG8_SB(0, 1), cB + hstep, voffB); PG8_STAGE(PG8_SA(0, 0), cA, voffA); PG8_STAGE(PG8_SA(0, 1), cA + hstep, voffA);
        if (wr == 1) PG8_BAR;
        PG8_WAIT_V(2); PG8_BAR;
        PG8_STAGE(PG8_SB(1, 0), cB + kstep, voffB); PG8_STAGE(PG8_SA(1, 0), cA + kstep, voffA); PG8_STAGE(PG8_SB(1, 1), cB + hstep + kstep, voffB);
        PG8_WAIT_V(6); PG8_BAR;
    } else {
        PG8_STAGE(PG8_SB(0, 0), cB, voffB); PG8_STAGE(PG8_SA(0, 0), cA, voffA); PG8_STAGE(PG8_SB(0, 1), cB + hstep, voffB); PG8_STAGE(PG8_SA(0, 1), cA + hstep, voffA);
        if (wr == 1) PG8_BAR;
        PG8_WAIT_V(4); PG8_BAR;
        PG8_STAGE(PG8_SB(1, 0), cB + kstep, voffB); PG8_STAGE(PG8_SA(1, 0), cA + kstep, voffA); PG8_STAGE(PG8_SB(1, 1), cB + hstep + kstep, voffB);
        PG8_WAIT_V(6); PG8_BAR;
    }
    for (;;) {
        const bool has_next = S.next(ui + 1, nxt);
        const char* nA = has_next ? (const char*)g.A + (size_t)nxt.pm * tstep : cA; const char* nB = has_next ? (const char*)g.Bt + (size_t)nxt.pn * tstep : cB;
        for (int t = 0; t < nt; t += 2) {
            const bool last = (t == nt - 2);
            const char* a1 = cA + (size_t)(t + 1) * kstep;
            const char* a2 = last ? nA : cA + (size_t)(t + 2) * kstep; const char* b2 = last ? nB : cB + (size_t)(t + 2) * kstep;
            const char* a3 = a2 + kstep; const char* b3 = b2 + kstep;
            if (last && has_next) S.a_ready(nxt);
            if constexpr (SP2) {
            PG8_LDB(B0, 0, 0); PG8_LDB(B1, 0, 1); PG8_SCHED; PG8_LDA(At, 0, 0); PG8_STAGE(PG8_SA(1, 1), a1 + hstep, voffA);
            PG8_WAIT_V(8); PG8_WAIT_L(0); PG8_BAR; PG8_MMA(0, 0, At, B0); PG8_MMA(0, 1, At, B1); PG8_BAR; PG8_SCHED;
            PG8_LDA(At, 0, 1); PG8_STAGE(PG8_SB(0, 0), b2, voffB); PG8_STAGE(PG8_SB(0, 1), b2 + hstep, voffB); PG8_STAGE(PG8_SA(0, 0), a2, voffA);
            PG8_WAIT_V(8); PG8_WAIT_L(0); PG8_BAR; PG8_MMA(1, 0, At, B0); PG8_MMA(1, 1, At, B1); PG8_BAR; PG8_SCHED;
            PG8_LDB(B0, 1, 0); PG8_LDB(B1, 1, 1); PG8_SCHED; PG8_LDA(At, 1, 0); PG8_STAGE(PG8_SA(0, 1), a2 + hstep, voffA);
            PG8_WAIT_V(8); PG8_WAIT_L(0); PG8_BAR; PG8_MMA(0, 0, At, B0); PG8_MMA(0, 1, At, B1); PG8_BAR; PG8_SCHED;
            PG8_LDA(At, 1, 1); PG8_STAGE(PG8_SB(1, 0), b3, voffB); PG8_STAGE(PG8_SB(1, 1), b3 + hstep, voffB); PG8_STAGE(PG8_SA(1, 0), a3, voffA);
            PG8_WAIT_V(8); PG8_WAIT_L(0); PG8_BAR; PG8_MMA(1, 0, At, B0); PG8_MMA(1, 1, At, B1); PG8_BAR; PG8_SCHED;
            } else {
            PG8_LDB(B0, 0, 0); PG8_SCHED; PG8_LDA(At, 0, 0); PG8_STAGE(PG8_SA(1, 1), a1 + hstep, voffA);
            PG8_WAIT_L(8); PG8_BAR; PG8_WAIT_L(0); PG8_MMA(0, 0, At, B0); PG8_BAR; PG8_SCHED;
            PG8_LDB(B1, 0, 1); PG8_STAGE(PG8_SB(0, 0), b2, voffB);
            PG8_BAR; PG8_WAIT_L(0); PG8_MMA(0, 1, At, B1); PG8_BAR;
            PG8_LDA(At, 0, 1); PG8_STAGE(PG8_SA(0, 0), a2, voffA);
            PG8_BAR; PG8_WAIT_L(0); PG8_MMA(1, 0, At, B0); PG8_BAR; PG8_SCHED;
            PG8_STAGE(PG8_SB(0, 1), b2 + hstep, voffB);
            PG8_WAIT_V(6); PG8_BAR; PG8_MMA(1, 1, At, B1); PG8_BAR;
            PG8_LDB(B0, 1, 0); PG8_SCHED; PG8_LDA(At, 1, 0); PG8_STAGE(PG8_SA(0, 1), a2 + hstep, voffA);
            PG8_WAIT_L(8); PG8_BAR; PG8_WAIT_L(0); PG8_MMA(0, 0, At, B0); PG8_BAR; PG8_SCHED;
            PG8_LDB(B1, 1, 1); PG8_STAGE(PG8_SB(1, 0), b3, voffB);
            PG8_BAR; PG8_WAIT_L(0); PG8_MMA(0, 1, At, B1); PG8_BAR;
            PG8_LDA(At, 1, 1); PG8_STAGE(PG8_SA(1, 0), a3, voffA);
            PG8_BAR; PG8_WAIT_L(0); PG8_MMA(1, 0, At, B0); PG8_BAR; PG8_SCHED;
            PG8_STAGE(PG8_SB(1, 1), b3 + hstep, voffB);
            PG8_WAIT_V(6); PG8_BAR; PG8_MMA(1, 1, At, B1); PG8_BAR;
            }
        }
        if constexpr (ALIGN_EPI) { if (wr == 0) PG8_BAR; }
        if constexpr (!Epi::AFTER_DRAIN) { E(acc, cur, wr, wc, fr, fq); S.done(cur); }
        if (!has_next) break;
#pragma unroll
        for (int a = 0; a < 2; ++a)
#pragma unroll
            for (int b = 0; b < 2; ++b)
#pragma unroll
                for (int m = 0; m < 4; ++m)
#pragma unroll
                    for (int n = 0; n < 2; ++n) acc[a][b][m][n] = (f32x4){0.f, 0.f, 0.f, 0.f};
        cur = nxt; cA = nA; cB = nB; ++ui;
        if constexpr (ALIGN_EPI) { if (wr == 1) PG8_BAR; }
    }
    PG8_WAIT_V(0);
    if constexpr (!ALIGN_EPI) { if (wr == 0) PG8_BAR; }
    PG8_BAR;
    if constexpr (Epi::AFTER_DRAIN) { E.fused(acc, cur, wr, wc, fr, fq, lds, wid, lane); S.done(cur); }
#undef PG8_SA
#undef PG8_SB
#undef PG8_STAGE
#undef PG8_LDA
#undef PG8_LDB
#undef PG8_MMA
#undef PG8_WAIT_V
#undef PG8_WAIT_L
#undef PG8_BAR
#undef PG8_SCHED
}
}
#define LAS __attribute__((address_space(3)))
#define DI __device__ __forceinline__
typedef unsigned short bf16_t;
typedef short bf16x8 __attribute__((ext_vector_type(8)));
typedef short s16x4 __attribute__((ext_vector_type(4)));
typedef float f32x2 __attribute__((ext_vector_type(2)));
typedef float f32x4 __attribute__((ext_vector_type(4)));
typedef float f32x16 __attribute__((ext_vector_type(16)));
typedef unsigned u32x4 __attribute__((ext_vector_type(4)));
typedef unsigned u32x2 __attribute__((ext_vector_type(2)));
#define MFMA32(a, b, c) __builtin_amdgcn_mfma_f32_32x32x16_bf16((a), (b), (c), 0, 0, 0)

constexpr int NPROMPT = 16384, NSAMP = 128, NVALID = NPROMPT + NSAMP, MP = 16640;
constexpr int DM = 1024, UC = 4096, DFF = 2816, INC = 4104;
constexpr float EPS = 1e-6f;
constexpr int LDS_BYTES = 147456;

constexpr size_t MiB = 1u << 20;
constexpr size_t WS_WIN = 0;
constexpr size_t WS_WOUT = 8 * MiB;
constexpr size_t WS_WCKV = 10 * MiB;
constexpr size_t WS_WCQ = 14 * MiB;
constexpr size_t WS_WCO = 16 * MiB;
constexpr size_t WS_WGU = 18 * MiB;
constexpr size_t WS_WDN = 29 * MiB;
constexpr size_t WS_MEMB = 35 * MiB;
constexpr size_t WS_KP = 39 * MiB;
constexpr size_t WS_VP = 43 * MiB;
constexpr size_t WS_SMALL = 47 * MiB; constexpr size_t WS_BAR = WS_SMALL + 896 * 1024;
constexpr size_t WS_BFA = 48 * MiB;
constexpr size_t WS_BFB = 81 * MiB;
constexpr size_t WS_BFC = 114 * MiB;
constexpr size_t WS_FA = 147 * MiB;
constexpr size_t WS_FB = 212 * MiB;
constexpr size_t WS_U = 277 * MiB;
constexpr size_t WS_END = 408 * MiB;
constexpr int SM_SS0 = 0, SM_RS1 = MP, SM_RS2 = 2 * MP, SM_RS3 = 3 * MP, SM_SSM = 4 * MP, SM_GATES = 4 * MP + 2048;

constexpr size_t O_YP = 0, O_YS = 16777216, O_MK = 16908288, O_MV = 19005440, O_CONVP = 21102592, O_CP = 21127168, O_NP = 21651456, O_MP = 21655552, O_SP = 21655584,
                 O_CONVS = 22179872, O_CS = 22573088, O_NS = 30961696, O_MS = 31027232, O_SS = 31027744, O_END = 39416352;

struct Params { const float* in[29]; float* out; unsigned char* ws; int ph_lo, ph_hi; };

DI unsigned f2bf(float f) { unsigned u = __builtin_bit_cast(unsigned, f); return (u + 0x7fffu + ((u >> 16) & 1u)) >> 16; }
DI unsigned pk2(float lo, float hi) { return f2bf(lo) | (f2bf(hi) << 16); }
DI float bf2f(unsigned h) { return __builtin_bit_cast(float, h << 16); }
DI float bflo(unsigned w) { return __builtin_bit_cast(float, w << 16); }
DI float bfhi(unsigned w) { return __builtin_bit_cast(float, w & 0xffff0000u); }
DI void unpack8(u32x4 w, float (&f)[8]) { f[0] = bflo(w.x); f[1] = bfhi(w.x); f[2] = bflo(w.y); f[3] = bfhi(w.y); f[4] = bflo(w.z); f[5] = bfhi(w.z); f[6] = bflo(w.w); f[7] = bfhi(w.w); }
DI u32x4 pack8(const float (&f)[8]) { u32x4 w; w.x = pk2(f[0], f[1]); w.y = pk2(f[2], f[3]); w.z = pk2(f[4], f[5]); w.w = pk2(f[6], f[7]); return w; }
DI float wave_sum(float v) {
#pragma unroll
    for (int o = 1; o < 64; o <<= 1) v += __shfl_xor(v, o);
    return v;
}
DI float wave_max(float v) {
#pragma unroll
    for (int o = 1; o < 64; o <<= 1) v = fmaxf(v, __shfl_xor(v, o));
    return v;
}
DI unsigned off_b(unsigned row, unsigned ch) { return 256u * row + 16u * (ch ^ (((row & 3u) << 2) | ((row >> 2) & 3u))); }
DI int crow(int i, int h) { return (i & 3) + 8 * (i >> 2) + 4 * h; }
DI void tr_read4(unsigned a0, unsigned a1, unsigned a2, unsigned a3, s16x4& r0, s16x4& r1, s16x4& r2, s16x4& r3) {
    asm volatile("ds_read_b64_tr_b16 %0, %4\n\tds_read_b64_tr_b16 %1, %5\n\tds_read_b64_tr_b16 %2, %6\n\tds_read_b64_tr_b16 %3, %7\n\ts_waitcnt lgkmcnt(0)"
                 : "=&v"(r0), "=&v"(r1), "=&v"(r2), "=&v"(r3) : "v"(a0), "v"(a1), "v"(a2), "v"(a3) : "memory");
}
DI bf16x8 cat4(s16x4 lo, s16x4 hi) { return __builtin_shufflevector(lo, hi, 0, 1, 2, 3, 4, 5, 6, 7); }
DI float sigmoidf_(float x) { return __builtin_amdgcn_rcpf(1.0f + __expf(-x)); }
DI float logsigmoidf_(float x) { return fminf(x, 0.f) - log1pf(__expf(-fabsf(x))); }
DI void sincos_red(float a, float& s, float& c) {
    const float n = rintf(a * 0.15915494309189535f);
    float r = fmaf(-n, 6.28125f, a); r = fmaf(-n, 1.9353071795864769e-3f, r);
    s = __sinf(r); c = __cosf(r);
}

struct TItem { const float* W; int ldw, K, c0, k0; bf16_t* WT; int r0; const float* gs; };
DI TItem p0_decode(const Params& p, int it) {
    unsigned char* ws = p.ws; TItem t;
    constexpr int I_IN = 16 * 64, I_SQ = 16 * 32, I_FF = 16 * 88;
    int r = it;
    if (r < 2 * I_IN) { const int half = r / I_IN; r -= half * I_IN; const int kb = r / 64, nb = r % 64;
        t.W = p.in[10]; t.ldw = INC; t.K = 1024; t.c0 = (half ? 2056 : 0) + 32 * nb; t.k0 = 64 * kb; t.WT = (bf16_t*)(ws + WS_WIN); t.r0 = half * 2048 + 32 * nb; t.gs = p.in[14]; return t; }
    r -= 2 * I_IN;
    if (r < 5 * I_SQ) { const int which = r / I_SQ; r -= which * I_SQ; const int kb = r / 32, nb = r % 32;
        t.ldw = 1024; t.K = 1024; t.c0 = 32 * nb; t.k0 = 64 * kb; t.r0 = 32 * nb;
        if (which == 0) { t.W = p.in[17]; t.WT = (bf16_t*)(ws + WS_WOUT); t.gs = nullptr; }
        else if (which == 1) { t.W = p.in[20]; t.WT = (bf16_t*)(ws + WS_WCKV); t.gs = p.in[19]; }
        else if (which == 2) { t.W = p.in[21]; t.WT = (bf16_t*)(ws + WS_WCKV); t.gs = p.in[19]; t.r0 += 1024; }
        else if (which == 3) { t.W = p.in[22]; t.WT = (bf16_t*)(ws + WS_WCQ); t.gs = p.in[18]; }
        else { t.W = p.in[23]; t.WT = (bf16_t*)(ws + WS_WCO); t.gs = nullptr; }
        return t; }
    r -= 5 * I_SQ;
    if (r < 2 * I_FF) { const int which = r / I_FF; r -= which * I_FF; const int kb = r / 88, nb = r % 88; const int n0 = 32 * nb;
        t.W = which ? p.in[26] : p.in[25]; t.ldw = DFF; t.K = 1024; t.c0 = n0; t.k0 = 64 * kb; t.WT = (bf16_t*)(ws + WS_WGU); t.r0 = 256 * (n0 >> 7) + (n0 & 127) + (which ? 128 : 0); t.gs = p.in[24]; return t; }
    r -= 2 * I_FF;
    { const int kb = r / 32, nb = r % 32; t.W = p.in[27]; t.ldw = 1024; t.K = DFF; t.c0 = 32 * nb; t.k0 = 64 * kb; t.WT = (bf16_t*)(ws + WS_WDN); t.r0 = 32 * nb; t.gs = nullptr; }
    return t;
}
DI void p0_item_load(const TItem& t, float (&v)[32], int lane) {
#pragma unroll
    for (int i = 0; i < 32; ++i) { const int kk = 2 * i + (lane >> 5); v[i] = t.W[(size_t)(t.k0 + kk) * t.ldw + t.c0 + (lane & 31)]; }
}
DI void p0_item_finish(const TItem& t, const float (&v)[32], LAS float* scr, int lane) {
#pragma unroll
    for (int i = 0; i < 32; ++i) { const int kk = 2 * i + (lane >> 5); float x = v[i]; if (t.gs) x *= t.gs[t.k0 + kk]; scr[kk * 33 + (lane & 31)] = x; }
    asm volatile("s_waitcnt lgkmcnt(0)" ::: "memory");
    const int c = lane & 7;
#pragma unroll
    for (int j = 0; j < 4; ++j) { const int n = (lane >> 3) + 8 * j; const LAS float* s = scr + (8 * c) * 33 + n;
        u32x4 o; o.x = pk2(s[0 * 33], s[1 * 33]); o.y = pk2(s[2 * 33], s[3 * 33]); o.z = pk2(s[4 * 33], s[5 * 33]); o.w = pk2(s[6 * 33], s[7 * 33]);
        *(u32x4*)(t.WT + (size_t)(t.r0 + n) * t.K + t.k0 + 8 * c) = o; }
    asm volatile("s_waitcnt lgkmcnt(0)" ::: "memory");
}
DI void p0_prologue(const Params& p, LAS unsigned char* lds) {
    const int tid = threadIdx.x, lane = tid & 63, wave = tid >> 6;
    unsigned char* ws = p.ws;
    float* sm = (float*)(ws + WS_SMALL);
    const float* w_in = p.in[10];
    const float* g_mix = p.in[14];
    LAS float* GW = (LAS float*)(lds + 69632);
    for (int i = tid; i < 8192; i += 512) { const int k = i >> 3, j = i & 7; GW[i] = g_mix[k] * w_in[(size_t)k * INC + 2048 + j]; }
    for (int i = blockIdx.x * 512 + tid; i < 3 * MP; i += gridDim.x * 512) sm[SM_RS1 + i] = 0.f;
    __syncthreads();
    const int gw = blockIdx.x * 8 + wave, NGW = gridDim.x * 8;
    LAS float* scr = (LAS float*)(lds + wave * 8448);
    const bool rows_first = ((blockIdx.x >> 3) & 1) != 0;
#pragma unroll 1
    for (int step = 0; step < 2; ++step) {
    if ((step == 0) != rows_first) {
    constexpr int NITEMS = 2 * (16 * 64) + 5 * (16 * 32) + 2 * (16 * 88) + 44 * 32;
#pragma unroll 1
    for (int it = gw; it < NITEMS; it += 2 * NGW) {
        const bool hasB = it + NGW < NITEMS;
        const TItem ta = p0_decode(p, it), tb = p0_decode(p, hasB ? it + NGW : it);
        float va[32], vb[32];
        p0_item_load(ta, va, lane); p0_item_load(tb, vb, lane);
        p0_item_finish(ta, va, scr, lane);
        if (hasB) p0_item_finish(tb, vb, scr, lane);
    }
    } else {
    const float* b_gate = p.in[11];
    constexpr int RB = 5, NROWS = NVALID + 2048, NGRP = (NROWS + RB - 1) / RB;
#pragma unroll 1
    for (int gi = gw; gi < NGRP; gi += NGW) {
        f32x4 v[RB][4];
#pragma unroll
        for (int r = 0; r < RB; ++r) { int m = gi * RB + r; if (m >= NROWS) m = NROWS - 1;
            const float* xr = (m >= NVALID) ? p.in[9] + (size_t)(m - NVALID) * DM : (m < NPROMPT ? p.in[0] + (size_t)m * DM : p.in[1] + (size_t)(m - NPROMPT) * DM);
#pragma unroll
            for (int j = 0; j < 4; ++j) v[r][j] = ((const f32x4*)xr)[64 * j + lane]; }
#pragma unroll
        for (int r = 0; r < RB; ++r) { const int m = gi * RB + r; if (m >= NROWS) continue;
            const bool ismem = m >= NVALID;
            bf16_t* orow = ismem ? (bf16_t*)(ws + WS_MEMB) + (size_t)(m - NVALID) * DM : (bf16_t*)(ws + WS_BFA) + (size_t)m * DM;
            float s = 0.f;
#pragma unroll
            for (int j = 0; j < 4; ++j) { s += (v[r][j].x * v[r][j].x + v[r][j].y * v[r][j].y) + (v[r][j].z * v[r][j].z + v[r][j].w * v[r][j].w);
                u32x2 w; w.x = pk2(v[r][j].x, v[r][j].y); w.y = pk2(v[r][j].z, v[r][j].w); ((u32x2*)orow)[64 * j + lane] = w; }
            s = wave_sum(s);
            if (ismem) { if (lane == 0) sm[SM_SSM + (m - NVALID)] = s; continue; }
            float g[8];
#pragma unroll
            for (int e = 0; e < 8; ++e) g[e] = 0.f;
#pragma unroll
            for (int j = 0; j < 4; ++j)
#pragma unroll
                for (int e = 0; e < 4; ++e) { const int k = 4 * (64 * j + lane) + e; const f32x4 a = *(const LAS f32x4*)(GW + 8 * k), bq = *(const LAS f32x4*)(GW + 8 * k + 4); const float xv = v[r][j][e];
                    g[0] += xv * a.x; g[1] += xv * a.y; g[2] += xv * a.z; g[3] += xv * a.w; g[4] += xv * bq.x; g[5] += xv * bq.y; g[6] += xv * bq.z; g[7] += xv * bq.w; }
#pragma unroll
            for (int e = 0; e < 8; ++e) g[e] = wave_sum(g[e]);
            const float rr = rsqrtf(s * (1.0f / 1024.0f) + EPS);
            if (lane == 0) { sm[SM_SS0 + m] = s;
#pragma unroll
                for (int e = 0; e < 8; ++e) sm[SM_GATES + (size_t)m * 8 + e] = g[e] * rr + b_gate[e]; }
        }
    }
    }
    }
}
#define LDS_BARRIER() do { asm volatile("s_waitcnt lgkmcnt(0)" ::: "memory"); __builtin_amdgcn_s_barrier(); asm volatile("" ::: "memory"); } while (0)
template <int PASS> DI void scan_prompt(const Params& p, LAS unsigned char* lds, int bh, int seg) {
    const int tid0 = threadIdx.x, wid = __builtin_amdgcn_readfirstlane(tid0 >> 6), wr = wid >> 1, wc = wid & 1;
    int tid = tid0, lane = tid & 63, hh = lane >> 5, l31 = lane & 31;
    const int b = bh >> 3, head8 = bh & 7, hd = head8 & 3; const bool ret = head8 >= 4;
    unsigned char* ws = p.ws;
    const bf16_t* U = (const bf16_t*)(ws + WS_U);
    bf16_t* HM = (bf16_t*)(ws + WS_BFB);
    const float* gates = (const float*)(ws + WS_SMALL) + SM_GATES;
    const int qcol = (ret ? 2048 : 0) + hd * 128, kcol = qcol + 512, vcol = qcol + 1024, gcol = qcol + 1536, ocol = head8 * 128;
    const float* ghead = (ret ? p.in[16] : p.in[15]) + hd * 128;
    LAS unsigned char* T0 = lds; LAS unsigned char* T1 = lds + 32768; LAS unsigned char* T2 = lds + 65536; LAS unsigned char* T3 = lds + 98304;
    LAS float* sb = (LAS float*)(lds + 131072);
    LAS float* sa = sb + 128;
    LAS float* sbm = sb + 256;
    LAS float* swin = sb + 384;
    LAS float* sem = sb + 512;
    LAS float* snq = sb + 640;
    LAS float* sws = sb + 768;
    LAS float* sn = sb + 896;
    LAS float* sinv = sb + 1024;
    LAS float* smisc = sb + 1152;
    const unsigned t1a = (unsigned)(uintptr_t)T1, t2a = (unsigned)(uintptr_t)T2;
    const float lg = log1pf(-exp2f(-5.0f - (float)hd));
    int blk = (lane >> 4) & 1, q4 = (lane & 15) >> 2, pp = lane & 3;
    for (int i = tid; i < 8192; i += 512) ((LAS unsigned*)T3)[i] = 0u;
    if (tid < 128) sn[tid] = 0.f;
    LAS float* scw = sb + 1344;
    if (!ret) for (int i = tid; i < 1280; i += 512) { const int which = i / 640, r = i % 640, j = r >> 7, c = r & 127, ci = which * 512 + hd * 128 + c; scw[i] = (j < 4) ? p.in[12][j * 1024 + ci] : p.in[13][ci]; }
    f32x16 accC[2];
#pragma unroll
    for (int c = 0; c < 2; ++c)
#pragma unroll
        for (int i = 0; i < 16; ++i) accC[c][i] = 0.f;
    float m_state = 0.f;
    LAS float* sbl = sb + 1280; LAS float* spm = sb + 1296; LAS float* smq = sb + 1312; LAS float* scf = sb + 1336;
    float* Lws = (float*)(ws + WS_FA); float* NLws = Lws + (size_t)64 * 3 * 16384;
    if (!ret) {
        for (int c = wid; c < 16; c += 8) { const float* gp = gates + ((size_t)b * 2048 + c * 128 + 2 * lane) * 8;
            const float i0 = gp[hd], i1 = gp[8 + hd], lf0 = logsigmoidf_(gp[4 + hd]), lf1 = logsigmoidf_(gp[12 + hd]);
            float incl = lf0 + lf1;
#pragma unroll
            for (int o = 1; o < 64; o <<= 1) { const float t = __shfl_up(incl, o); if (lane >= o) incl += t; }
            const float b1 = incl, b0 = incl - lf1, a0 = i0 - b0, a1 = i1 - b1;
            float pin = fmaxf(a0, a1);
#pragma unroll
            for (int o = 1; o < 64; o <<= 1) { const float t = __shfl_up(pin, o); if (lane >= o) pin = fmaxf(pin, t); }
            if (lane == 63) { sbl[c] = incl; spm[c] = pin; } }
    } else if (tid < 16) { sbl[tid] = 128.0f * lg; spm[tid] = 0.f; }
    __syncthreads();
    if (tid == 0) {
        float m = 0.f; smq[0] = 0.f;
        for (int c = 0; c < 16; ++c) { m = ret ? 0.f : sbl[c] + fmaxf(m, spm[c]); smq[c + 1] = m; }
        float run = 1.f;
        for (int i = seg - 1; i >= 0; --i) { scf[i] = run; const float sB = ret ? 512.0f * lg : (sbl[4 * i] + sbl[4 * i + 1]) + (sbl[4 * i + 2] + sbl[4 * i + 3]); run *= __expf(sB + smq[4 * i] - smq[4 * i + 4]); }
    }
    __syncthreads();
    m_state = smq[4 * seg];
    if constexpr (PASS == 2) {
        for (int i = 0; i < seg; ++i) { const float cf = scf[i]; const float* L = Lws + (size_t)(bh * 3 + i) * 16384;
#pragma unroll
            for (int c = 0; c < 2; ++c)
#pragma unroll
                for (int ii = 0; ii < 16; ++ii) accC[c][ii] += cf * L[(32 * wr + crow(ii, hh)) * 128 + 64 * wc + 32 * c + l31];
            if (tid < 128) sn[tid] += cf * NLws[(size_t)(bh * 3 + i) * 128 + tid]; }
#pragma unroll
        for (int c = 0; c < 2; ++c) { const int k_idx = 64 * wc + 32 * c + l31;
#pragma unroll
            for (int i = 0; i < 16; ++i) { const int v = 32 * wr + crow(i, hh); *(LAS unsigned short*)(T3 + off_b(v, k_idx >> 3) + 2 * (k_idx & 7)) = (unsigned short)f2bf(accC[c][i]); } }
    }
    __syncthreads();
    for (int ch = 4 * seg; ch < 4 * seg + 4; ++ch) {
        const int t0 = ch * 128; const size_t m0 = (size_t)b * 2048 + t0;
        tid = tid0; asm volatile("" : "+v"(tid)); lane = tid & 63; hh = lane >> 5; l31 = lane & 31; blk = (lane >> 4) & 1; q4 = (lane & 15) >> 2; pp = lane & 3;
        if (wid == 0) {
            float lf0, lf1, i0, i1;
            if (!ret) { const float* gp = gates + (m0 + 2 * lane) * 8; i0 = gp[hd]; i1 = gp[8 + hd]; lf0 = logsigmoidf_(gp[4 + hd]); lf1 = logsigmoidf_(gp[12 + hd]); }
            else { lf0 = lg; lf1 = lg; i0 = 0.f; i1 = 0.f; }
            float incl = lf0 + lf1;
#pragma unroll
            for (int o = 1; o < 64; o <<= 1) { const float t = __shfl_up(incl, o); if (lane >= o) incl += t; }
            const float b1 = incl, b0 = incl - lf1, a0 = i0 - b0, a1 = i1 - b1;
            float pin = fmaxf(a0, a1);
#pragma unroll
            for (int o = 1; o < 64; o <<= 1) { const float t = __shfl_up(pin, o); if (lane >= o) pin = fmaxf(pin, t); }
            float pex = __shfl_up(pin, 1); if (lane == 0) pex = -INFINITY;
            const float pm0 = fmaxf(pex, a0), pm1 = pin;
            const float mt0 = ret ? 0.f : b0 + fmaxf(m_state, pm0), mt1 = ret ? 0.f : b1 + fmaxf(m_state, pm1);
            const float bL = __shfl(incl, 63), pmL = __shfl(pin, 63);
            const float m_new = ret ? 0.f : bL + fmaxf(m_state, pmL);
            sb[2 * lane] = b0; sb[2 * lane + 1] = b1; sa[2 * lane] = a0; sa[2 * lane + 1] = a1;
            sbm[2 * lane] = b0 - mt0; sbm[2 * lane + 1] = b1 - mt1;
            swin[2 * lane] = __expf(b0 + m_state - mt0); swin[2 * lane + 1] = __expf(b1 + m_state - mt1);
            sem[2 * lane] = __expf(-mt0); sem[2 * lane + 1] = __expf(-mt1);
            sws[2 * lane] = __expf(bL + a0 - m_new); sws[2 * lane + 1] = __expf(bL + a1 - m_new);
            if (lane == 0) { smisc[0] = m_new; smisc[1] = __expf(bL + m_state - m_new); }
        }
        u32x4 vv[4];
#pragma unroll
        for (int i = 0; i < 4; ++i) { const int idx = tid + 512 * i, t = idx >> 4, c8 = idx & 15; vv[i] = *(const u32x4*)(U + (m0 + t) * UC + vcol + 8 * c8); }
        if (!ret) {
            const int c8 = tid & 15, tq = tid >> 4;
            u32x4 xq[7], xk[7];
#pragma unroll
            for (int j = 0; j < 7; ++j) { const int rr = 4 * tq - 3 + j; const size_t row = (t0 + rr >= 0) ? (m0 + rr) : m0;
                if constexpr (PASS == 2) xq[j] = *(const u32x4*)(U + row * UC + qcol + 8 * c8);
                xk[j] = *(const u32x4*)(U + row * UC + kcol + 8 * c8); }
#pragma unroll
            for (int which = (PASS == 1 ? 1 : 0); which < 2; ++which) {
                const float scl = which ? 0.08838834764831845f : 1.0f; LAS unsigned char* T = which ? T1 : T0;
                const LAS float* cw = scw + which * 640 + 8 * c8;
                float wv[4][8], bc[8];
#pragma unroll
                for (int j = 0; j < 4; ++j) { const f32x4 a = *(const LAS f32x4*)(cw + j * 128), bq = *(const LAS f32x4*)(cw + j * 128 + 4);
                    wv[j][0] = a.x; wv[j][1] = a.y; wv[j][2] = a.z; wv[j][3] = a.w; wv[j][4] = bq.x; wv[j][5] = bq.y; wv[j][6] = bq.z; wv[j][7] = bq.w; }
                { const f32x4 a = *(const LAS f32x4*)(cw + 512), bq = *(const LAS f32x4*)(cw + 516); bc[0] = a.x; bc[1] = a.y; bc[2] = a.z; bc[3] = a.w; bc[4] = bq.x; bc[5] = bq.y; bc[6] = bq.z; bc[7] = bq.w; }
#pragma unroll
                for (int i = 0; i < 4; ++i) { const int t = 4 * tq + i;
                    float o[8];
#pragma unroll
                    for (int e = 0; e < 8; ++e) o[e] = bc[e];
#pragma unroll
                    for (int j = 0; j < 4; ++j) { const float msk = (t0 + t - 3 + j >= 0) ? 1.0f : 0.0f; float x[8]; unpack8(which ? xk[i + j] : xq[i + j], x);
#pragma unroll
                        for (int e = 0; e < 8; ++e) o[e] += (wv[j][e] * msk) * x[e]; }
#pragma unroll
                    for (int e = 0; e < 8; ++e) o[e] = o[e] * sigmoidf_(o[e]) * scl;
                    *(LAS u32x4*)(T + off_b(t, c8)) = pack8(o); }
            }
        } else {
            u32x4 rl[2][2], rh[2][2];
#pragma unroll
            for (int which = (PASS == 1 ? 1 : 0); which < 2; ++which)
#pragma unroll
                for (int i = 0; i < 2; ++i) { const int idx = tid + 512 * i, t = idx >> 3, c8 = idx & 7; const int ucol = which ? kcol : qcol;
                    rl[which][i] = *(const u32x4*)(U + (m0 + t) * UC + ucol + 8 * c8); rh[which][i] = *(const u32x4*)(U + (m0 + t) * UC + ucol + 64 + 8 * c8); }
#pragma unroll
            for (int which = (PASS == 1 ? 1 : 0); which < 2; ++which) {
                const float scl = which ? 0.08838834764831845f : 1.0f; LAS unsigned char* T = which ? T1 : T0;
#pragma unroll
                for (int i = 0; i < 2; ++i) { const int idx = tid + 512 * i, t = idx >> 3, c8 = idx & 7;
                    float x1[8], x2[8], o1[8], o2[8]; unpack8(rl[which][i], x1); unpack8(rh[which][i], x2); const float pos = (float)(t0 + t);
#pragma unroll
                    for (int e = 0; e < 8; ++e) { const float inv = exp2f(-(float)(8 * c8 + e) * 0.20762050593046014f); float sn_, cs_; sincos_red(pos * inv, sn_, cs_);
                        o1[e] = (x1[e] * cs_ - x2[e] * sn_) * scl; o2[e] = (x2[e] * cs_ + x1[e] * sn_) * scl; }
                    *(LAS u32x4*)(T + off_b(t, c8)) = pack8(o1); *(LAS u32x4*)(T + off_b(t, c8 + 8)) = pack8(o2); }
            }
        }
#pragma unroll
        for (int i = 0; i < 4; ++i) { const int idx = tid + 512 * i, t = idx >> 4, c8 = idx & 15; *(LAS u32x4*)(T2 + off_b(t, c8)) = vv[i]; }
        LDS_BARRIER();
        const float m_new = smisc[0], carry = smisc[1];
        if constexpr (PASS == 2) {
        { const int t = tid >> 2, part = tid & 3; float d = 0.f;
#pragma unroll
            for (int cc = 0; cc < 4; ++cc) { const int c8 = 4 * part + cc; float x[8]; unpack8(*(const LAS u32x4*)(T0 + off_b(t, c8)), x);
#pragma unroll
                for (int e = 0; e < 8; ++e) d += x[e] * sn[8 * c8 + e]; }
            d += __shfl_xor(d, 1); d += __shfl_xor(d, 2); if (part == 0) snq[t] = d; }
        f32x16 aS[2], aN[2];
#pragma unroll
        for (int c = 0; c < 2; ++c)
#pragma unroll
            for (int i = 0; i < 16; ++i) { aS[c][i] = 0.f; aN[c][i] = 0.f; }
#pragma unroll
        for (int s = 0; s < 8; ++s) { const bf16x8 A = *(const LAS bf16x8*)(T0 + off_b(32 * wr + l31, 2 * s + hh));
#pragma unroll
            for (int c = 0; c < 2; ++c) { const bf16x8 B = *(const LAS bf16x8*)(T1 + off_b(64 * wc + 32 * c + l31, 2 * s + hh)); aS[c] = MFMA32(A, B, aS[c]);
                const bf16x8 B2 = *(const LAS bf16x8*)(T3 + off_b(64 * wc + 32 * c + l31, 2 * s + hh)); aN[c] = MFMA32(A, B2, aN[c]); } }
#pragma unroll
        for (int c = 0; c < 2; ++c) { const int s_idx = 64 * wc + 32 * c + l31; const float a_s = sa[s_idx];
#pragma unroll
            for (int i = 0; i < 16; ++i) { const int t = 32 * wr + crow(i, hh); const float w = __expf(fminf(sbm[t] + a_s, 0.f)) * aS[c][i]; aS[c][i] = (s_idx <= t) ? w : 0.f; aN[c][i] *= swin[t]; } }
        LDS_BARRIER();
#pragma unroll
        for (int c = 0; c < 2; ++c) { const int s_idx = 64 * wc + 32 * c + l31;
#pragma unroll
            for (int i = 0; i < 16; ++i) { const int t = 32 * wr + crow(i, hh); *(LAS unsigned short*)(T0 + off_b(t, s_idx >> 3) + 2 * (s_idx & 7)) = (unsigned short)f2bf(aS[c][i]); } }
        LDS_BARRIER();
#pragma unroll
        for (int ks = 0; ks < 8; ++ks) { const bf16x8 A = *(const LAS bf16x8*)(T0 + off_b(32 * wr + l31, 2 * ks + hh));
            s16x4 r0, r1, r2, r3; const int rowb = 16 * ks + 8 * hh + q4; const int cg0 = 2 * wc, cg1 = 2 * wc + 1;
            tr_read4(t2a + off_b(rowb, 4 * cg0 + 2 * blk + (pp >> 1)) + 8 * (pp & 1), t2a + off_b(rowb + 4, 4 * cg0 + 2 * blk + (pp >> 1)) + 8 * (pp & 1),
                     t2a + off_b(rowb, 4 * cg1 + 2 * blk + (pp >> 1)) + 8 * (pp & 1), t2a + off_b(rowb + 4, 4 * cg1 + 2 * blk + (pp >> 1)) + 8 * (pp & 1), r0, r1, r2, r3);
            aN[0] = MFMA32(A, cat4(r0, r1), aN[0]); aN[1] = MFMA32(A, cat4(r2, r3), aN[1]); }
        { const int t = tid >> 2, part = tid & 3; float d = 0.f;
#pragma unroll
            for (int cc = 0; cc < 4; ++cc) { float x[8]; unpack8(*(const LAS u32x4*)(T0 + off_b(t, 4 * part + cc)), x);
#pragma unroll
                for (int e = 0; e < 8; ++e) d += x[e]; }
            d += __shfl_xor(d, 1); d += __shfl_xor(d, 2);
            if (part == 0) { const float den = d + swin[t] * snq[t]; sinv[t] = ret ? 1.0f : __builtin_amdgcn_rcpf(fmaxf(fabsf(den), sem[t])); } }
        LDS_BARRIER();
#pragma unroll
        for (int c = 0; c < 2; ++c) { const int v_idx = 64 * wc + 32 * c + l31;
#pragma unroll
            for (int i = 0; i < 16; ++i) { const int t = 32 * wr + crow(i, hh); *(LAS unsigned short*)(T0 + off_b(t, v_idx >> 3) + 2 * (v_idx & 7)) = (unsigned short)f2bf(aN[c][i] * sinv[t]); } }
        LDS_BARRIER();
        { const int t = tid >> 2, part = tid & 3; float ss = 0.f;
#pragma unroll
            for (int cc = 0; cc < 4; ++cc) { float x[8]; unpack8(*(const LAS u32x4*)(T0 + off_b(t, 4 * part + cc)), x);
#pragma unroll
                for (int e = 0; e < 8; ++e) ss += x[e] * x[e]; }
            ss += __shfl_xor(ss, 1); ss += __shfl_xor(ss, 2);
            const float rn = rsqrtf(ss * (1.0f / 128.0f) + EPS);
#pragma unroll
            for (int cc = 0; cc < 4; ++cc) { const int c8 = 4 * part + cc; float x[8], gt[8], o[8]; unpack8(*(const LAS u32x4*)(T0 + off_b(t, c8)), x);
                unpack8(*(const u32x4*)(U + (m0 + t) * UC + gcol + 8 * c8), gt);
#pragma unroll
                for (int e = 0; e < 8; ++e) { const float sg = sigmoidf_(gt[e]); o[e] = x[e] * rn * ghead[8 * c8 + e] * (ret ? gt[e] * sg : sg); }
                *(u32x4*)(HM + (m0 + t) * DM + ocol + 8 * c8) = pack8(o); } }
        }
        { const int s = tid >> 2, part = tid & 3; const float w = sws[s];
#pragma unroll
            for (int cc = 0; cc < 4; ++cc) { LAS u32x4* ptr = (LAS u32x4*)(T1 + off_b(s, 4 * part + cc)); float x[8]; unpack8(*ptr, x);
#pragma unroll
                for (int e = 0; e < 8; ++e) x[e] *= w;
                *ptr = pack8(x); } }
        if (!ret && tid < 128) sn[tid] *= carry;
        LDS_BARRIER();
#pragma unroll
        for (int c = 0; c < 2; ++c)
#pragma unroll
            for (int i = 0; i < 16; ++i) accC[c][i] *= carry;
#pragma unroll
        for (int ks = 0; ks < 8; ++ks) { const int rowb = 16 * ks + 8 * hh + q4; const int cg0 = 2 * wc, cg1 = 2 * wc + 1;
            s16x4 a0, a1, d0, d1, r0, r1, r2, r3;
            tr_read4(t2a + off_b(rowb, 4 * wr + 2 * blk + (pp >> 1)) + 8 * (pp & 1), t2a + off_b(rowb + 4, 4 * wr + 2 * blk + (pp >> 1)) + 8 * (pp & 1),
                     t1a + off_b(rowb, 4 * cg0 + 2 * blk + (pp >> 1)) + 8 * (pp & 1), t1a + off_b(rowb + 4, 4 * cg0 + 2 * blk + (pp >> 1)) + 8 * (pp & 1), a0, a1, r0, r1);
            tr_read4(t1a + off_b(rowb, 4 * cg1 + 2 * blk + (pp >> 1)) + 8 * (pp & 1), t1a + off_b(rowb + 4, 4 * cg1 + 2 * blk + (pp >> 1)) + 8 * (pp & 1),
                     t1a + off_b(rowb, 4 * cg1 + 2 * blk + (pp >> 1)) + 8 * (pp & 1), t1a + off_b(rowb + 4, 4 * cg1 + 2 * blk + (pp >> 1)) + 8 * (pp & 1), r2, r3, d0, d1);
            const bf16x8 A = cat4(a0, a1);
            accC[0] = MFMA32(A, cat4(r0, r1), accC[0]); accC[1] = MFMA32(A, cat4(r2, r3), accC[1]); }
        if (!ret) { const int kcol_ = tid & 127, r0 = 32 * (tid >> 7); float s = 0.f;
#pragma unroll 8
            for (int r = 0; r < 32; ++r) s += bf2f(*(const LAS unsigned short*)(T1 + off_b(r0 + r, kcol_ >> 3) + 2 * (kcol_ & 7)));
            atomicAdd((float*)(sn + kcol_), s); }
        if constexpr (PASS == 2) {
#pragma unroll
        for (int c = 0; c < 2; ++c) { const int k_idx = 64 * wc + 32 * c + l31;
#pragma unroll
            for (int i = 0; i < 16; ++i) { const int v = 32 * wr + crow(i, hh); *(LAS unsigned short*)(T3 + off_b(v, k_idx >> 3) + 2 * (k_idx & 7)) = (unsigned short)f2bf(accC[c][i]); } }
        }
        m_state = m_new;
        LDS_BARRIER();
    }
    float* out = p.out;
    if constexpr (PASS == 1) {
        float* L = Lws + (size_t)(bh * 3 + seg) * 16384;
#pragma unroll
        for (int c = 0; c < 2; ++c)
#pragma unroll
            for (int ii = 0; ii < 16; ++ii) L[(32 * wr + crow(ii, hh)) * 128 + 64 * wc + 32 * c + l31] = accC[c][ii];
        if (tid < 128) NLws[(size_t)(bh * 3 + seg) * 128 + tid] = sn[tid];
        __syncthreads();
        return;
    }
    if (seg != 3) { __syncthreads(); return; }
#pragma unroll
    for (int c = 0; c < 2; ++c) { const int k_idx = 64 * wc + 32 * c + l31;
#pragma unroll
        for (int i = 0; i < 16; ++i) { const int v = 32 * wr + crow(i, hh);
            if (!ret) out[O_CP + ((size_t)(b * 4 + hd) * 128 + v) * 128 + k_idx] = accC[c][i];
            else out[O_SP + ((size_t)(b * 4 + hd) * 128 + k_idx) * 128 + v] = accC[c][i]; } }
    if (!ret) { if (tid < 128) out[O_NP + (size_t)(b * 4 + hd) * 128 + tid] = sn[tid]; if (tid == 0) out[O_MP + b * 4 + hd] = m_state; }
    __syncthreads();
}
DI void scan_sample_block(const Params& p, LAS unsigned char* lds, int item) {
    const int tid = threadIdx.x, lane = tid & 63, wid = tid >> 6;
    const int b = item >> 3, head8 = item & 7, hd = head8 & 3; const bool ret = head8 >= 4;
    unsigned char* ws = p.ws; float* out = p.out;
    const size_t m = (size_t)NPROMPT + b;
    const bf16_t* ur = (const bf16_t*)(ws + WS_U) + m * UC;
    bf16_t* HM = (bf16_t*)(ws + WS_BFB) + m * DM;
    const float* gates = (const float*)(ws + WS_SMALL) + SM_GATES + m * 8;
    LAS float* sq = (LAS float*)lds; LAS float* sk = sq + 128; LAS float* sv = sq + 256; LAS float* sred = sq + 384; LAS float* spart = sq + 1024;
    const int part = tid & 3;
    if (!ret) {
        const float* C0 = p.in[5] + (size_t)(b * 4 + hd) * 16384 + (tid >> 2) * 128 + 32 * part;
        f32x4 cr[8];
#pragma unroll
        for (int j = 0; j < 8; ++j) cr[j] = ((const f32x4*)C0)[j];
        if (tid < 128) { const float* w_conv = p.in[12]; const float* b_conv = p.in[13]; const float* cst = p.in[4] + (size_t)b * 3 * 1024;
            const int cq = hd * 128 + tid, ck = 512 + cq;
            const float aq = b_conv[cq] + w_conv[cq] * cst[cq] + w_conv[1024 + cq] * cst[1024 + cq] + w_conv[2048 + cq] * cst[2048 + cq] + w_conv[3072 + cq] * bf2f(ur[cq]);
            const float ak = b_conv[ck] + w_conv[ck] * cst[ck] + w_conv[1024 + ck] * cst[1024 + ck] + w_conv[2048 + ck] * cst[2048 + ck] + w_conv[3072 + ck] * bf2f(ur[ck]);
            sq[tid] = aq * sigmoidf_(aq); sk[tid] = ak * sigmoidf_(ak) * 0.08838834764831845f; sv[tid] = bf2f(ur[1024 + hd * 128 + tid]); }
        __syncthreads();
        const int v = tid >> 2;
        float* C1 = out + O_CS + (size_t)(b * 4 + hd) * 16384 + v * 128 + 32 * part;
        const float* n0 = p.in[6] + (size_t)(b * 4 + hd) * 128;
        float qk = 0.f, nq = 0.f, cq = 0.f;
        f32x4 qv[8], kv[8];
#pragma unroll
        for (int j = 0; j < 8; ++j) { qv[j] = *(const LAS f32x4*)(sq + 32 * part + 4 * j); kv[j] = *(const LAS f32x4*)(sk + 32 * part + 4 * j); const f32x4 nn = *(const f32x4*)(n0 + 32 * part + 4 * j);
            qk += (qv[j].x * kv[j].x + qv[j].y * kv[j].y) + (qv[j].z * kv[j].z + qv[j].w * kv[j].w); nq += (qv[j].x * nn.x + qv[j].y * nn.y) + (qv[j].z * nn.z + qv[j].w * nn.w);
            cq += (qv[j].x * cr[j].x + qv[j].y * cr[j].y) + (qv[j].z * cr[j].z + qv[j].w * cr[j].w); }
        qk += __shfl_xor(qk, 1); qk += __shfl_xor(qk, 2); nq += __shfl_xor(nq, 1); nq += __shfl_xor(nq, 2); cq += __shfl_xor(cq, 1); cq += __shfl_xor(cq, 2);
        const float ig = gates[hd], lf = logsigmoidf_(gates[4 + hd]), m0s = p.in[7][b * 4 + hd];
        const float mt = fmaxf(lf + m0s, ig), wts_e = __expf(ig - mt), win = __expf(lf + m0s - mt);
        const float wts = wts_e * qk, den = wts + win * nq, dinv = 1.0f / fmaxf(fabsf(den), __expf(-mt));
        const float vv = sv[v], hv = (wts * vv + win * cq) * dinv, wv = wts_e * vv;
#pragma unroll
        for (int j = 0; j < 8; ++j) ((f32x4*)C1)[j] = cr[j] * win + kv[j] * wv;
        if (tid < 128) out[O_NS + (size_t)(b * 4 + hd) * 128 + tid] = win * n0[tid] + wts_e * sk[tid];
        if (tid == 0) out[O_MS + b * 4 + hd] = mt;
        float ss = (part == 0) ? hv * hv : 0.f; ss = wave_sum(ss);
        if (lane == 0) sred[wid] = ss;
        __syncthreads();
        const float tot = ((sred[0] + sred[1]) + (sred[2] + sred[3])) + ((sred[4] + sred[5]) + (sred[6] + sred[7]));
        const float rn = rsqrtf(tot * (1.0f / 128.0f) + EPS);
        if (part == 0) HM[hd * 128 + v] = (bf16_t)f2bf(hv * rn * p.in[15][hd * 128 + v] * sigmoidf_(bf2f(ur[1536 + hd * 128 + v])));
    } else {
        const int qc = 2048 + hd * 128;
        const float* S0 = p.in[8] + (size_t)(b * 4 + hd) * 16384 + (8 * (tid >> 5)) * 128 + 4 * (tid & 31);
        f32x4 sr[8];
#pragma unroll
        for (int j = 0; j < 8; ++j) sr[j] = *(const f32x4*)(S0 + j * 128);
        if (tid < 64) { float sn_, cs_; const float inv = exp2f(-(float)tid * 0.20762050593046014f); sincos_red(16384.0f * inv, sn_, cs_);
            const float xq1 = bf2f(ur[qc + tid]), xq2 = bf2f(ur[qc + 64 + tid]), xk1 = bf2f(ur[qc + 512 + tid]), xk2 = bf2f(ur[qc + 576 + tid]);
            sq[tid] = xq1 * cs_ - xq2 * sn_; sq[tid + 64] = xq2 * cs_ + xq1 * sn_;
            sk[tid] = (xk1 * cs_ - xk2 * sn_) * 0.08838834764831845f; sk[tid + 64] = (xk2 * cs_ + xk1 * sn_) * 0.08838834764831845f; }
        else if (tid < 192) sv[tid - 64] = bf2f(ur[qc + 1024 + tid - 64]);
        __syncthreads();
        const int kg = tid >> 5, v4 = tid & 31;
        float* S1 = out + O_SS + (size_t)(b * 4 + hd) * 16384 + (8 * kg) * 128 + 4 * v4;
        float qk = 0.f;
#pragma unroll
        for (int j = 0; j < 32; ++j) qk += sq[32 * part + j] * sk[32 * part + j];
        qk += __shfl_xor(qk, 1); qk += __shfl_xor(qk, 2);
        const float gamma = 1.0f - exp2f(-5.0f - (float)hd);
        const f32x4 vv4 = *(const LAS f32x4*)(sv + 4 * v4);
        f32x4 a4 = {0.f, 0.f, 0.f, 0.f};
#pragma unroll
        for (int j = 0; j < 8; ++j) { const float qj = sq[8 * kg + j], kj = sk[8 * kg + j]; a4 += sr[j] * qj; *(f32x4*)(S1 + j * 128) = sr[j] * gamma + vv4 * kj; }
        *(LAS f32x4*)(spart + kg * 128 + 4 * v4) = a4;
        __syncthreads();
        float o = 0.f, ss = 0.f;
        if (tid < 128) { float a = 0.f;
#pragma unroll
            for (int g = 0; g < 16; ++g) a += spart[g * 128 + tid];
            o = qk * sv[tid] + gamma * a; ss = o * o; }
        ss = wave_sum(ss);
        if (lane == 0) sred[wid] = ss;
        __syncthreads();
        const float rn = rsqrtf((sred[0] + sred[1]) * (1.0f / 128.0f) + EPS);
        if (tid < 128) { const float g0 = bf2f(ur[qc + 1536 + tid]); HM[512 + hd * 128 + tid] = (bf16_t)f2bf(o * rn * p.in[16][hd * 128 + tid] * g0 * sigmoidf_(g0)); }
    }
    __syncthreads();
}
DI void scan_sample_two(const Params& p, LAS unsigned char* lds, int item0) {
    constexpr int NI = 2;
    const int tid = threadIdx.x, lane = tid & 63, wid = tid >> 6, part = tid & 3;
    const int head8 = item0 & 7, hd = head8 & 3; const bool ret = head8 >= 4;
    unsigned char* ws = p.ws; float* out = p.out;
    LAS float* fb = (LAS float*)lds;
    int bb[NI]; const bf16_t* ur[NI]; bf16_t* HM[NI];
#pragma unroll
    for (int i = 0; i < NI; ++i) { bb[i] = (item0 >> 3) + 32 * i; const size_t m = (size_t)NPROMPT + bb[i]; ur[i] = (const bf16_t*)(ws + WS_U) + m * UC; HM[i] = (bf16_t*)(ws + WS_BFB) + m * DM; }
    if (!ret) {
        f32x4 cr[NI][8]; float g_i[NI], g_f[NI], m0s[NI], n0t[NI], mov[NI];
        float cin[NI][9];
        const int cq = hd * 128 + (tid & 127), ck = 512 + cq;
#pragma unroll
        for (int i = 0; i < NI; ++i) { const float* C0 = p.in[5] + (size_t)(bb[i] * 4 + hd) * 16384 + (tid >> 2) * 128 + 32 * part;
#pragma unroll
            for (int j = 0; j < 8; ++j) cr[i][j] = ((const f32x4*)C0)[j];
            const float* gates = (const float*)(ws + WS_SMALL) + SM_GATES + ((size_t)NPROMPT + bb[i]) * 8;
            g_i[i] = gates[hd]; g_f[i] = gates[4 + hd]; m0s[i] = p.in[7][bb[i] * 4 + hd]; n0t[i] = p.in[6][(size_t)(bb[i] * 4 + hd) * 128 + (tid & 127)];
            mov[i] = bf2f(ur[i][1536 + hd * 128 + (tid >> 2)]);
            const float* cst = p.in[4] + (size_t)bb[i] * 3 * 1024;
            cin[i][0] = cst[cq]; cin[i][1] = cst[1024 + cq]; cin[i][2] = cst[2048 + cq]; cin[i][3] = bf2f(ur[i][cq]);
            cin[i][4] = cst[ck]; cin[i][5] = cst[1024 + ck]; cin[i][6] = cst[2048 + ck]; cin[i][7] = bf2f(ur[i][ck]); cin[i][8] = bf2f(ur[i][1024 + hd * 128 + (tid & 127)]); }
        const float* w_conv = p.in[12]; const float* b_conv = p.in[13];
        const float wq0 = w_conv[cq], wq1 = w_conv[1024 + cq], wq2 = w_conv[2048 + cq], wq3 = w_conv[3072 + cq], bq_ = b_conv[cq];
        const float wk0 = w_conv[ck], wk1 = w_conv[1024 + ck], wk2 = w_conv[2048 + ck], wk3 = w_conv[3072 + ck], bk_ = b_conv[ck];
        const float ghv = p.in[15][hd * 128 + (tid >> 2)];
        if (tid < 128) {
#pragma unroll
            for (int i = 0; i < NI; ++i) { LAS float* f = fb + 512 * i;
                const float aq = bq_ + wq0 * cin[i][0] + wq1 * cin[i][1] + wq2 * cin[i][2] + wq3 * cin[i][3];
                const float ak = bk_ + wk0 * cin[i][4] + wk1 * cin[i][5] + wk2 * cin[i][6] + wk3 * cin[i][7];
                f[tid] = aq * sigmoidf_(aq); f[128 + tid] = ak * sigmoidf_(ak) * 0.08838834764831845f; f[256 + tid] = cin[i][8]; f[384 + tid] = n0t[i]; } }
        LDS_BARRIER();
        const int v = tid >> 2; float hv[NI];
#pragma unroll
        for (int i = 0; i < NI; ++i) { const LAS float* f = fb + 512 * i;
            float* C1 = out + O_CS + (size_t)(bb[i] * 4 + hd) * 16384 + v * 128 + 32 * part;
            float qk = 0.f, nq = 0.f, cqs = 0.f; f32x4 kv[8];
#pragma unroll
            for (int j = 0; j < 8; ++j) { const f32x4 qv = *(const LAS f32x4*)(f + 32 * part + 4 * j); kv[j] = *(const LAS f32x4*)(f + 128 + 32 * part + 4 * j); const f32x4 nn = *(const LAS f32x4*)(f + 384 + 32 * part + 4 * j);
                qk += (qv.x * kv[j].x + qv.y * kv[j].y) + (qv.z * kv[j].z + qv.w * kv[j].w); nq += (qv.x * nn.x + qv.y * nn.y) + (qv.z * nn.z + qv.w * nn.w);
                cqs += (qv.x * cr[i][j].x + qv.y * cr[i][j].y) + (qv.z * cr[i][j].z + qv.w * cr[i][j].w); }
            qk += __shfl_xor(qk, 1); qk += __shfl_xor(qk, 2); nq += __shfl_xor(nq, 1); nq += __shfl_xor(nq, 2); cqs += __shfl_xor(cqs, 1); cqs += __shfl_xor(cqs, 2);
            const float ig = g_i[i], lf = logsigmoidf_(g_f[i]);
            const float mt = fmaxf(lf + m0s[i], ig), wts_e = __expf(ig - mt), win = __expf(lf + m0s[i] - mt);
            const float wts = wts_e * qk, den = wts + win * nq, dinv = 1.0f / fmaxf(fabsf(den), __expf(-mt));
            const float vv = f[256 + v], wv = wts_e * vv; hv[i] = (wts * vv + win * cqs) * dinv;
#pragma unroll
            for (int j = 0; j < 8; ++j) ((f32x4*)C1)[j] = cr[i][j] * win + kv[j] * wv;
            if (tid < 128) out[O_NS + (size_t)(bb[i] * 4 + hd) * 128 + tid] = win * n0t[i] + wts_e * f[128 + tid];
            if (tid == 0) out[O_MS + bb[i] * 4 + hd] = mt;
            float ss = (part == 0) ? hv[i] * hv[i] : 0.f; ss = wave_sum(ss);
            if (lane == 0) fb[1024 + 8 * i + wid] = ss; }
        LDS_BARRIER();
#pragma unroll
        for (int i = 0; i < NI; ++i) { const LAS float* sr_ = fb + 1024 + 8 * i;
            const float tot = ((sr_[0] + sr_[1]) + (sr_[2] + sr_[3])) + ((sr_[4] + sr_[5]) + (sr_[6] + sr_[7]));
            const float rn = rsqrtf(tot * (1.0f / 128.0f) + EPS);
            if (part == 0) HM[i][hd * 128 + v] = (bf16_t)f2bf(hv[i] * rn * ghv * sigmoidf_(mov[i])); }
    } else {
        const int qc = 2048 + hd * 128, kg = tid >> 5, v4 = tid & 31;
        f32x4 sr[NI][8]; float rin[NI][5], rgv[NI];
#pragma unroll
        for (int i = 0; i < NI; ++i) { const float* S0 = p.in[8] + (size_t)(bb[i] * 4 + hd) * 16384 + (8 * kg) * 128 + 4 * v4;
#pragma unroll
            for (int j = 0; j < 8; ++j) sr[i][j] = *(const f32x4*)(S0 + j * 128);
            rgv[i] = bf2f(ur[i][qc + 1536 + (tid & 127)]);
            const int l6 = tid & 63;
            rin[i][0] = bf2f(ur[i][qc + l6]); rin[i][1] = bf2f(ur[i][qc + 64 + l6]); rin[i][2] = bf2f(ur[i][qc + 512 + l6]); rin[i][3] = bf2f(ur[i][qc + 576 + l6]); rin[i][4] = bf2f(ur[i][qc + 1024 + (tid & 127)]); }
        const float ghr = p.in[16][hd * 128 + (tid & 127)];
        if (tid < 64) { float sn_, cs_; const float inv = exp2f(-(float)tid * 0.20762050593046014f); sincos_red(16384.0f * inv, sn_, cs_);
#pragma unroll
            for (int i = 0; i < NI; ++i) { LAS float* f = fb + 512 * i;
                f[tid] = rin[i][0] * cs_ - rin[i][1] * sn_; f[tid + 64] = rin[i][1] * cs_ + rin[i][0] * sn_;
                f[128 + tid] = (rin[i][2] * cs_ - rin[i][3] * sn_) * 0.08838834764831845f; f[128 + tid + 64] = (rin[i][3] * cs_ + rin[i][2] * sn_) * 0.08838834764831845f; } }
        if (tid >= 128 && tid < 256) {
#pragma unroll
            for (int i = 0; i < NI; ++i) fb[512 * i + 256 + (tid & 127)] = rin[i][4]; }
        LDS_BARRIER();
        const float gamma = 1.0f - exp2f(-5.0f - (float)hd);
        float qk[NI];
#pragma unroll
        for (int i = 0; i < NI; ++i) { const LAS float* f = fb + 512 * i;
            float* S1 = out + O_SS + (size_t)(bb[i] * 4 + hd) * 16384 + (8 * kg) * 128 + 4 * v4;
            float q_ = 0.f;
#pragma unroll
            for (int j = 0; j < 32; ++j) q_ += f[32 * part + j] * f[128 + 32 * part + j];
            q_ += __shfl_xor(q_, 1); q_ += __shfl_xor(q_, 2); qk[i] = q_;
            const f32x4 vv4 = *(const LAS f32x4*)(f + 256 + 4 * v4);
            f32x4 a4 = {0.f, 0.f, 0.f, 0.f};
#pragma unroll
            for (int j = 0; j < 8; ++j) { const float qj = f[8 * kg + j], kj = f[128 + 8 * kg + j]; a4 += sr[i][j] * qj; *(f32x4*)(S1 + j * 128) = sr[i][j] * gamma + vv4 * kj; }
            *(LAS f32x4*)(fb + 2048 + 2048 * i + kg * 128 + 4 * v4) = a4; }
        LDS_BARRIER();
        float o[NI];
#pragma unroll
        for (int i = 0; i < NI; ++i) { float ss = 0.f; o[i] = 0.f;
            if (tid < 128) { float a = 0.f;
#pragma unroll
                for (int g = 0; g < 16; ++g) a += fb[2048 + 2048 * i + g * 128 + tid];
                o[i] = qk[i] * fb[512 * i + 256 + tid] + gamma * a; ss = o[i] * o[i]; }
            ss = wave_sum(ss);
            if (lane == 0) fb[1024 + 8 * i + wid] = ss; }
        LDS_BARRIER();
#pragma unroll
        for (int i = 0; i < NI; ++i) { const float rn = rsqrtf((fb[1024 + 8 * i] + fb[1024 + 8 * i + 1]) * (1.0f / 128.0f) + EPS);
            if (tid < 128) { const float g0 = rgv[i]; HM[i][512 + hd * 128 + tid] = (bf16_t)f2bf(o[i] * rn * ghr * g0 * sigmoidf_(g0)); } }
    }
    LDS_BARRIER();
}
DI void conv_outputs(const Params& p, int idx0, int stride) {
    const bf16_t* U = (const bf16_t*)(p.ws + WS_U); float* out = p.out;
    for (int i = idx0; i < 8 * 3 * 1024; i += stride) { const int b = i / 3072, j = (i / 1024) % 3, c = i & 1023; out[O_CONVP + i] = bf2f(U[((size_t)b * 2048 + 2045 + j) * UC + c]); }
    for (int i = idx0; i < 128 * 3 * 1024; i += stride) { const int b = i / 3072, j = (i / 1024) % 3, c = i & 1023;
        out[O_CONVS + i] = (j < 2) ? p.in[4][(size_t)b * 3072 + (j + 1) * 1024 + c] : bf2f(U[((size_t)NPROMPT + b) * UC + c]); }
}

DI void attn_prompt_unit(const Params& p, LAS unsigned char* lds, int u) {
    const int tid = threadIdx.x, wid = __builtin_amdgcn_readfirstlane(tid >> 6);
    int lane = tid & 63, hh = lane >> 5, l31 = lane & 31;
    const int b = u >> 5, h = (u >> 3) & 3, qt = u & 7;
    unsigned char* ws = p.ws;
    const bf16_t* Q = (const bf16_t*)(ws + WS_BFA); bf16_t* O = (bf16_t*)(ws + WS_BFB);
    const bf16_t* KP = (const bf16_t*)(ws + WS_KP) + (size_t)(b * 4 + h) * 65536; const bf16_t* VP = (const bf16_t*)(ws + WS_VP) + (size_t)(b * 4 + h) * 65536;
    const size_t mrow = (size_t)b * 2048 + qt * 256 + 32 * wid;
    const unsigned la = (unsigned)(uintptr_t)lds;
    int blk = (lane >> 4) & 1, q4 = (lane & 15) >> 2, pp = lane & 3;
#pragma unroll
    for (int i = 0; i < 16; ++i) { const int idx = tid + 512 * i, row = idx >> 5, c8 = idx & 31; *(LAS u32x4*)(lds + (c8 >> 4) * 65536 + off_b(row, c8 & 15)) = *(const u32x4*)(KP + row * 256 + 8 * c8); }
    __syncthreads();
    f32x16 acc[8];
#pragma unroll
    for (int c = 0; c < 8; ++c)
#pragma unroll
        for (int i = 0; i < 16; ++i) acc[c][i] = 0.f;
#pragma unroll 1
    for (int sh = 0; sh < 4; ++sh) {
        lane = tid & 63; asm volatile("" : "+v"(lane)); hh = lane >> 5; l31 = lane & 31;
        bf16x8 bq[4];
#pragma unroll
        for (int s = 0; s < 4; ++s) bq[s] = *(const bf16x8*)(Q + (mrow + l31) * DM + h * 256 + 16 * (4 * sh + s) + 8 * hh);
#pragma unroll
        for (int s = 0; s < 4; ++s) { const int c16 = 2 * (4 * sh + s) + hh;
#pragma unroll
            for (int c = 0; c < 8; ++c) { const bf16x8 A = *(const LAS bf16x8*)(lds + (c16 >> 4) * 65536 + off_b(32 * c + l31, c16 & 15)); acc[c] = MFMA32(A, bq[s], acc[c]); } }
    }
    float mx = -INFINITY;
#pragma unroll
    for (int c = 0; c < 8; ++c)
#pragma unroll
        for (int i = 0; i < 16; ++i) mx = fmaxf(mx, acc[c][i]);
    mx = fmaxf(mx, __shfl_xor(mx, 32));
    float sum = 0.f;
    bf16x8 pf[8][2];
#pragma unroll
    for (int c = 0; c < 8; ++c) {
        float e[16];
#pragma unroll
        for (int i = 0; i < 16; ++i) { e[i] = __expf(acc[c][i] - mx); sum += e[i]; }
#pragma unroll
        for (int s2 = 0; s2 < 2; ++s2) { u32x4 w; w.x = pk2(e[8 * s2], e[8 * s2 + 1]); w.y = pk2(e[8 * s2 + 2], e[8 * s2 + 3]); w.z = pk2(e[8 * s2 + 4], e[8 * s2 + 5]); w.w = pk2(e[8 * s2 + 6], e[8 * s2 + 7]);
            pf[c][s2] = __builtin_bit_cast(bf16x8, w); }
    }
    sum += __shfl_xor(sum, 32);
    float rinv[16];
#pragma unroll
    for (int i = 0; i < 16; ++i) rinv[i] = 1.0f / __shfl(sum, crow(i, hh));
    __syncthreads();
#pragma unroll
    for (int i = 0; i < 16; ++i) { const int idx = tid + 512 * i, row = idx >> 5, c8 = idx & 31; *(LAS u32x4*)(lds + (c8 >> 4) * 65536 + off_b(row, c8 & 15)) = *(const u32x4*)(VP + row * 256 + 8 * c8); }
    __syncthreads();
#pragma unroll 1
    for (int dt = 0; dt < 8; ++dt) {
        lane = tid & 63; asm volatile("" : "+v"(lane)); hh = lane >> 5; l31 = lane & 31; blk = (lane >> 4) & 1; q4 = (lane & 15) >> 2; pp = lane & 3;
        f32x16 o;
#pragma unroll
        for (int i = 0; i < 16; ++i) o[i] = 0.f;
        const unsigned base = la + (dt >> 2) * 65536; const int chk = 4 * (dt & 3) + 2 * blk + (pp >> 1); const unsigned sub8 = 8 * (pp & 1);
#pragma unroll
        for (int c = 0; c < 8; ++c) {
            const int r0 = 32 * c + 4 * hh + q4; s16x4 x0, x1, x2, x3;
            tr_read4(base + off_b(r0, chk) + sub8, base + off_b(r0 + 8, chk) + sub8, base + off_b(r0 + 16, chk) + sub8, base + off_b(r0 + 24, chk) + sub8, x0, x1, x2, x3);
            o = MFMA32(pf[c][0], cat4(x0, x1), o); o = MFMA32(pf[c][1], cat4(x2, x3), o); }
#pragma unroll
        for (int i = 0; i < 16; ++i) O[(mrow + crow(i, hh)) * DM + h * 256 + 32 * dt + l31] = (bf16_t)f2bf(o[i] * rinv[i]);
    }
    __syncthreads();
}
DI void attn_sample_pair(const Params& p, LAS unsigned char* lds, int it0) {
    const int tid = threadIdx.x, lane = tid & 63, wid = tid >> 6, sub = wid >> 2, w4 = wid & 3, g = lane >> 4, i16 = lane & 15;
    const int it = it0 + sub, b = it >> 2, h = it & 3;
    const bf16_t* Q = (const bf16_t*)(p.ws + WS_BFA) + ((size_t)NPROMPT + b) * DM + h * 256;
    LAS float* xm = (LAS float*)(lds + 131072); LAS float* xs = xm + 8; LAS float* part = xm + 16;
    f32x4 q[4];
#pragma unroll
    for (int j = 0; j < 4; ++j) { const u32x2 qw = *(const u32x2*)(Q + 4 * (i16 + 16 * j)); q[j].x = bflo(qw.x); q[j].y = bfhi(qw.x); q[j].z = bflo(qw.y); q[j].w = bfhi(qw.y); }
    const float* ck = p.in[2] + (((size_t)b * 256 + 64 * w4 + g) * 4 + h) * 256 + 4 * i16; const float* cv = p.in[3] + (((size_t)b * 256 + 64 * w4 + g) * 4 + h) * 256 + 4 * i16;
    float sc[16];
#pragma unroll
    for (int s = 0; s < 16; ++s) { float d = 0.f;
#pragma unroll
        for (int j = 0; j < 4; ++j) { const f32x4 kr = *(const f32x4*)(ck + (size_t)s * 4096 + 64 * j); d += (kr.x * q[j].x + kr.y * q[j].y) + (kr.z * q[j].z + kr.w * q[j].w); }
        d += __shfl_xor(d, 1); d += __shfl_xor(d, 2); d += __shfl_xor(d, 4); d += __shfl_xor(d, 8); sc[s] = d; }
    float lm = sc[0];
#pragma unroll
    for (int s = 1; s < 16; ++s) lm = fmaxf(lm, sc[s]);
    lm = fmaxf(lm, __shfl_xor(lm, 16)); lm = fmaxf(lm, __shfl_xor(lm, 32));
    if (lane == 0) xm[sub * 4 + w4] = lm;
    __syncthreads();
    const float gm = fmaxf(fmaxf(xm[sub * 4], xm[sub * 4 + 1]), fmaxf(xm[sub * 4 + 2], xm[sub * 4 + 3]));
    float ls = 0.f;
#pragma unroll
    for (int s = 0; s < 16; ++s) { sc[s] = __expf(sc[s] - gm); ls += sc[s]; }
    ls += __shfl_xor(ls, 16); ls += __shfl_xor(ls, 32);
    if (lane == 0) xs[sub * 4 + w4] = ls;
    f32x4 o[4];
#pragma unroll
    for (int j = 0; j < 4; ++j) o[j] = (f32x4){0.f, 0.f, 0.f, 0.f};
#pragma unroll
    for (int s = 0; s < 16; ++s)
#pragma unroll
        for (int j = 0; j < 4; ++j) { const f32x4 vr = *(const f32x4*)(cv + (size_t)s * 4096 + 64 * j); o[j] += vr * sc[s]; }
#pragma unroll
    for (int j = 0; j < 4; ++j)
#pragma unroll
        for (int e = 0; e < 4; ++e) { float t = o[j][e]; t += __shfl_xor(t, 16); t += __shfl_xor(t, 32); o[j][e] = t; }
    if (g == 0) {
#pragma unroll
        for (int j = 0; j < 4; ++j) *(LAS f32x4*)(part + (sub * 4 + w4) * 256 + 4 * (i16 + 16 * j)) = o[j]; }
    __syncthreads();
    { const int d = tid & 255, s2 = tid >> 8; const float gs = (xs[s2 * 4] + xs[s2 * 4 + 1]) + (xs[s2 * 4 + 2] + xs[s2 * 4 + 3]);
      const float v = (part[(s2 * 4) * 256 + d] + part[(s2 * 4 + 1) * 256 + d]) + (part[(s2 * 4 + 2) * 256 + d] + part[(s2 * 4 + 3) * 256 + d]);
      const int it2 = it0 + s2; bf16_t* O2 = (bf16_t*)(p.ws + WS_BFB) + ((size_t)NPROMPT + (it2 >> 2)) * DM + (it2 & 3) * 256; O2[d] = (bf16_t)f2bf(v / gs); }
    __syncthreads();
}
DI void final_norm(const Params& p) {
    const int lane = threadIdx.x & 63, gw = blockIdx.x * 8 + (threadIdx.x >> 6), NGW = gridDim.x * 8;
    const bf16_t* X3 = (const bf16_t*)(p.ws + WS_BFA); const float* rs3 = (const float*)(p.ws + WS_SMALL) + SM_RS3; const float* gf = p.in[28];
    f32x4 g[4];
#pragma unroll
    for (int j = 0; j < 4; ++j) g[j] = ((const f32x4*)gf)[4 * lane + j];
    constexpr int RB = 9, NGRP = (NVALID + RB - 1) / RB;
#pragma unroll 1
    for (int gi = gw; gi < NGRP; gi += NGW) {
        u32x4 w0[RB], w1[RB]; float rr[RB];
#pragma unroll
        for (int r = 0; r < RB; ++r) { int m = gi * RB + r; if (m >= NVALID) m = NVALID - 1; const u32x4* xr = (const u32x4*)(X3 + (size_t)m * DM) + 2 * lane; w0[r] = xr[0]; w1[r] = xr[1]; rr[r] = rs3[m]; }
#pragma unroll
        for (int r = 0; r < RB; ++r) { const int m = gi * RB + r; if (m >= NVALID) continue;
            const float sc = rsqrtf(rr[r] * (1.0f / 1024.0f) + EPS);
            f32x4* orow = (f32x4*)(p.out + (m < NPROMPT ? O_YP + (size_t)m * DM : O_YS + (size_t)(m - NPROMPT) * DM)) + 4 * lane;
            float x[16]; { float t[8]; unpack8(w0[r], t);
#pragma unroll
                for (int e = 0; e < 8; ++e) x[e] = t[e]; unpack8(w1[r], t);
#pragma unroll
                for (int e = 0; e < 8; ++e) x[8 + e] = t[e]; }
#pragma unroll
            for (int j = 0; j < 4; ++j) { f32x4 o; o.x = x[4 * j] * sc * g[j].x; o.y = x[4 * j + 1] * sc * g[j].y; o.z = x[4 * j + 2] * sc * g[j].z; o.w = x[4 * j + 3] * sc * g[j].w; orow[j] = o; } }
    }
}
struct SkScale { bf16_t* O; int ldc; const float* ss; float post;
    DI void operator()(float v0, float v1, int r, int c, int lane) const { const float sc = rsqrtf(ss[r] * (1.0f / 1024.0f) + EPS) * post; *(unsigned*)(O + (size_t)r * ldc + c) = pk2(v0 * sc, v1 * sc); } };
struct SkRes { const float* resf; const bf16_t* resb; bf16_t* outb; float* rs;
    DI void operator()(float v0, float v1, int r, int c, int lane) const { const size_t o = (size_t)r * 1024 + c;
        if (resf) { v0 += resf[o]; v1 += resf[o + 1]; } else { const unsigned w = *(const unsigned*)(resb + o); v0 += bflo(w); v1 += bfhi(w); }
        *(unsigned*)(outb + o) = pk2(v0, v1);
        float q = v0 * v0 + v1 * v1; q += __shfl_xor(q, 1); q += __shfl_xor(q, 2); q += __shfl_xor(q, 4); q += __shfl_xor(q, 8);
        if ((lane & 15) == 0) atomicAdd(rs + r, q); } };
template <class Epi> DI void skinny_gemm(LAS unsigned char* lds, const bf16_t* A, int lda, const bf16_t* Bt, int K, int N, const Epi& E) {
    const int tid = threadIdx.x, lane = tid & 63, wid = tid >> 6, l31 = lane & 31, hh = lane >> 5, G = gridDim.x;
    const int njobs = 4 * (N / 32), kw = K / 8;
    LAS float* part = (LAS float*)lds;
    for (int j = blockIdx.x; j < njobs; j += G) {
        const int rt = j & 3, ct = j >> 2;
        const bf16_t* ap = A + (size_t)(32 * rt + l31) * lda + wid * kw + 8 * hh; const bf16_t* bp = Bt + (size_t)(32 * ct + l31) * K + wid * kw + 8 * hh;
        f32x16 acc;
#pragma unroll
        for (int i = 0; i < 16; ++i) acc[i] = 0.f;
        int k = 0;
#pragma unroll 1
        for (; k + 128 <= kw; k += 128) { bf16x8 a[8], bb[8];
#pragma unroll
            for (int u = 0; u < 8; ++u) { a[u] = *(const bf16x8*)(ap + k + 16 * u); bb[u] = *(const bf16x8*)(bp + k + 16 * u); }
#pragma unroll
            for (int u = 0; u < 8; ++u) acc = MFMA32(a[u], bb[u], acc); }
#pragma unroll 1
        for (; k < kw; k += 16) { const bf16x8 a = *(const bf16x8*)(ap + k), bb = *(const bf16x8*)(bp + k); acc = MFMA32(a, bb, acc); }
#pragma unroll
        for (int i = 0; i < 16; ++i) part[wid * 1024 + crow(i, hh) * 32 + l31] = acc[i];
        __syncthreads();
        { const int e0 = 2 * tid, r = e0 >> 5, c = e0 & 31; float v0 = 0.f, v1 = 0.f;
#pragma unroll
            for (int w = 0; w < 8; ++w) { const f32x2 t = *(const LAS f32x2*)(part + w * 1024 + e0); v0 += t.x; v1 += t.y; }
            E(v0, v1, 32 * rt + r, 32 * ct + c, lane); }
        __syncthreads();
    }
}
#define XB_TMO      128
#define XB_XCNT(j)  (256  + 64 * (j))
#define XB_XSUB(j)  (1280 + 64 * (j))
#define XB_XGEN(j)  (2304 + 64 * (j))
#define XB_TOP      3328
#define XB_TOPGEN   3392
#define XCD_BAR_WORDS 3456
#define XB_SPIN_CAP (1u << 18)

__device__ __forceinline__ unsigned xb_ld(unsigned* p)              { return __hip_atomic_load(p, __ATOMIC_RELAXED, __HIP_MEMORY_SCOPE_AGENT); }
__device__ __forceinline__ unsigned xb_add(unsigned* p, unsigned v) { return __hip_atomic_fetch_add(p, v, __ATOMIC_RELAXED, __HIP_MEMORY_SCOPE_AGENT); }
__device__ __forceinline__ unsigned xb_xcc_id() { return (unsigned)__builtin_amdgcn_s_getreg((3 << 11) | 20) & 0xFu; }
#define XB_SPIN(cond, bar) do { unsigned _sp = 0; while (cond) { __builtin_amdgcn_s_sleep(1); \
    if ((++_sp & 255u) == 0u) { if (xb_ld(&(bar)[XB_TMO])) break; if (_sp > XB_SPIN_CAP) { atomicAdd(&(bar)[XB_TMO], 1u); break; } } } } while (0)

struct XcdBarrier {
    unsigned* bar; unsigned x;
    volatile LAS unsigned* st;
};

__device__ __forceinline__ XcdBarrier xcd_barrier_post(unsigned* bar, volatile LAS unsigned* st) {
    XcdBarrier b; b.bar = bar; b.x = xb_xcc_id(); b.st = st;
    if (threadIdx.x == 0) (void)xb_add(&bar[XB_XCNT(b.x)], 1u);
    return b;
}
__device__ __forceinline__ void xcd_barrier_complete(unsigned* bar, unsigned x, unsigned& nloc, unsigned& nx) {
    const unsigned G = gridDim.x * gridDim.y * gridDim.z;
    unsigned sum, cnt, mine, sp = 0u;
    for (;;) {
        sum = 0u; cnt = 0u; mine = 0u;
#pragma unroll
        for (unsigned j = 0; j < 16; ++j) { const unsigned c = xb_ld(&bar[XB_XCNT(j)]); sum += c; cnt += (c > 0u) ? 1u : 0u; mine = (j == x) ? c : mine; }
        if (sum == G) break;
        __builtin_amdgcn_s_sleep(1);
        if ((++sp & 255u) == 0u) { if (xb_ld(&bar[XB_TMO])) break; if (sp > XB_SPIN_CAP) { atomicAdd(&bar[XB_TMO], 1u); break; } }
    }
    nloc = mine > 0u ? mine : 1u; nx = cnt > 0u ? cnt : 1u;
}

__device__ __forceinline__ void xcd_barrier(const XcdBarrier& b) {
    asm volatile("s_waitcnt vmcnt(0)" ::: "memory");
    __syncthreads();
    if (threadIdx.x == 0) {
        unsigned* bar = b.bar;
        __builtin_amdgcn_s_waitcnt(0);
        unsigned nloc = b.st[0], nx = b.st[1];
        if (nloc == 0u) { xcd_barrier_complete(bar, b.x, nloc, nx); b.st[0] = nloc; b.st[1] = nx; }
        const unsigned old = xb_add(&bar[XB_XSUB(b.x)], 1u);
        const unsigned gen = old / nloc;
        if (old + 1u == (gen + 1u) * nloc) {
            __builtin_amdgcn_fence(__ATOMIC_RELEASE, "agent");
            asm volatile("s_waitcnt vmcnt(0)" ::: "memory");
            const unsigned og = xb_add(&bar[XB_TOP], 1u);
            const unsigned tg = og / nx;
            if (og + 1u == (tg + 1u) * nx) xb_add(&bar[XB_TOPGEN], 1u);
            else XB_SPIN(xb_ld(&bar[XB_TOPGEN]) == tg, bar);
            __builtin_amdgcn_fence(__ATOMIC_ACQUIRE, "agent");
            xb_add(&bar[XB_XGEN(b.x)], 1u);
            asm volatile("s_waitcnt vmcnt(0)" ::: "memory");
        } else {
            XB_SPIN(xb_ld(&bar[XB_XGEN(b.x)]) == gen, bar);
            __builtin_amdgcn_fence(__ATOMIC_ACQUIRE, "agent");
            asm volatile("s_waitcnt vmcnt(0)" ::: "memory");
        }
    }
    __syncthreads();
}

__global__ void __launch_bounds__(512, 2) fwd_megakernel(Params p) {
    extern __shared__ __attribute__((aligned(16))) unsigned char lds_raw[];
    LAS unsigned char* lds = (LAS unsigned char*)lds_raw;
    cg::grid_group grid = cg::this_grid();
    unsigned char* ws = p.ws;
    float* sm = (float*)(ws + WS_SMALL);
    const int lo = p.ph_lo, hi = p.ph_hi;
    volatile LAS unsigned* bst = (volatile LAS unsigned*)(lds + LDS_BYTES - 64);
    if (threadIdx.x < 2) bst[threadIdx.x] = 0u;
    __syncthreads();
    const XcdBarrier bar = xcd_barrier_post((unsigned*)(ws + WS_BAR), bst);
    if (lo < 0) grid.sync();
#ifndef PHMASK
#define PHMASK 0x7ff
#endif
#define IN(k) (((PHMASK >> (k)) & 1) && lo <= (k) && (k) < hi)
#define SEAM(k) do { if (IN(k) && IN((k) + 1)) xcd_barrier(bar); } while (0)
#ifndef RPT
#define RPT 0
#endif
#define NREP(k) (((RPT >> (k)) & 1) ? 2 : 1)
    const int G = gridDim.x, bx = blockIdx.x;
    if (IN(0)) for (int rep = 0; rep < NREP(0); ++rep) { p0_prologue(p, lds); __syncthreads(); } SEAM(0);
    if (IN(1)) for (int rep = 0; rep < NREP(1); ++rep) {
        pg8::Gemm g{(const bf16_t*)(ws + WS_BFA), (const bf16_t*)(ws + WS_WIN), NPROMPT, UC, DM}; pg8::StaticOrder S; S.init(NPROMPT, UC, G, bx);
        pg8::EpiScaleBf16 E{(bf16_t*)(ws + WS_U), UC, sm + SM_SS0, 1.0f};
        pg8::gemm_phase<pg8::EpiScaleBf16, pg8::StaticOrder, true, true>(lds, g, S, E);
        skinny_gemm(lds, (const bf16_t*)(ws + WS_BFA) + (size_t)NPROMPT * DM, DM, (const bf16_t*)(ws + WS_WIN), DM, UC, SkScale{(bf16_t*)(ws + WS_U) + (size_t)NPROMPT * UC, UC, sm + SM_SS0 + NPROMPT, 1.0f});
    } SEAM(1);
    if (IN(2)) {
        const bool items_first = (G == 256) && (bx < 192) && (((bx >> 3) & 1) != 0);
        if (items_first) { scan_sample_two(p, lds, bx); scan_sample_two(p, lds, bx + 512); }
        if (bx < 192) { scan_prompt<1>(p, lds, bx & 63, bx >> 6); if (RPT & 0x2000) scan_prompt<1>(p, lds, bx & 63, bx >> 6); }
        else {
            pg8::Gemm g{(const bf16_t*)(ws + WS_MEMB), (const bf16_t*)(ws + WS_WCKV), 2048, 2048, DM}; pg8::SubOrder S{bx - 192, 64, 8};
            pg8::EpiKV E{sm + SM_SSM, p.out + O_MK, p.out + O_MV, (bf16_t*)(ws + WS_KP), (bf16_t*)(ws + WS_VP)};
            pg8::gemm_phase<pg8::EpiKV, pg8::SubOrder, false, true>(lds, g, S, E);
        }
        if (items_first) { }
        else if (G == 256) { scan_sample_two(p, lds, bx); scan_sample_two(p, lds, bx + 512); }
        else for (int item = bx; item < 1024; item += G) scan_sample_block(p, lds, item);
        conv_outputs(p, bx * 512 + threadIdx.x, G * 512);
    } SEAM(2);
    if (IN(3)) { scan_prompt<2>(p, lds, bx & 63, bx >> 6); if (RPT & 0x1000) scan_prompt<2>(p, lds, bx & 63, bx >> 6); } SEAM(3);
    if (IN(4)) for (int rep = 0; rep < NREP(4); ++rep) {
        pg8::Gemm g{(const bf16_t*)(ws + WS_BFB), (const bf16_t*)(ws + WS_WOUT), NPROMPT, DM, DM}; pg8::StaticOrder S; S.init(NPROMPT, DM, G, bx);
        pg8::EpiResB<true> E{p.in[0], nullptr, (bf16_t*)(ws + WS_BFC), rep ? nullptr : sm + SM_RS1};
        pg8::gemm_phase<pg8::EpiResB<true>, pg8::StaticOrder, true, true>(lds, g, S, E);
        if (rep == 0) skinny_gemm(lds, (const bf16_t*)(ws + WS_BFB) + (size_t)NPROMPT * DM, DM, (const bf16_t*)(ws + WS_WOUT), DM, DM, SkRes{p.in[1], nullptr, (bf16_t*)(ws + WS_BFC) + (size_t)NPROMPT * DM, sm + SM_RS1 + NPROMPT});
    } SEAM(4);
    if (IN(5)) for (int rep = 0; rep < NREP(5); ++rep) {
        pg8::Gemm g{(const bf16_t*)(ws + WS_BFC), (const bf16_t*)(ws + WS_WCQ), NPROMPT, DM, DM}; pg8::StaticOrder S; S.init(NPROMPT, DM, G, bx);
        pg8::EpiScaleBf16 E{(bf16_t*)(ws + WS_BFA), DM, sm + SM_RS1, 0.0625f};
        pg8::gemm_phase<pg8::EpiScaleBf16, pg8::StaticOrder, true, true>(lds, g, S, E);
        skinny_gemm(lds, (const bf16_t*)(ws + WS_BFC) + (size_t)NPROMPT * DM, DM, (const bf16_t*)(ws + WS_WCQ), DM, DM, SkScale{(bf16_t*)(ws + WS_BFA) + (size_t)NPROMPT * DM, DM, sm + SM_RS1 + NPROMPT, 0.0625f});
    } SEAM(5);
    if (IN(6)) for (int rep = 0; rep < NREP(6); ++rep) {
        const bool early = ((bx >> 3) & 1) != 0;
        if (early) { for (int it0 = bx * 2; it0 < 512; it0 += G * 2) attn_sample_pair(p, lds, it0); }
        for (int u = bx; u < 256; u += G) attn_prompt_unit(p, lds, u);
        if (!early) { for (int it0 = bx * 2; it0 < 512; it0 += G * 2) attn_sample_pair(p, lds, it0); }
    } SEAM(6);
    if (IN(7)) for (int rep = 0; rep < NREP(7); ++rep) {
        pg8::Gemm g{(const bf16_t*)(ws + WS_BFB), (const bf16_t*)(ws + WS_WCO), NPROMPT, DM, DM}; pg8::StaticOrder S; S.init(NPROMPT, DM, G, bx);
        pg8::EpiResB<false> E{nullptr, (const bf16_t*)(ws + WS_BFC), (bf16_t*)(ws + WS_BFC), sm + SM_RS2};
        pg8::gemm_phase<pg8::EpiResB<false>, pg8::StaticOrder, true, true>(lds, g, S, E);
        if (rep == 0) skinny_gemm(lds, (const bf16_t*)(ws + WS_BFB) + (size_t)NPROMPT * DM, DM, (const bf16_t*)(ws + WS_WCO), DM, DM, SkRes{nullptr, (const bf16_t*)(ws + WS_BFC) + (size_t)NPROMPT * DM, (bf16_t*)(ws + WS_BFC) + (size_t)NPROMPT * DM, sm + SM_RS2 + NPROMPT});
    } SEAM(7);
    if (IN(8)) for (int rep = 0; rep < NREP(8); ++rep) {
        pg8::Gemm g{(const bf16_t*)(ws + WS_BFC), (const bf16_t*)(ws + WS_WGU), MP, 2 * DFF, DM}; pg8::StaticOrder S; S.init(MP, 2 * DFF, G, bx);
        pg8::EpiGU E{(bf16_t*)(ws + WS_U), sm + SM_RS2};
        pg8::gemm_phase<pg8::EpiGU, pg8::StaticOrder, true, true>(lds, g, S, E);
    } SEAM(8);
    if (IN(9)) for (int rep = 0; rep < NREP(9); ++rep) {
        pg8::Gemm g{(const bf16_t*)(ws + WS_U), (const bf16_t*)(ws + WS_WDN), NPROMPT, DM, DFF}; pg8::StaticOrder S; S.init(NPROMPT, DM, G, bx);
        pg8::EpiResB<false> E{nullptr, (const bf16_t*)(ws + WS_BFC), (bf16_t*)(ws + WS_BFA), rep ? nullptr : sm + SM_RS3};
        pg8::gemm_phase<pg8::EpiResB<false>, pg8::StaticOrder, true, true>(lds, g, S, E);
        if (rep == 0) skinny_gemm(lds, (const bf16_t*)(ws + WS_U) + (size_t)NPROMPT * DFF, DFF, (const bf16_t*)(ws + WS_WDN), DFF, DM, SkRes{nullptr, (const bf16_t*)(ws + WS_BFC) + (size_t)NPROMPT * DM, (bf16_t*)(ws + WS_BFA) + (size_t)NPROMPT * DM, sm + SM_RS3 + NPROMPT});
    } SEAM(9);
    if (IN(10)) for (int rep = 0; rep < NREP(10); ++rep) final_norm(p);
#ifdef XSYNC
    for (int i = 0; i < XSYNC; ++i) xcd_barrier(bar);
#endif
#undef IN
#undef SEAM
}

#ifndef N_LAUNCHES
#define N_LAUNCHES 1
#endif
extern "C" void kernel_launch(void* const* d_in, const int* in_sizes, int n_in, void* d_out, int out_size, void* d_ws, size_t ws_size, hipStream_t stream) {
    static int grid = 0;
    if (grid == 0) {
        if (n_in != 29 || out_size != (int)O_END || ws_size < WS_END) { fprintf(stderr, "kernel_launch: unexpected shapes (n_in %d, out %d, ws %zu)\n", n_in, out_size, ws_size); grid = -1; return; }
        int dev = 0, cus = 0, per_cu = 0;
        hipGetDevice(&dev); hipDeviceGetAttribute(&cus, hipDeviceAttributeMultiprocessorCount, dev);
        if (hipFuncSetAttribute((const void*)fwd_megakernel, hipFuncAttributeMaxDynamicSharedMemorySize, LDS_BYTES) != hipSuccess) { fprintf(stderr, "kernel_launch: hipFuncSetAttribute failed\n"); }
        if (hipOccupancyMaxActiveBlocksPerMultiprocessor(&per_cu, (const void*)fwd_megakernel, 512, LDS_BYTES) != hipSuccess) per_cu = 0;
        (void)hipGetLastError();
        fprintf(stderr, "kernel_launch: %d CUs, %d blocks/CU\n", cus, per_cu);
        if (cus * per_cu < 256) { fprintf(stderr, "kernel_launch: resident capacity %d < 256 blocks\n", cus * per_cu); grid = -1; return; }
        grid = 256;
    }
    if (grid < 0) return;
    if (hipMemsetAsync((char*)d_ws + WS_BAR, 0, XCD_BAR_WORDS * 4, stream) != hipSuccess) { fprintf(stderr, "kernel_launch: memset failed\n"); return; }
    Params p{};
    for (int i = 0; i < 29; ++i) p.in[i] = (const float*)d_in[i];
    p.out = (float*)d_out; p.ws = (unsigned char*)d_ws;
#if N_LAUNCHES == 1
    p.ph_lo = 0; p.ph_hi = 11;
    { void* args[] = {&p}; hipError_t e = hipLaunchCooperativeKernel((const void*)fwd_megakernel, dim3(grid), dim3(512), args, LDS_BYTES, stream);
      if (e != hipSuccess) fprintf(stderr, "cooperative launch failed: %s\n", hipGetErrorString(e)); }
#else
    for (int ph = 0; ph < 11; ++ph) { p.ph_lo = ph; p.ph_hi = ph + 1; void* args[] = {&p};
        hipError_t e = hipLaunchCooperativeKernel((const void*)fwd_megakernel, dim3(grid), dim3(512), args, LDS_BYTES, stream);
        if (e != hipSuccess) fprintf(stderr, "cooperative launch %d failed: %s\n", ph, hipGetErrorString(e)); }
#endif
}
```

```cpp
#include <hip/hip_runtime.h>
#include <hip/hip_cooperative_groups.h>
#include <cstdio>
#include <cstdint>
namespace cg = cooperative_groups;
namespace pg8 {
#define PG8_LAS __attribute__((address_space(3)))
typedef unsigned short bf16_t;
typedef short bf16x8 __attribute__((ext_vector_type(8)));
typedef float f32x4 __attribute__((ext_vector_type(4)));
typedef unsigned u32x4 __attribute__((ext_vector_type(4)));
constexpr int BM = 256, BK = 64, HALF = 128, HTB = HALF * BK * 2  , STAGE_BYTES = 8 * HTB, NXCD = 8, WGM = 8;

__host__ __device__ __forceinline__ int lds_byte(int r, int c) { const int st = (r >> 4) * 2 + (c >> 5), rr = r & 15, cc = c & 31, ob = rr * 64 + cc * 2; return st * 1024 + (ob ^ (((ob >> 9) & 1) << 5)); }
__host__ __device__ __forceinline__ void stage_rc(int b, int& R, int& C) { const int st = b / 1024, sb = b % 1024, swz = sb ^ (((sb >> 9) & 1) << 5); R = (st >> 1) * 16 + swz / 64; C = (st & 1) * 32 + (swz % 64) / 2; }
__host__ __device__ __forceinline__ int perm32(int rho) { const int n = rho >> 4, i = rho & 15; return 8 * (i >> 2) + 4 * n + (i & 3); }

struct Unit { int pm, pn; };
struct Gemm { const bf16_t* A; const bf16_t* Bt; int M, N, K; };

struct StaticOrder {
    int nM, nN, nwg, G, c;
    __host__ __device__ void init(int M, int N, int G_, int c_) { nM = M / BM; nN = N / BM; nwg = nM * nN; G = G_; c = c_; }
    __host__ __device__ bool next(int i, Unit& u) const {
        const long L = (long)i * G + c; if (L >= nwg) return false;
        int wgid = (int)L; { const int q = nwg / NXCD, r = nwg % NXCD, xcd = wgid % NXCD, off = wgid / NXCD; wgid = (xcd < r ? xcd * (q + 1) : r * (q + 1) + (xcd - r) * q) + off; }
        const int nig = WGM * nN, gid = wgid / nig, fm = gid * WGM, gsz = (nM - fm) < WGM ? (nM - fm) : WGM;
        u.pm = fm + ((wgid % nig) % gsz); u.pn = (wgid % nig) / gsz; return true;
    }
    __device__ __forceinline__ void a_ready(const Unit&) const {}
    __device__ __forceinline__ void done(const Unit&) const {}
};

__device__ __forceinline__ unsigned cvt_pk_bf16(float lo, float hi) { unsigned r; asm volatile("v_cvt_pk_bf16_f32 %0, %1, %2" : "=v"(r) : "v"(lo), "v"(hi)); return r; }
typedef unsigned u32x2v __attribute__((ext_vector_type(2)));
constexpr float NORM_EPS = 1e-6f;
struct SubOrder {
    int idx, n, nN;
    __device__ bool next(int i, Unit& u) const { if (i != 0 || idx < 0 || idx >= n) return false; u.pm = idx / nN; u.pn = idx % nN; return true; }
    __device__ __forceinline__ void a_ready(const Unit&) const {}
    __device__ __forceinline__ void done(const Unit&) const {}
};
struct EpiScaleBf16 {
    static constexpr bool PERM = true, AFTER_DRAIN = false;
    bf16_t* O; int ldc; const float* ss; float post;
    __device__ __forceinline__ void operator()(const f32x4 (&acc)[2][2][4][2], const Unit& u, int wr, int wc, int fr, int fq) const {
        const int row0 = u.pm * BM + wr * 64 + fr, col0 = u.pn * BM + wc * 32 + 8 * fq;
#pragma unroll
        for (int ai = 0; ai < 2; ++ai)
#pragma unroll
            for (int m = 0; m < 4; ++m) { const int r = row0 + ai * HALF + m * 16; const float sc = rsqrtf(ss[r] * (1.0f / 1024.0f) + NORM_EPS) * post;
                bf16_t* rowp = O + (size_t)r * ldc + col0;
#pragma unroll
                for (int bj = 0; bj < 2; ++bj) { const f32x4 v0 = acc[ai][bj][m][0] * sc, v1 = acc[ai][bj][m][1] * sc;
                    u32x4 w; w.x = cvt_pk_bf16(v0[0], v0[1]); w.y = cvt_pk_bf16(v0[2], v0[3]); w.z = cvt_pk_bf16(v1[0], v1[1]); w.w = cvt_pk_bf16(v1[2], v1[3]);
                    *(u32x4*)(rowp + bj * HALF) = w; } }
    }
};
struct EpiRes {
    static constexpr bool PERM = false, AFTER_DRAIN = false;
    const float* res0; const float* res1; int split, nvalid; float* outf; bf16_t* outb; float* rs;
    __device__ __forceinline__ void operator()(const f32x4 (&acc)[2][2][4][2], const Unit& u, int wr, int wc, int fr, int fq) const {
        const int row0 = u.pm * BM + wr * 64 + fr, col0 = u.pn * BM + wc * 32 + 4 * fq;
#pragma unroll
        for (int ai = 0; ai < 2; ++ai)
#pragma unroll
            for (int m = 0; m < 4; ++m) { const int r = row0 + ai * HALF + m * 16;
                const float* rp = (r < split) ? res0 + (size_t)r * 1024 : ((r < nvalid) ? res1 + (size_t)(r - split) * 1024 : nullptr);
                float s = 0.f;
#pragma unroll
                for (int bj = 0; bj < 2; ++bj)
#pragma unroll
                    for (int n = 0; n < 2; ++n) { const int c = col0 + bj * HALF + n * 16;
                        f32x4 v = acc[ai][bj][m][n]; if (rp) v += *(const f32x4*)(rp + c);
                        *(f32x4*)(outf + (size_t)r * 1024 + c) = v;
                        if (outb) { u32x2v w; w.x = cvt_pk_bf16(v[0], v[1]); w.y = cvt_pk_bf16(v[2], v[3]); *(u32x2v*)(outb + (size_t)r * 1024 + c) = w; }
                        s += (v[0] * v[0] + v[1] * v[1]) + (v[2] * v[2] + v[3] * v[3]); }
                s += __shfl_xor(s, 16); s += __shfl_xor(s, 32);
                if (rs && fq == 0) atomicAdd(rs + r, s); }
    }
};
template <bool RES_F32> struct EpiResB {
    static constexpr bool PERM = true, AFTER_DRAIN = false;
    const float* resf; const bf16_t* resb; bf16_t* outb; float* rs;
    __device__ __forceinline__ void operator()(const f32x4 (&acc)[2][2][4][2], const Unit& u, int wr, int wc, int fr, int fq) const {
        const int row0 = u.pm * BM + wr * 64 + fr, col0 = u.pn * BM + wc * 32 + 8 * fq;
#pragma unroll
        for (int ai = 0; ai < 2; ++ai)
#pragma unroll
            for (int m = 0; m < 4; ++m) { const int r = row0 + ai * HALF + m * 16; float s = 0.f;
#pragma unroll
                for (int bj = 0; bj < 2; ++bj) { const size_t o = (size_t)r * 1024 + col0 + bj * HALF;
                    f32x4 v0 = acc[ai][bj][m][0], v1 = acc[ai][bj][m][1];
                    if (RES_F32) { v0 += *(const f32x4*)(resf + o); v1 += *(const f32x4*)(resf + o + 4); }
                    else { const u32x4 w = *(const u32x4*)(resb + o);
                        v0[0] += __builtin_bit_cast(float, w.x << 16); v0[1] += __builtin_bit_cast(float, w.x & 0xffff0000u); v0[2] += __builtin_bit_cast(float, w.y << 16); v0[3] += __builtin_bit_cast(float, w.y & 0xffff0000u);
                        v1[0] += __builtin_bit_cast(float, w.z << 16); v1[1] += __builtin_bit_cast(float, w.z & 0xffff0000u); v1[2] += __builtin_bit_cast(float, w.w << 16); v1[3] += __builtin_bit_cast(float, w.w & 0xffff0000u); }
                    u32x4 w2; w2.x = cvt_pk_bf16(v0[0], v0[1]); w2.y = cvt_pk_bf16(v0[2], v0[3]); w2.z = cvt_pk_bf16(v1[0], v1[1]); w2.w = cvt_pk_bf16(v1[2], v1[3]);
                    *(u32x4*)(outb + o) = w2;
                    s += ((v0[0] * v0[0] + v0[1] * v0[1]) + (v0[2] * v0[2] + v0[3] * v0[3])) + ((v1[0] * v1[0] + v1[1] * v1[1]) + (v1[2] * v1[2] + v1[3] * v1[3])); }
                s += __shfl_xor(s, 16); s += __shfl_xor(s, 32);
                if (rs && fq == 0) atomicAdd(rs + r, s); }
    }
};
struct EpiKV {
    static constexpr bool PERM = false, AFTER_DRAIN = false;
    const float* ss; float* outk; float* outv; bf16_t* kp; bf16_t* vp;
    __device__ __forceinline__ void operator()(const f32x4 (&acc)[2][2][4][2], const Unit& u, int wr, int wc, int fr, int fq) const {
        const int row0 = u.pm * BM + wr * 64 + fr, col0 = u.pn * BM + wc * 32 + 4 * fq;
#pragma unroll
        for (int ai = 0; ai < 2; ++ai)
#pragma unroll
            for (int m = 0; m < 4; ++m) { const int r = row0 + ai * HALF + m * 16; const float sc = rsqrtf(ss[r] * (1.0f / 1024.0f) + NORM_EPS);
                const int b = r >> 8, key = r & 255;
#pragma unroll
                for (int bj = 0; bj < 2; ++bj)
#pragma unroll
                    for (int n = 0; n < 2; ++n) { const int c = col0 + bj * HALF + n * 16; const f32x4 v = acc[ai][bj][m][n] * sc;
                        const int cc = c & 1023, hd = cc >> 8, dim = cc & 255; const bool isv = c >= 1024;
                        *(f32x4*)((isv ? outv : outk) + (size_t)r * 1024 + cc) = v;
                        u32x2v w; w.x = cvt_pk_bf16(v[0], v[1]); w.y = cvt_pk_bf16(v[2], v[3]);
                        *(u32x2v*)((isv ? vp : kp) + ((size_t)((b * 4 + hd) * 256 + key)) * 256 + dim) = w; } }
    }
};
struct EpiGU {
    static constexpr bool PERM = true, AFTER_DRAIN = false;
    bf16_t* O; const float* ss;
    __device__ __forceinline__ void operator()(const f32x4 (&acc)[2][2][4][2], const Unit& u, int wr, int wc, int fr, int fq) const {
        const int row0 = u.pm * BM + wr * 64 + fr, col0 = u.pn * HALF + wc * 32 + 8 * fq;
#pragma unroll
        for (int ai = 0; ai < 2; ++ai)
#pragma unroll
            for (int m = 0; m < 4; ++m) { const int r = row0 + ai * HALF + m * 16; const float sc = rsqrtf(ss[r] * (1.0f / 1024.0f) + NORM_EPS);
                float a[8];
#pragma unroll
                for (int n = 0; n < 2; ++n)
#pragma unroll
                    for (int e = 0; e < 4; ++e) { const float g = acc[ai][0][m][n][e] * sc, up = acc[ai][1][m][n][e] * sc; a[4 * n + e] = g * __builtin_amdgcn_rcpf(1.0f + __expf(-g)) * up; }
                u32x4 w; w.x = cvt_pk_bf16(a[0], a[1]); w.y = cvt_pk_bf16(a[2], a[3]); w.z = cvt_pk_bf16(a[4], a[5]); w.w = cvt_pk_bf16(a[6], a[7]);
                *(u32x4*)(O + (size_t)r * 2816 + col0) = w; }
    }
};
template <class Epi, class Sched, bool ALIGN_EPI = false, bool SP2 = false>
__device__ __forceinline__ void gemm_phase(PG8_LAS unsigned char* lds, const Gemm g, const Sched& S, const Epi& E) {
    const int tid = threadIdx.x, wid = __builtin_amdgcn_readfirstlane(tid >> 6), lane = tid & 63, wr = wid >> 2, wc = wid & 3, fr = lane & 15, fq = lane >> 4;
    const int K = g.K, nt = K / BK;
    unsigned voffA[2], voffB[2];
#pragma unroll
    for (int i = 0; i < 2; ++i) { int R, C; stage_rc(tid * 16 + i * 8192, R, C); const int Rb = Epi::PERM ? ((R & ~31) + perm32(R & 31)) : R;
        voffA[i] = (unsigned)(R * K + C) * 2u; voffB[i] = (unsigned)(Rb * K + C) * 2u; }
    const size_t kstep = (size_t)(BK * 2);
    const size_t hstep = (size_t)HALF * K * 2;
    const size_t tstep = 2 * hstep;
    const unsigned ldsw = (unsigned)wid * 1024u;
    const int aoff = lds_byte(wr * 64 + fr, fq * 8), boff = lds_byte(wc * 32 + fr, fq * 8);
#define PG8_SA(b, h) (((b) * 2 + (h)) * HTB)
#define PG8_SB(b, h) ((4 + (b) * 2 + (h)) * HTB)
#define PG8_STAGE(bufoff, gbase, voff) do { _Pragma("unroll") for (int _i = 0; _i < 2; ++_i) \
        __builtin_amdgcn_global_load_lds((const unsigned*)((const char*)(gbase) + (voff)[_i]), (PG8_LAS unsigned*)(lds + (bufoff) + ldsw + _i * 8192), 16, 0, 0); } while (0)
#define PG8_LDA(dst, b, h) do { _Pragma("unroll") for (int m = 0; m < 4; ++m) _Pragma("unroll") for (int k = 0; k < 2; ++k) dst[m][k] = *(const PG8_LAS bf16x8*)(lds + PG8_SA(b, h) + aoff + m * 2048 + k * 1024); } while (0)
#define PG8_LDB(dst, b, h) do { _Pragma("unroll") for (int n = 0; n < 2; ++n) _Pragma("unroll") for (int k = 0; k < 2; ++k) dst[n][k] = *(const PG8_LAS bf16x8*)(lds + PG8_SB(b, h) + boff + n * 2048 + k * 1024); } while (0)
#define PG8_MMA(ai, bj, At, Bt) do { __builtin_amdgcn_s_setprio(1); _Pragma("unroll") for (int m = 0; m < 4; ++m) _Pragma("unroll") for (int n = 0; n < 2; ++n) _Pragma("unroll") for (int k = 0; k < 2; ++k) \
        acc[ai][bj][m][n] = __builtin_amdgcn_mfma_f32_16x16x32_bf16(Bt[n][k], At[m][k], acc[ai][bj][m][n], 0, 0, 0); __builtin_amdgcn_s_setprio(0); } while (0)
#define PG8_WAIT_V(n) asm volatile("s_waitcnt vmcnt(" #n ")" ::: "memory")
#define PG8_WAIT_L(n) asm volatile("s_waitcnt lgkmcnt(" #n ")" ::: "memory")
#define PG8_BAR __builtin_amdgcn_s_barrier()
#define PG8_SCHED __builtin_amdgcn_sched_barrier(0)
    Unit cur, nxt; int ui = 0;
    if (!S.next(0, cur)) return;
    f32x4 acc[2][2][4][2];
#pragma unroll
    for (int a = 0; a < 2; ++a)
#pragma unroll
        for (int b = 0; b < 2; ++b)
#pragma unroll
            for (int m = 0; m < 4; ++m)
#pragma unroll
                for (int n = 0; n < 2; ++n) acc[a][b][m][n] = (f32x4){0.f, 0.f, 0.f, 0.f};
    bf16x8 At[4][2], B0[2][2], B1[2][2];
    const char* cA = (const char*)g.A + (size_t)cur.pm * tstep; const char* cB = (const char*)g.Bt + (size_t)cur.pn * tstep;
    S.a_ready(cur);
    if constexpr (SP2) {
        PG8_STAGE(PG8_SB(0, 0), cB, voffB); PG8_STAGE(PG8_SB(0, 1), cB + hstep, voffB); PG8_STAGE(PG8_SA(0, 0), cA, voffA); PG8_STAGE(PG8_SA(0, 1), cA + hstep, voffA);
        if (wr == 1) PG8_BAR;
        PG8_WAIT_V(2); PG8_BAR;
        PG8_STAGE(PG8_SB(1, 0), cB + kstep, voffB); PG8_STAGE(PG8_SA(1, 0), cA + kstep, voffA); PG8_STAGE(PG8_SB(1, 1), cB + hstep + kstep, voffB);
        PG8_WAIT_V(6); PG8_BAR;
    } else {
        PG8_STAGE(PG8_SB(0, 0), cB, voffB); PG8_STAGE(PG8_SA(0, 0), cA, voffA); PG8_STAGE(PG8_SB(0, 1), cB + hstep, voffB); PG8_STAGE(PG8_SA(0, 1), cA + hstep, voffA);
        if (wr == 1) PG8_BAR;
        PG8_WAIT_V(4); PG8_BAR;
        PG8_STAGE(PG8_SB(1, 0), cB + kstep, voffB); PG8_STAGE(PG8_SA(1, 0), cA + kstep, voffA); PG8_STAGE(PG8_SB(1, 1), cB + hstep + kstep, voffB);
        PG8_WAIT_V(6); PG8_BAR;
    }
    for (;;) {
        const bool has_next = S.next(ui + 1, nxt);
        const char* nA = has_next ? (const char*)g.A + (size_t)nxt.pm * tstep : cA; const char* nB = has_next ? (const char*)g.Bt + (size_t)nxt.pn * tstep : cB;
        for (int t = 0; t < nt; t += 2) {
            const bool last = (t == nt - 2);
            const char* a1 = cA + (size_t)(t + 1) * kstep;
            const char* a2 = last ? nA : cA + (size_t)(t + 2) * kstep; const char* b2 = last ? nB : cB + (size_t)(t + 2) * kstep;
            const char* a3 = a2 + kstep; const char* b3 = b2 + kstep;
            if (last && has_next) S.a_ready(nxt);
            if constexpr (SP2) {
            PG8_LDB(B0, 0, 0); PG8_LDB(B1, 0, 1); PG8_SCHED; PG8_LDA(At, 0, 0); PG8_STAGE(PG8_SA(1, 1), a1 + hstep, voffA);
            PG8_WAIT_V(8); PG8_WAIT_L(0); PG8_BAR; PG8_MMA(0, 0, At, B0); PG8_MMA(0, 1, At, B1); PG8_BAR; PG8_SCHED;
            PG8_LDA(At, 0, 1); PG8_STAGE(PG8_SB(0, 0), b2, voffB); PG8_STAGE(PG8_SB(0, 1), b2 + hstep, voffB); PG8_STAGE(PG8_SA(0, 0), a2, voffA);
            PG8_WAIT_V(8); PG8_WAIT_L(0); PG8_BAR; PG8_MMA(1, 0, At, B0); PG8_MMA(1, 1, At, B1); PG8_BAR; PG8_SCHED;
            PG8_LDB(B0, 1, 0); PG8_LDB(B1, 1, 1); PG8_SCHED; PG8_LDA(At, 1, 0); PG8_STAGE(PG8_SA(0, 1), a2 + hstep, voffA);
            PG8_WAIT_V(8); PG8_WAIT_L(0); PG8_BAR; PG8_MMA(0, 0, At, B0); PG8_MMA(0, 1, At, B1); PG8_BAR; PG8_SCHED;
            PG8_LDA(At, 1, 1); PG8_STAGE(PG8_SB(1, 0), b3, voffB); PG8_STAGE(PG8_SB(1, 1), b3 + hstep, voffB); PG8_STAGE(PG8_SA(1, 0), a3, voffA);
            PG8_WAIT_V(8); PG8_WAIT_L(0); PG8_BAR; PG8_MMA(1, 0, At, B0); PG8_MMA(1, 1, At, B1); PG8_BAR; PG8_SCHED;
            } else {
            PG8_LDB(B0, 0, 0); PG8_SCHED; PG8_LDA(At, 0, 0); PG8_STAGE(PG8_SA(1, 1), a1 + hstep, voffA);
            PG8_WAIT_L(8); PG8_BAR; PG8_WAIT_L(0); PG8_MMA(0, 0, At, B0); PG8_BAR; PG8_SCHED;
            PG8_LDB(B1, 0, 1); PG8_STAGE(PG8_SB(0, 0), b2, voffB);
            PG8_BAR; PG8_WAIT_L(0); PG8_MMA(0, 1, At, B1); PG8_BAR;
            PG8_LDA(At, 0, 1); PG8_STAGE(PG8_SA(0, 0), a2, voffA);
            PG8_BAR; PG8_WAIT_L(0); PG8_MMA(1, 0, At, B0); PG8_BAR; PG8_SCHED;
            PG8_STAGE(PG8_SB(0, 1), b2 + hstep, voffB);
            PG8_WAIT_V(6); PG8_BAR; PG8_MMA(1, 1, At, B1); PG8_BAR;
            PG8_LDB(B0, 1, 0); PG8_SCHED; PG8_LDA(At, 1, 0); PG8_STAGE(PG8_SA(0, 1), a2 + hstep, voffA);
            PG8_WAIT_L(8); PG8_BAR; PG8_WAIT_L(0); PG8_MMA(0, 0, At, B0); PG8_BAR; PG8_SCHED;
            PG8_LDB(B1, 1, 1); PG8_STAGE(PG8_SB(1, 0), b3, voffB);
            PG8_BAR; PG8_WAIT_L(0); PG8_MMA(0, 1, At, B1); PG8_BAR;
            PG8_LDA(At, 1, 1); PG8_STAGE(PG8_SA(1, 0), a3, voffA);
            PG8_BAR; PG8_WAIT_L(0); PG8_MMA(1, 0, At, B0); PG8_BAR; PG8_SCHED;
            PG8_STAGE(PG8_SB(1, 1), b3 + hstep, voffB);
            PG8_WAIT_V(6); PG8_BAR; PG8_MMA(1, 1, At, B1); PG8_BAR;
            }
        }
        if constexpr (ALIGN_EPI) { if (wr == 0) PG8_BAR; }
        if constexpr (!Epi::AFTER_DRAIN) { E(acc, cur, wr, wc, fr, fq); S.done(cur); }
        if (!has_next) break;
#pragma unroll
        for (int a = 0; a < 2; ++a)
#pragma unroll
            for (int b = 0; b < 2; ++b)
#pragma unroll
                for (int m = 0; m < 4; ++m)
#pragma unroll
                    for (int n = 0; n < 2; ++n) acc[a][b][m][n] = (f32x4){0.f, 0.f, 0.f, 0.f};
        cur = nxt; cA = nA; cB = nB; ++ui;
        if constexpr (ALIGN_EPI) { if (wr == 1) PG8_BAR; }
    }
    PG8_WAIT_V(0);
    if constexpr (!ALIGN_EPI) { if (wr == 0) PG8_BAR; }
    PG8_BAR;
    if constexpr (Epi::AFTER_DRAIN) { E.fused(acc, cur, wr, wc, fr, fq, lds, wid, lane); S.done(cur); }
#undef PG8_SA
#undef PG8_SB
#undef PG8_STAGE
#undef PG8_LDA
#undef PG8_LDB
#undef PG8_MMA
#undef PG8_WAIT_V
#undef PG8_WAIT_L
#undef PG8_BAR
#undef PG8_SCHED
}
}
#define LAS __attribute__((address_space(3)))
#define DI __device__ __forceinline__
typedef unsigned short bf16_t;
typedef short bf16x8 __attribute__((ext_vector_type(8)));
typedef short s16x4 __attribute__((ext_vector_type(4)));
typedef float f32x2 __attribute__((ext_vector_type(2)));
typedef float f32x4 __attribute__((ext_vector_type(4)));
typedef float f32x16 __attribute__((ext_vector_type(16)));
typedef unsigned u32x4 __attribute__((ext_vector_type(4)));
typedef unsigned u32x2 __attribute__((ext_vector_type(2)));
#define MFMA32(a, b, c) __builtin_amdgcn_mfma_f32_32x32x16_bf16((a), (b), (c), 0, 0, 0)

constexpr int NPROMPT = 16384, NSAMP = 128, NVALID = NPROMPT + NSAMP, MP = 16640;
constexpr int DM = 1024, UC = 4096, DFF = 2816, INC = 4104;
constexpr float EPS = 1e-6f;
constexpr int LDS_BYTES = 147456;

constexpr size_t MiB = 1u << 20;
constexpr size_t WS_WIN = 0;
constexpr size_t WS_WOUT = 8 * MiB;
constexpr size_t WS_WCKV = 10 * MiB;
constexpr size_t WS_WCQ = 14 * MiB;
constexpr size_t WS_WCO = 16 * MiB;
constexpr size_t WS_WGU = 18 * MiB;
constexpr size_t WS_WDN = 29 * MiB;
constexpr size_t WS_MEMB = 35 * MiB;
constexpr size_t WS_KP = 39 * MiB;
constexpr size_t WS_VP = 43 * MiB;
constexpr size_t WS_SMALL = 47 * MiB; constexpr size_t WS_BAR = WS_SMALL + 896 * 1024;
constexpr size_t WS_BFA = 48 * MiB;
constexpr size_t WS_BFB = 81 * MiB;
constexpr size_t WS_BFC = 114 * MiB;
constexpr size_t WS_FA = 147 * MiB;
constexpr size_t WS_FB = 212 * MiB;
constexpr size_t WS_U = 277 * MiB;
constexpr size_t WS_END = 408 * MiB;
constexpr int SM_SS0 = 0, SM_RS1 = MP, SM_RS2 = 2 * MP, SM_RS3 = 3 * MP, SM_SSM = 4 * MP, SM_GATES = 4 * MP + 2048;

constexpr size_t O_YP = 0, O_YS = 16777216, O_MK = 16908288, O_MV = 19005440, O_CONVP = 21102592, O_CP = 21127168, O_NP = 21651456, O_MP = 21655552, O_SP = 21655584,
                 O_CONVS = 22179872, O_CS = 22573088, O_NS = 30961696, O_MS = 31027232, O_SS = 31027744, O_END = 39416352;

struct Params { const float* in[29]; float* out; unsigned char* ws; int ph_lo, ph_hi; };

DI unsigned f2bf(float f) { unsigned u = __builtin_bit_cast(unsigned, f); return (u + 0x7fffu + ((u >> 16) & 1u)) >> 16; }
DI unsigned pk2(float lo, float hi) { return f2bf(lo) | (f2bf(hi) << 16); }
DI float bf2f(unsigned h) { return __builtin_bit_cast(float, h << 16); }
DI float bflo(unsigned w) { return __builtin_bit_cast(float, w << 16); }
DI float bfhi(unsigned w) { return __builtin_bit_cast(float, w & 0xffff0000u); }
DI void unpack8(u32x4 w, float (&f)[8]) { f[0] = bflo(w.x); f[1] = bfhi(w.x); f[2] = bflo(w.y); f[3] = bfhi(w.y); f[4] = bflo(w.z); f[5] = bfhi(w.z); f[6] = bflo(w.w); f[7] = bfhi(w.w); }
DI u32x4 pack8(const float (&f)[8]) { u32x4 w; w.x = pk2(f[0], f[1]); w.y = pk2(f[2], f[3]); w.z = pk2(f[4], f[5]); w.w = pk2(f[6], f[7]); return w; }
DI float wave_sum(float v) {
#pragma unroll
    for (int o = 1; o < 64; o <<= 1) v += __shfl_xor(v, o);
    return v;
}
DI float wave_max(float v) {
#pragma unroll
    for (int o = 1; o < 64; o <<= 1) v = fmaxf(v, __shfl_xor(v, o));
    return v;
}
DI unsigned off_b(unsigned row, unsigned ch) { return 256u * row + 16u * (ch ^ (((row & 3u) << 2) | ((row >> 2) & 3u))); }
DI int crow(int i, int h) { return (i & 3) + 8 * (i >> 2) + 4 * h; }
DI void tr_read4(unsigned a0, unsigned a1, unsigned a2, unsigned a3, s16x4& r0, s16x4& r1, s16x4& r2, s16x4& r3) {
    asm volatile("ds_read_b64_tr_b16 %0, %4\n\tds_read_b64_tr_b16 %1, %5\n\tds_read_b64_tr_b16 %2, %6\n\tds_read_b64_tr_b16 %3, %7\n\ts_waitcnt lgkmcnt(0)"
                 : "=&v"(r0), "=&v"(r1), "=&v"(r2), "=&v"(r3) : "v"(a0), "v"(a1), "v"(a2), "v"(a3) : "memory");
}
DI bf16x8 cat4(s16x4 lo, s16x4 hi) { return __builtin_shufflevector(lo, hi, 0, 1, 2, 3, 4, 5, 6, 7); }
DI float sigmoidf_(float x) { return __builtin_amdgcn_rcpf(1.0f + __expf(-x)); }
DI float logsigmoidf_(float x) { return fminf(x, 0.f) - log1pf(__expf(-fabsf(x))); }
DI void sincos_red(float a, float& s, float& c) {
    const float n = rintf(a * 0.15915494309189535f);
    float r = fmaf(-n, 6.28125f, a); r = fmaf(-n, 1.9353071795864769e-3f, r);
    s = __sinf(r); c = __cosf(r);
}

struct TItem { const float* W; int ldw, K, c0, k0; bf16_t* WT; int r0; const float* gs; };
DI TItem p0_decode(const Params& p, int it) {
    unsigned char* ws = p.ws; TItem t;
    constexpr int I_IN = 16 * 64, I_SQ = 16 * 32, I_FF = 16 * 88;
    int r = it;
    if (r < 2 * I_IN) { const int half = r / I_IN; r -= half * I_IN; const int kb = r / 64, nb = r % 64;
        t.W = p.in[10]; t.ldw = INC; t.K = 1024; t.c0 = (half ? 2056 : 0) + 32 * nb; t.k0 = 64 * kb; t.WT = (bf16_t*)(ws + WS_WIN); t.r0 = half * 2048 + 32 * nb; t.gs = p.in[14]; return t; }
    r -= 2 * I_IN;
    if (r < 5 * I_SQ) { const int which = r / I_SQ; r -= which * I_SQ; const int kb = r / 32, nb = r % 32;
        t.ldw = 1024; t.K = 1024; t.c0 = 32 * nb; t.k0 = 64 * kb; t.r0 = 32 * nb;
        if (which == 0) { t.W = p.in[17]; t.WT = (bf16_t*)(ws + WS_WOUT); t.gs = nullptr; }
        else if (which == 1) { t.W = p.in[20]; t.WT = (bf16_t*)(ws + WS_WCKV); t.gs = p.in[19]; }
        else if (which == 2) { t.W = p.in[21]; t.WT = (bf16_t*)(ws + WS_WCKV); t.gs = p.in[19]; t.r0 += 1024; }
        else if (which == 3) { t.W = p.in[22]; t.WT = (bf16_t*)(ws + WS_WCQ); t.gs = p.in[18]; }
        else { t.W = p.in[23]; t.WT = (bf16_t*)(ws + WS_WCO); t.gs = nullptr; }
        return t; }
    r -= 5 * I_SQ;
    if (r < 2 * I_FF) { const int which = r / I_FF; r -= which * I_FF; const int kb = r / 88, nb = r % 88; const int n0 = 32 * nb;
        t.W = which ? p.in[26] : p.in[25]; t.ldw = DFF; t.K = 1024; t.c0 = n0; t.k0 = 64 * kb; t.WT = (bf16_t*)(ws + WS_WGU); t.r0 = 256 * (n0 >> 7) + (n0 & 127) + (which ? 128 : 0); t.gs = p.in[24]; return t; }
    r -= 2 * I_FF;
    { const int kb = r / 32, nb = r % 32; t.W = p.in[27]; t.ldw = 1024; t.K = DFF; t.c0 = 32 * nb; t.k0 = 64 * kb; t.WT = (bf16_t*)(ws + WS_WDN); t.r0 = 32 * nb; t.gs = nullptr; }
    return t;
}
DI void p0_item_load(const TItem& t, float (&v)[32], int lane) {
#pragma unroll
    for (int i = 0; i < 32; ++i) { const int kk = 2 * i + (lane >> 5); v[i] = t.W[(size_t)(t.k0 + kk) * t.ldw + t.c0 + (lane & 31)]; }
}
DI void p0_item_finish(const TItem& t, const float (&v)[32], LAS float* scr, int lane) {
#pragma unroll
    for (int i = 0; i < 32; ++i) { const int kk = 2 * i + (lane >> 5); float x = v[i]; if (t.gs) x *= t.gs[t.k0 + kk]; scr[kk * 33 + (lane & 31)] = x; }
    asm volatile("s_waitcnt lgkmcnt(0)" ::: "memory");
    const int c = lane & 7;
#pragma unroll
    for (int j = 0; j < 4; ++j) { const int n = (lane >> 3) + 8 * j; const LAS float* s = scr + (8 * c) * 33 + n;
        u32x4 o; o.x = pk2(s[0 * 33], s[1 * 33]); o.y = pk2(s[2 * 33], s[3 * 33]); o.z = pk2(s[4 * 33], s[5 * 33]); o.w = pk2(s[6 * 33], s[7 * 33]);
        *(u32x4*)(t.WT + (size_t)(t.r0 + n) * t.K + t.k0 + 8 * c) = o; }
    asm volatile("s_waitcnt lgkmcnt(0)" ::: "memory");
}
DI void p0_prologue(const Params& p, LAS unsigned char* lds) {
    const int tid = threadIdx.x, lane = tid & 63, wave = tid >> 6;
    unsigned char* ws = p.ws;
    float* sm = (float*)(ws + WS_SMALL);
    const float* w_in = p.in[10];
    const float* g_mix = p.in[14];
    LAS float* GW = (LAS float*)(lds + 69632);
    for (int i = tid; i < 8192; i += 512) { const int k = i >> 3, j = i & 7; GW[i] = g_mix[k] * w_in[(size_t)k * INC + 2048 + j]; }
    for (int i = blockIdx.x * 512 + tid; i < 3 * MP; i += gridDim.x * 512) sm[SM_RS1 + i] = 0.f;
    __syncthreads();
    const int gw = blockIdx.x * 8 + wave, NGW = gridDim.x * 8;
    LAS float* scr = (LAS float*)(lds + wave * 8448);
    constexpr int NITEMS = 2 * (16 * 64) + 5 * (16 * 32) + 2 * (16 * 88) + 44 * 32;
#pragma unroll 1
    for (int it = gw; it < NITEMS; it += 2 * NGW) {
        const bool hasB = it + NGW < NITEMS;
        const TItem ta = p0_decode(p, it), tb = p0_decode(p, hasB ? it + NGW : it);
        float va[32], vb[32];
        p0_item_load(ta, va, lane); p0_item_load(tb, vb, lane);
        p0_item_finish(ta, va, scr, lane);
        if (hasB) p0_item_finish(tb, vb, scr, lane);
    }
    const float* b_gate = p.in[11];
    constexpr int RB = 5, NROWS = NVALID + 2048, NGRP = (NROWS + RB - 1) / RB;
#pragma unroll 1
    for (int gi = gw; gi < NGRP; gi += NGW) {
        f32x4 v[RB][4];
#pragma unroll
        for (int r = 0; r < RB; ++r) { int m = gi * RB + r; if (m >= NROWS) m = NROWS - 1;
            const float* xr = (m >= NVALID) ? p.in[9] + (size_t)(m - NVALID) * DM : (m < NPROMPT ? p.in[0] + (size_t)m * DM : p.in[1] + (size_t)(m - NPROMPT) * DM);
#pragma unroll
            for (int j = 0; j < 4; ++j) v[r][j] = ((const f32x4*)xr)[64 * j + lane]; }
#pragma unroll
        for (int r = 0; r < RB; ++r) { const int m = gi * RB + r; if (m >= NROWS) continue;
            const bool ismem = m >= NVALID;
            bf16_t* orow = ismem ? (bf16_t*)(ws + WS_MEMB) + (size_t)(m - NVALID) * DM : (bf16_t*)(ws + WS_BFA) + (size_t)m * DM;
            float s = 0.f;
#pragma unroll
            for (int j = 0; j < 4; ++j) { s += (v[r][j].x * v[r][j].x + v[r][j].y * v[r][j].y) + (v[r][j].z * v[r][j].z + v[r][j].w * v[r][j].w);
                u32x2 w; w.x = pk2(v[r][j].x, v[r][j].y); w.y = pk2(v[r][j].z, v[r][j].w); ((u32x2*)orow)[64 * j + lane] = w; }
            s = wave_sum(s);
            if (ismem) { if (lane == 0) sm[SM_SSM + (m - NVALID)] = s; continue; }
            float g[8];
#pragma unroll
            for (int e = 0; e < 8; ++e) g[e] = 0.f;
#pragma unroll
            for (int j = 0; j < 4; ++j)
#pragma unroll
                for (int e = 0; e < 4; ++e) { const int k = 4 * (64 * j + lane) + e; const f32x4 a = *(const LAS f32x4*)(GW + 8 * k), bq = *(const LAS f32x4*)(GW + 8 * k + 4); const float xv = v[r][j][e];
                    g[0] += xv * a.x; g[1] += xv * a.y; g[2] += xv * a.z; g[3] += xv * a.w; g[4] += xv * bq.x; g[5] += xv * bq.y; g[6] += xv * bq.z; g[7] += xv * bq.w; }
#pragma unroll
            for (int e = 0; e < 8; ++e) g[e] = wave_sum(g[e]);
            const float rr = rsqrtf(s * (1.0f / 1024.0f) + EPS);
            if (lane == 0) { sm[SM_SS0 + m] = s;
#pragma unroll
                for (int e = 0; e < 8; ++e) sm[SM_GATES + (size_t)m * 8 + e] = g[e] * rr + b_gate[e]; }
        }
    }
}
#define LDS_BARRIER() do { asm volatile("s_waitcnt lgkmcnt(0)" ::: "memory"); __builtin_amdgcn_s_barrier(); asm volatile("" ::: "memory"); } while (0)
template <int PASS> DI void scan_prompt(const Params& p, LAS unsigned char* lds, int bh, int seg) {
    const int tid0 = threadIdx.x, wid = __builtin_amdgcn_readfirstlane(tid0 >> 6), wr = wid >> 1, wc = wid & 1;
    int tid = tid0, lane = tid & 63, hh = lane >> 5, l31 = lane & 31;
    const int b = bh >> 3, head8 = bh & 7, hd = head8 & 3; const bool ret = head8 >= 4;
    unsigned char* ws = p.ws;
    const bf16_t* U = (const bf16_t*)(ws + WS_U);
    bf16_t* HM = (bf16_t*)(ws + WS_BFB);
    const float* gates = (const float*)(ws + WS_SMALL) + SM_GATES;
    const int qcol = (ret ? 2048 : 0) + hd * 128, kcol = qcol + 512, vcol = qcol + 1024, gcol = qcol + 1536, ocol = head8 * 128;
    const float* ghead = (ret ? p.in[16] : p.in[15]) + hd * 128;
    LAS unsigned char* T0 = lds; LAS unsigned char* T1 = lds + 32768; LAS unsigned char* T2 = lds + 65536; LAS unsigned char* T3 = lds + 98304;
    LAS float* sb = (LAS float*)(lds + 131072);
    LAS float* sa = sb + 128;
    LAS float* sbm = sb + 256;
    LAS float* swin = sb + 384;
    LAS float* sem = sb + 512;
    LAS float* snq = sb + 640;
    LAS float* sws = sb + 768;
    LAS float* sn = sb + 896;
    LAS float* sinv = sb + 1024;
    LAS float* smisc = sb + 1152;
    const unsigned t1a = (unsigned)(uintptr_t)T1, t2a = (unsigned)(uintptr_t)T2;
    const float lg = log1pf(-exp2f(-5.0f - (float)hd));
    int blk = (lane >> 4) & 1, q4 = (lane & 15) >> 2, pp = lane & 3;
    for (int i = tid; i < 8192; i += 512) ((LAS unsigned*)T3)[i] = 0u;
    if (tid < 128) sn[tid] = 0.f;
    LAS float* scw = sb + 1344;
    if (!ret) for (int i = tid; i < 1280; i += 512) { const int which = i / 640, r = i % 640, j = r >> 7, c = r & 127, ci = which * 512 + hd * 128 + c; scw[i] = (j < 4) ? p.in[12][j * 1024 + ci] : p.in[13][ci]; }
    f32x16 accC[2];
#pragma unroll
    for (int c = 0; c < 2; ++c)
#pragma unroll
        for (int i = 0; i < 16; ++i) accC[c][i] = 0.f;
    float m_state = 0.f;
    LAS float* sbl = sb + 1280; LAS float* spm = sb + 1296; LAS float* smq = sb + 1312; LAS float* scf = sb + 1336;
    float* Lws = (float*)(ws + WS_FA); float* NLws = Lws + (size_t)64 * 3 * 16384;
    if (!ret) {
        for (int c = wid; c < 16; c += 8) { const float* gp = gates + ((size_t)b * 2048 + c * 128 + 2 * lane) * 8;
            const float i0 = gp[hd], i1 = gp[8 + hd], lf0 = logsigmoidf_(gp[4 + hd]), lf1 = logsigmoidf_(gp[12 + hd]);
            float incl = lf0 + lf1;
#pragma unroll
            for (int o = 1; o < 64; o <<= 1) { const float t = __shfl_up(incl, o); if (lane >= o) incl += t; }
            const float b1 = incl, b0 = incl - lf1, a0 = i0 - b0, a1 = i1 - b1;
            float pin = fmaxf(a0, a1);
#pragma unroll
            for (int o = 1; o < 64; o <<= 1) { const float t = __shfl_up(pin, o); if (lane >= o) pin = fmaxf(pin, t); }
            if (lane == 63) { sbl[c] = incl; spm[c] = pin; } }
    } else if (tid < 16) { sbl[tid] = 128.0f * lg; spm[tid] = 0.f; }
    __syncthreads();
    if (tid == 0) {
        float m = 0.f; smq[0] = 0.f;
        for (int c = 0; c < 16; ++c) { m = ret ? 0.f : sbl[c] + fmaxf(m, spm[c]); smq[c + 1] = m; }
        float run = 1.f;
        for (int i = seg - 1; i >= 0; --i) { scf[i] = run; const float sB = ret ? 512.0f * lg : (sbl[4 * i] + sbl[4 * i + 1]) + (sbl[4 * i + 2] + sbl[4 * i + 3]); run *= __expf(sB + smq[4 * i] - smq[4 * i + 4]); }
    }
    __syncthreads();
    m_state = smq[4 * seg];
    if constexpr (PASS == 2) {
        for (int i = 0; i < seg; ++i) { const float cf = scf[i]; const float* L = Lws + (size_t)(bh * 3 + i) * 16384;
#pragma unroll
            for (int c = 0; c < 2; ++c)
#pragma unroll
                for (int ii = 0; ii < 16; ++ii) accC[c][ii] += cf * L[(32 * wr + crow(ii, hh)) * 128 + 64 * wc + 32 * c + l31];
            if (tid < 128) sn[tid] += cf * NLws[(size_t)(bh * 3 + i) * 128 + tid]; }
#pragma unroll
        for (int c = 0; c < 2; ++c) { const int k_idx = 64 * wc + 32 * c + l31;
#pragma unroll
            for (int i = 0; i < 16; ++i) { const int v = 32 * wr + crow(i, hh); *(LAS unsigned short*)(T3 + off_b(v, k_idx >> 3) + 2 * (k_idx & 7)) = (unsigned short)f2bf(accC[c][i]); } }
    }
    __syncthreads();
    for (int ch = 4 * seg; ch < 4 * seg + 4; ++ch) {
        const int t0 = ch * 128; const size_t m0 = (size_t)b * 2048 + t0;
        tid = tid0; asm volatile("" : "+v"(tid)); lane = tid & 63; hh = lane >> 5; l31 = lane & 31; blk = (lane >> 4) & 1; q4 = (lane & 15) >> 2; pp = lane & 3;
        if (wid == 0) {
            float lf0, lf1, i0, i1;
            if (!ret) { const float* gp = gates + (m0 + 2 * lane) * 8; i0 = gp[hd]; i1 = gp[8 + hd]; lf0 = logsigmoidf_(gp[4 + hd]); lf1 = logsigmoidf_(gp[12 + hd]); }
            else { lf0 = lg; lf1 = lg; i0 = 0.f; i1 = 0.f; }
            float incl = lf0 + lf1;
#pragma unroll
            for (int o = 1; o < 64; o <<= 1) { const float t = __shfl_up(incl, o); if (lane >= o) incl += t; }
            const float b1 = incl, b0 = incl - lf1, a0 = i0 - b0, a1 = i1 - b1;
            float pin = fmaxf(a0, a1);
#pragma unroll
            for (int o = 1; o < 64; o <<= 1) { const float t = __shfl_up(pin, o); if (lane >= o) pin = fmaxf(pin, t); }
            float pex = __shfl_up(pin, 1); if (lane == 0) pex = -INFINITY;
            const float pm0 = fmaxf(pex, a0), pm1 = pin;
            const float mt0 = ret ? 0.f : b0 + fmaxf(m_state, pm0), mt1 = ret ? 0.f : b1 + fmaxf(m_state, pm1);
            const float bL = __shfl(incl, 63), pmL = __shfl(pin, 63);
            const float m_new = ret ? 0.f : bL + fmaxf(m_state, pmL);
            sb[2 * lane] = b0; sb[2 * lane + 1] = b1; sa[2 * lane] = a0; sa[2 * lane + 1] = a1;
            sbm[2 * lane] = b0 - mt0; sbm[2 * lane + 1] = b1 - mt1;
            swin[2 * lane] = __expf(b0 + m_state - mt0); swin[2 * lane + 1] = __expf(b1 + m_state - mt1);
            sem[2 * lane] = __expf(-mt0); sem[2 * lane + 1] = __expf(-mt1);
            sws[2 * lane] = __expf(bL + a0 - m_new); sws[2 * lane + 1] = __expf(bL + a1 - m_new);
            if (lane == 0) { smisc[0] = m_new; smisc[1] = __expf(bL + m_state - m_new); }
        }
        u32x4 vv[4];
#pragma unroll
        for (int i = 0; i < 4; ++i) { const int idx = tid + 512 * i, t = idx >> 4, c8 = idx & 15; vv[i] = *(const u32x4*)(U + (m0 + t) * UC + vcol + 8 * c8); }
        if (!ret) {
            const int c8 = tid & 15, tq = tid >> 4;
            u32x4 xq[7], xk[7];
#pragma unroll
            for (int j = 0; j < 7; ++j) { const int rr = 4 * tq - 3 + j; const size_t row = (t0 + rr >= 0) ? (m0 + rr) : m0;
                if constexpr (PASS == 2) xq[j] = *(const u32x4*)(U + row * UC + qcol + 8 * c8);
                xk[j] = *(const u32x4*)(U + row * UC + kcol + 8 * c8); }
#pragma unroll
            for (int which = (PASS == 1 ? 1 : 0); which < 2; ++which) {
                const float scl = which ? 0.08838834764831845f : 1.0f; LAS unsigned char* T = which ? T1 : T0;
                const LAS float* cw = scw + which * 640 + 8 * c8;
                float wv[4][8], bc[8];
#pragma unroll
                for (int j = 0; j < 4; ++j) { const f32x4 a = *(const LAS f32x4*)(cw + j * 128), bq = *(const LAS f32x4*)(cw + j * 128 + 4);
                    wv[j][0] = a.x; wv[j][1] = a.y; wv[j][2] = a.z; wv[j][3] = a.w; wv[j][4] = bq.x; wv[j][5] = bq.y; wv[j][6] = bq.z; wv[j][7] = bq.w; }
                { const f32x4 a = *(const LAS f32x4*)(cw + 512), bq = *(const LAS f32x4*)(cw + 516); bc[0] = a.x; bc[1] = a.y; bc[2] = a.z; bc[3] = a.w; bc[4] = bq.x; bc[5] = bq.y; bc[6] = bq.z; bc[7] = bq.w; }
#pragma unroll
                for (int i = 0; i < 4; ++i) { const int t = 4 * tq + i;
                    float o[8];
#pragma unroll
                    for (int e = 0; e < 8; ++e) o[e] = bc[e];
#pragma unroll
                    for (int j = 0; j < 4; ++j) { const float msk = (t0 + t - 3 + j >= 0) ? 1.0f : 0.0f; float x[8]; unpack8(which ? xk[i + j] : xq[i + j], x);
#pragma unroll
                        for (int e = 0; e < 8; ++e) o[e] += (wv[j][e] * msk) * x[e]; }
#pragma unroll
                    for (int e = 0; e < 8; ++e) o[e] = o[e] * sigmoidf_(o[e]) * scl;
                    *(LAS u32x4*)(T + off_b(t, c8)) = pack8(o); }
            }
        } else {
            u32x4 rl[2][2], rh[2][2];
#pragma unroll
            for (int which = (PASS == 1 ? 1 : 0); which < 2; ++which)
#pragma unroll
                for (int i = 0; i < 2; ++i) { const int idx = tid + 512 * i, t = idx >> 3, c8 = idx & 7; const int ucol = which ? kcol : qcol;
                    rl[which][i] = *(const u32x4*)(U + (m0 + t) * UC + ucol + 8 * c8); rh[which][i] = *(const u32x4*)(U + (m0 + t) * UC + ucol + 64 + 8 * c8); }
#pragma unroll
            for (int which = (PASS == 1 ? 1 : 0); which < 2; ++which) {
                const float scl = which ? 0.08838834764831845f : 1.0f; LAS unsigned char* T = which ? T1 : T0;
#pragma unroll
                for (int i = 0; i < 2; ++i) { const int idx = tid + 512 * i, t = idx >> 3, c8 = idx & 7;
                    float x1[8], x2[8], o1[8], o2[8]; unpack8(rl[which][i], x1); unpack8(rh[which][i], x2); const float pos = (float)(t0 + t);
#pragma unroll
                    for (int e = 0; e < 8; ++e) { const float inv = exp2f(-(float)(8 * c8 + e) * 0.20762050593046014f); float sn_, cs_; sincos_red(pos * inv, sn_, cs_);
                        o1[e] = (x1[e] * cs_ - x2[e] * sn_) * scl; o2[e] = (x2[e] * cs_ + x1[e] * sn_) * scl; }
                    *(LAS u32x4*)(T + off_b(t, c8)) = pack8(o1); *(LAS u32x4*)(T + off_b(t, c8 + 8)) = pack8(o2); }
            }
        }
#pragma unroll
        for (int i = 0; i < 4; ++i) { const int idx = tid + 512 * i, t = idx >> 4, c8 = idx & 15; *(LAS u32x4*)(T2 + off_b(t, c8)) = vv[i]; }
        LDS_BARRIER();
        const float m_new = smisc[0], carry = smisc[1];
        if constexpr (PASS == 2) {
        { const int t = tid >> 2, part = tid & 3; float d = 0.f;
#pragma unroll
            for (int cc = 0; cc < 4; ++cc) { const int c8 = 4 * part + cc; float x[8]; unpack8(*(const LAS u32x4*)(T0 + off_b(t, c8)), x);
#pragma unroll
                for (int e = 0; e < 8; ++e) d += x[e] * sn[8 * c8 + e]; }
            d += __shfl_xor(d, 1); d += __shfl_xor(d, 2); if (part == 0) snq[t] = d; }
        f32x16 aS[2], aN[2];
#pragma unroll
        for (int c = 0; c < 2; ++c)
#pragma unroll
            for (int i = 0; i < 16; ++i) { aS[c][i] = 0.f; aN[c][i] = 0.f; }
#pragma unroll
        for (int s = 0; s < 8; ++s) { const bf16x8 A = *(const LAS bf16x8*)(T0 + off_b(32 * wr + l31, 2 * s + hh));
#pragma unroll
            for (int c = 0; c < 2; ++c) { const bf16x8 B = *(const LAS bf16x8*)(T1 + off_b(64 * wc + 32 * c + l31, 2 * s + hh)); aS[c] = MFMA32(A, B, aS[c]);
                const bf16x8 B2 = *(const LAS bf16x8*)(T3 + off_b(64 * wc + 32 * c + l31, 2 * s + hh)); aN[c] = MFMA32(A, B2, aN[c]); } }
#pragma unroll
        for (int c = 0; c < 2; ++c) { const int s_idx = 64 * wc + 32 * c + l31; const float a_s = sa[s_idx];
#pragma unroll
            for (int i = 0; i < 16; ++i) { const int t = 32 * wr + crow(i, hh); const float w = __expf(fminf(sbm[t] + a_s, 0.f)) * aS[c][i]; aS[c][i] = (s_idx <= t) ? w : 0.f; aN[c][i] *= swin[t]; } }
        LDS_BARRIER();
#pragma unroll
        for (int c = 0; c < 2; ++c) { const int s_idx = 64 * wc + 32 * c + l31;
#pragma unroll
            for (int i = 0; i < 16; ++i) { const int t = 32 * wr + crow(i, hh); *(LAS unsigned short*)(T0 + off_b(t, s_idx >> 3) + 2 * (s_idx & 7)) = (unsigned short)f2bf(aS[c][i]); } }
        LDS_BARRIER();
#pragma unroll
        for (int ks = 0; ks < 8; ++ks) { const bf16x8 A = *(const LAS bf16x8*)(T0 + off_b(32 * wr + l31, 2 * ks + hh));
            s16x4 r0, r1, r2, r3; const int rowb = 16 * ks + 8 * hh + q4; const int cg0 = 2 * wc, cg1 = 2 * wc + 1;
            tr_read4(t2a + off_b(rowb, 4 * cg0 + 2 * blk + (pp >> 1)) + 8 * (pp & 1), t2a + off_b(rowb + 4, 4 * cg0 + 2 * blk + (pp >> 1)) + 8 * (pp & 1),
                     t2a + off_b(rowb, 4 * cg1 + 2 * blk + (pp >> 1)) + 8 * (pp & 1), t2a + off_b(rowb + 4, 4 * cg1 + 2 * blk + (pp >> 1)) + 8 * (pp & 1), r0, r1, r2, r3);
            aN[0] = MFMA32(A, cat4(r0, r1), aN[0]); aN[1] = MFMA32(A, cat4(r2, r3), aN[1]); }
        { const int t = tid >> 2, part = tid & 3; float d = 0.f;
#pragma unroll
            for (int cc = 0; cc < 4; ++cc) { float x[8]; unpack8(*(const LAS u32x4*)(T0 + off_b(t, 4 * part + cc)), x);
#pragma unroll
                for (int e = 0; e < 8; ++e) d += x[e]; }
            d += __shfl_xor(d, 1); d += __shfl_xor(d, 2);
            if (part == 0) { const float den = d + swin[t] * snq[t]; sinv[t] = ret ? 1.0f : __builtin_amdgcn_rcpf(fmaxf(fabsf(den), sem[t])); } }
        LDS_BARRIER();
#pragma unroll
        for (int c = 0; c < 2; ++c) { const int v_idx = 64 * wc + 32 * c + l31;
#pragma unroll
            for (int i = 0; i < 16; ++i) { const int t = 32 * wr + crow(i, hh); *(LAS unsigned short*)(T0 + off_b(t, v_idx >> 3) + 2 * (v_idx & 7)) = (unsigned short)f2bf(aN[c][i] * sinv[t]); } }
        LDS_BARRIER();
        { const int t = tid >> 2, part = tid & 3; float ss = 0.f;
#pragma unroll
            for (int cc = 0; cc < 4; ++cc) { float x[8]; unpack8(*(const LAS u32x4*)(T0 + off_b(t, 4 * part + cc)), x);
#pragma unroll
                for (int e = 0; e < 8; ++e) ss += x[e] * x[e]; }
            ss += __shfl_xor(ss, 1); ss += __shfl_xor(ss, 2);
            const float rn = rsqrtf(ss * (1.0f / 128.0f) + EPS);
#pragma unroll
            for (int cc = 0; cc < 4; ++cc) { const int c8 = 4 * part + cc; float x[8], gt[8], o[8]; unpack8(*(const LAS u32x4*)(T0 + off_b(t, c8)), x);
                unpack8(*(const u32x4*)(U + (m0 + t) * UC + gcol + 8 * c8), gt);
#pragma unroll
                for (int e = 0; e < 8; ++e) { const float sg = sigmoidf_(gt[e]); o[e] = x[e] * rn * ghead[8 * c8 + e] * (ret ? gt[e] * sg : sg); }
                *(u32x4*)(HM + (m0 + t) * DM + ocol + 8 * c8) = pack8(o); } }
        }
        { const int s = tid >> 2, part = tid & 3; const float w = sws[s];
#pragma unroll
            for (int cc = 0; cc < 4; ++cc) { LAS u32x4* ptr = (LAS u32x4*)(T1 + off_b(s, 4 * part + cc)); float x[8]; unpack8(*ptr, x);
#pragma unroll
                for (int e = 0; e < 8; ++e) x[e] *= w;
                *ptr = pack8(x); } }
        if (!ret && tid < 128) sn[tid] *= carry;
        LDS_BARRIER();
#pragma unroll
        for (int c = 0; c < 2; ++c)
#pragma unroll
            for (int i = 0; i < 16; ++i) accC[c][i] *= carry;
#pragma unroll
        for (int ks = 0; ks < 8; ++ks) { const int rowb = 16 * ks + 8 * hh + q4; const int cg0 = 2 * wc, cg1 = 2 * wc + 1;
            s16x4 a0, a1, d0, d1, r0, r1, r2, r3;
            tr_read4(t2a + off_b(rowb, 4 * wr + 2 * blk + (pp >> 1)) + 8 * (pp & 1), t2a + off_b(rowb + 4, 4 * wr + 2 * blk + (pp >> 1)) + 8 * (pp & 1),
                     t1a + off_b(rowb, 4 * cg0 + 2 * blk + (pp >> 1)) + 8 * (pp & 1), t1a + off_b(rowb + 4, 4 * cg0 + 2 * blk + (pp >> 1)) + 8 * (pp & 1), a0, a1, r0, r1);
            tr_read4(t1a + off_b(rowb, 4 * cg1 + 2 * blk + (pp >> 1)) + 8 * (pp & 1), t1a + off_b(rowb + 4, 4 * cg1 + 2 * blk + (pp >> 1)) + 8 * (pp & 1),
                     t1a + off_b(rowb, 4 * cg1 + 2 * blk + (pp >> 1)) + 8 * (pp & 1), t1a + off_b(rowb + 4, 4 * cg1 + 2 * blk + (pp >> 1)) + 8 * (pp & 1), r2, r3, d0, d1);
            const bf16x8 A = cat4(a0, a1);
            accC[0] = MFMA32(A, cat4(r0, r1), accC[0]); accC[1] = MFMA32(A, cat4(r2, r3), accC[1]); }
        if (!ret) { const int kcol_ = tid & 127, r0 = 32 * (tid >> 7); float s = 0.f;
#pragma unroll 8
            for (int r = 0; r < 32; ++r) s += bf2f(*(const LAS unsigned short*)(T1 + off_b(r0 + r, kcol_ >> 3) + 2 * (kcol_ & 7)));
            atomicAdd((float*)(sn + kcol_), s); }
        if constexpr (PASS == 2) {
#pragma unroll
        for (int c = 0; c < 2; ++c) { const int k_idx = 64 * wc + 32 * c + l31;
#pragma unroll
            for (int i = 0; i < 16; ++i) { const int v = 32 * wr + crow(i, hh); *(LAS unsigned short*)(T3 + off_b(v, k_idx >> 3) + 2 * (k_idx & 7)) = (unsigned short)f2bf(accC[c][i]); } }
        }
        m_state = m_new;
        LDS_BARRIER();
    }
    float* out = p.out;
    if constexpr (PASS == 1) {
        float* L = Lws + (size_t)(bh * 3 + seg) * 16384;
#pragma unroll
        for (int c = 0; c < 2; ++c)
#pragma unroll
            for (int ii = 0; ii < 16; ++ii) L[(32 * wr + crow(ii, hh)) * 128 + 64 * wc + 32 * c + l31] = accC[c][ii];
        if (tid < 128) NLws[(size_t)(bh * 3 + seg) * 128 + tid] = sn[tid];
        __syncthreads();
        return;
    }
    if (seg != 3) { __syncthreads(); return; }
#pragma unroll
    for (int c = 0; c < 2; ++c) { const int k_idx = 64 * wc + 32 * c + l31;
#pragma unroll
        for (int i = 0; i < 16; ++i) { const int v = 32 * wr + crow(i, hh);
            if (!ret) out[O_CP + ((size_t)(b * 4 + hd) * 128 + v) * 128 + k_idx] = accC[c][i];
            else out[O_SP + ((size_t)(b * 4 + hd) * 128 + k_idx) * 128 + v] = accC[c][i]; } }
    if (!ret) { if (tid < 128) out[O_NP + (size_t)(b * 4 + hd) * 128 + tid] = sn[tid]; if (tid == 0) out[O_MP + b * 4 + hd] = m_state; }
    __syncthreads();
}
DI void scan_sample_block(const Params& p, LAS unsigned char* lds, int item) {
    const int tid = threadIdx.x, lane = tid & 63, wid = tid >> 6;
    const int b = item >> 3, head8 = item & 7, hd = head8 & 3; const bool ret = head8 >= 4;
    unsigned char* ws = p.ws; float* out = p.out;
    const size_t m = (size_t)NPROMPT + b;
    const bf16_t* ur = (const bf16_t*)(ws + WS_U) + m * UC;
    bf16_t* HM = (bf16_t*)(ws + WS_BFB) + m * DM;
    const float* gates = (const float*)(ws + WS_SMALL) + SM_GATES + m * 8;
    LAS float* sq = (LAS float*)lds; LAS float* sk = sq + 128; LAS float* sv = sq + 256; LAS float* sred = sq + 384; LAS float* spart = sq + 1024;
    const int part = tid & 3;
    if (!ret) {
        const float* C0 = p.in[5] + (size_t)(b * 4 + hd) * 16384 + (tid >> 2) * 128 + 32 * part;
        f32x4 cr[8];
#pragma unroll
        for (int j = 0; j < 8; ++j) cr[j] = ((const f32x4*)C0)[j];
        if (tid < 128) { const float* w_conv = p.in[12]; const float* b_conv = p.in[13]; const float* cst = p.in[4] + (size_t)b * 3 * 1024;
            const int cq = hd * 128 + tid, ck = 512 + cq;
            const float aq = b_conv[cq] + w_conv[cq] * cst[cq] + w_conv[1024 + cq] * cst[1024 + cq] + w_conv[2048 + cq] * cst[2048 + cq] + w_conv[3072 + cq] * bf2f(ur[cq]);
            const float ak = b_conv[ck] + w_conv[ck] * cst[ck] + w_conv[1024 + ck] * cst[1024 + ck] + w_conv[2048 + ck] * cst[2048 + ck] + w_conv[3072 + ck] * bf2f(ur[ck]);
            sq[tid] = aq * sigmoidf_(aq); sk[tid] = ak * sigmoidf_(ak) * 0.08838834764831845f; sv[tid] = bf2f(ur[1024 + hd * 128 + tid]); }
        __syncthreads();
        const int v = tid >> 2;
        float* C1 = out + O_CS + (size_t)(b * 4 + hd) * 16384 + v * 128 + 32 * part;
        const float* n0 = p.in[6] + (size_t)(b * 4 + hd) * 128;
        float qk = 0.f, nq = 0.f, cq = 0.f;
        f32x4 qv[8], kv[8];
#pragma unroll
        for (int j = 0; j < 8; ++j) { qv[j] = *(const LAS f32x4*)(sq + 32 * part + 4 * j); kv[j] = *(const LAS f32x4*)(sk + 32 * part + 4 * j); const f32x4 nn = *(const f32x4*)(n0 + 32 * part + 4 * j);
            qk += (qv[j].x * kv[j].x + qv[j].y * kv[j].y) + (qv[j].z * kv[j].z + qv[j].w * kv[j].w); nq += (qv[j].x * nn.x + qv[j].y * nn.y) + (qv[j].z * nn.z + qv[j].w * nn.w);
            cq += (qv[j].x * cr[j].x + qv[j].y * cr[j].y) + (qv[j].z * cr[j].z + qv[j].w * cr[j].w); }
        qk += __shfl_xor(qk, 1); qk += __shfl_xor(qk, 2); nq += __shfl_xor(nq, 1); nq += __shfl_xor(nq, 2); cq += __shfl_xor(cq, 1); cq += __shfl_xor(cq, 2);
        const float ig = gates[hd], lf = logsigmoidf_(gates[4 + hd]), m0s = p.in[7][b * 4 + hd];
        const float mt = fmaxf(lf + m0s, ig), wts_e = __expf(ig - mt), win = __expf(lf + m0s - mt);
        const float wts = wts_e * qk, den = wts + win * nq, dinv = 1.0f / fmaxf(fabsf(den), __expf(-mt));
        const float vv = sv[v], hv = (wts * vv + win * cq) * dinv, wv = wts_e * vv;
#pragma unroll
        for (int j = 0; j < 8; ++j) ((f32x4*)C1)[j] = cr[j] * win + kv[j] * wv;
        if (tid < 128) out[O_NS + (size_t)(b * 4 + hd) * 128 + tid] = win * n0[tid] + wts_e * sk[tid];
        if (tid == 0) out[O_MS + b * 4 + hd] = mt;
        float ss = (part == 0) ? hv * hv : 0.f; ss = wave_sum(ss);
        if (lane == 0) sred[wid] = ss;
        __syncthreads();
        const float tot = ((sred[0] + sred[1]) + (sred[2] + sred[3])) + ((sred[4] + sred[5]) + (sred[6] + sred[7]));
        const float rn = rsqrtf(tot * (1.0f / 128.0f) + EPS);
        if (part == 0) HM[hd * 128 + v] = (bf16_t)f2bf(hv * rn * p.in[15][hd * 128 + v] * sigmoidf_(bf2f(ur[1536 + hd * 128 + v])));
    } else {
        const int qc = 2048 + hd * 128;
        const float* S0 = p.in[8] + (size_t)(b * 4 + hd) * 16384 + (8 * (tid >> 5)) * 128 + 4 * (tid & 31);
        f32x4 sr[8];
#pragma unroll
        for (int j = 0; j < 8; ++j) sr[j] = *(const f32x4*)(S0 + j * 128);
        if (tid < 64) { float sn_, cs_; const float inv = exp2f(-(float)tid * 0.20762050593046014f); sincos_red(16384.0f * inv, sn_, cs_);
            const float xq1 = bf2f(ur[qc + tid]), xq2 = bf2f(ur[qc + 64 + tid]), xk1 = bf2f(ur[qc + 512 + tid]), xk2 = bf2f(ur[qc + 576 + tid]);
            sq[tid] = xq1 * cs_ - xq2 * sn_; sq[tid + 64] = xq2 * cs_ + xq1 * sn_;
            sk[tid] = (xk1 * cs_ - xk2 * sn_) * 0.08838834764831845f; sk[tid + 64] = (xk2 * cs_ + xk1 * sn_) * 0.08838834764831845f; }
        else if (tid < 192) sv[tid - 64] = bf2f(ur[qc + 1024 + tid - 64]);
        __syncthreads();
        const int kg = tid >> 5, v4 = tid & 31;
        float* S1 = out + O_SS + (size_t)(b * 4 + hd) * 16384 + (8 * kg) * 128 + 4 * v4;
        float qk = 0.f;
#pragma unroll
        for (int j = 0; j < 32; ++j) qk += sq[32 * part + j] * sk[32 * part + j];
        qk += __shfl_xor(qk, 1); qk += __shfl_xor(qk, 2);
        const float gamma = 1.0f - exp2f(-5.0f - (float)hd);
        const f32x4 vv4 = *(const LAS f32x4*)(sv + 4 * v4);
        f32x4 a4 = {0.f, 0.f, 0.f, 0.f};
#pragma unroll
        for (int j = 0; j < 8; ++j) { const float qj = sq[8 * kg + j], kj = sk[8 * kg + j]; a4 += sr[j] * qj; *(f32x4*)(S1 + j * 128) = sr[j] * gamma + vv4 * kj; }
        *(LAS f32x4*)(spart + kg * 128 + 4 * v4) = a4;
        __syncthreads();
        float o = 0.f, ss = 0.f;
        if (tid < 128) { float a = 0.f;
#pragma unroll
            for (int g = 0; g < 16; ++g) a += spart[g * 128 + tid];
            o = qk * sv[tid] + gamma * a; ss = o * o; }
        ss = wave_sum(ss);
        if (lane == 0) sred[wid] = ss;
        __syncthreads();
        const float rn = rsqrtf((sred[0] + sred[1]) * (1.0f / 128.0f) + EPS);
        if (tid < 128) { const float g0 = bf2f(ur[qc + 1536 + tid]); HM[512 + hd * 128 + tid] = (bf16_t)f2bf(o * rn * p.in[16][hd * 128 + tid] * g0 * sigmoidf_(g0)); }
    }
    __syncthreads();
}
DI void scan_sample_two(const Params& p, LAS unsigned char* lds, int item0) {
    constexpr int NI = 2;
    const int tid = threadIdx.x, lane = tid & 63, wid = tid >> 6, part = tid & 3;
    const int head8 = item0 & 7, hd = head8 & 3; const bool ret = head8 >= 4;
    unsigned char* ws = p.ws; float* out = p.out;
    LAS float* fb = (LAS float*)lds;
    int bb[NI]; const bf16_t* ur[NI]; bf16_t* HM[NI];
#pragma unroll
    for (int i = 0; i < NI; ++i) { bb[i] = (item0 >> 3) + 32 * i; const size_t m = (size_t)NPROMPT + bb[i]; ur[i] = (const bf16_t*)(ws + WS_U) + m * UC; HM[i] = (bf16_t*)(ws + WS_BFB) + m * DM; }
    if (!ret) {
        f32x4 cr[NI][8]; float g_i[NI], g_f[NI], m0s[NI], n0t[NI], mov[NI];
        float cin[NI][9];
        const int cq = hd * 128 + (tid & 127), ck = 512 + cq;
#pragma unroll
        for (int i = 0; i < NI; ++i) { const float* C0 = p.in[5] + (size_t)(bb[i] * 4 + hd) * 16384 + (tid >> 2) * 128 + 32 * part;
#pragma unroll
            for (int j = 0; j < 8; ++j) cr[i][j] = ((const f32x4*)C0)[j];
            const float* gates = (const float*)(ws + WS_SMALL) + SM_GATES + ((size_t)NPROMPT + bb[i]) * 8;
            g_i[i] = gates[hd]; g_f[i] = gates[4 + hd]; m0s[i] = p.in[7][bb[i] * 4 + hd]; n0t[i] = p.in[6][(size_t)(bb[i] * 4 + hd) * 128 + (tid & 127)];
            mov[i] = bf2f(ur[i][1536 + hd * 128 + (tid >> 2)]);
            const float* cst = p.in[4] + (size_t)bb[i] * 3 * 1024;
            cin[i][0] = cst[cq]; cin[i][1] = cst[1024 + cq]; cin[i][2] = cst[2048 + cq]; cin[i][3] = bf2f(ur[i][cq]);
            cin[i][4] = cst[ck]; cin[i][5] = cst[1024 + ck]; cin[i][6] = cst[2048 + ck]; cin[i][7] = bf2f(ur[i][ck]); cin[i][8] = bf2f(ur[i][1024 + hd * 128 + (tid & 127)]); }
        const float* w_conv = p.in[12]; const float* b_conv = p.in[13];
        const float wq0 = w_conv[cq], wq1 = w_conv[1024 + cq], wq2 = w_conv[2048 + cq], wq3 = w_conv[3072 + cq], bq_ = b_conv[cq];
        const float wk0 = w_conv[ck], wk1 = w_conv[1024 + ck], wk2 = w_conv[2048 + ck], wk3 = w_conv[3072 + ck], bk_ = b_conv[ck];
        const float ghv = p.in[15][hd * 128 + (tid >> 2)];
        if (tid < 128) {
#pragma unroll
            for (int i = 0; i < NI; ++i) { LAS float* f = fb + 512 * i;
                const float aq = bq_ + wq0 * cin[i][0] + wq1 * cin[i][1] + wq2 * cin[i][2] + wq3 * cin[i][3];
                const float ak = bk_ + wk0 * cin[i][4] + wk1 * cin[i][5] + wk2 * cin[i][6] + wk3 * cin[i][7];
                f[tid] = aq * sigmoidf_(aq); f[128 + tid] = ak * sigmoidf_(ak) * 0.08838834764831845f; f[256 + tid] = cin[i][8]; f[384 + tid] = n0t[i]; } }
        LDS_BARRIER();
        const int v = tid >> 2; float hv[NI];
#pragma unroll
        for (int i = 0; i < NI; ++i) { const LAS float* f = fb + 512 * i;
            float* C1 = out + O_CS + (size_t)(bb[i] * 4 + hd) * 16384 + v * 128 + 32 * part;
            float qk = 0.f, nq = 0.f, cqs = 0.f; f32x4 kv[8];
#pragma unroll
            for (int j = 0; j < 8; ++j) { const f32x4 qv = *(const LAS f32x4*)(f + 32 * part + 4 * j); kv[j] = *(const LAS f32x4*)(f + 128 + 32 * part + 4 * j); const f32x4 nn = *(const LAS f32x4*)(f + 384 + 32 * part + 4 * j);
                qk += (qv.x * kv[j].x + qv.y * kv[j].y) + (qv.z * kv[j].z + qv.w * kv[j].w); nq += (qv.x * nn.x + qv.y * nn.y) + (qv.z * nn.z + qv.w * nn.w);
                cqs += (qv.x * cr[i][j].x + qv.y * cr[i][j].y) + (qv.z * cr[i][j].z + qv.w * cr[i][j].w); }
            qk += __shfl_xor(qk, 1); qk += __shfl_xor(qk, 2); nq += __shfl_xor(nq, 1); nq += __shfl_xor(nq, 2); cqs += __shfl_xor(cqs, 1); cqs += __shfl_xor(cqs, 2);
            const float ig = g_i[i], lf = logsigmoidf_(g_f[i]);
            const float mt = fmaxf(lf + m0s[i], ig), wts_e = __expf(ig - mt), win = __expf(lf + m0s[i] - mt);
            const float wts = wts_e * qk, den = wts + win * nq, dinv = 1.0f / fmaxf(fabsf(den), __expf(-mt));
            const float vv = f[256 + v], wv = wts_e * vv; hv[i] = (wts * vv + win * cqs) * dinv;
#pragma unroll
            for (int j = 0; j < 8; ++j) ((f32x4*)C1)[j] = cr[i][j] * win + kv[j] * wv;
            if (tid < 128) out[O_NS + (size_t)(bb[i] * 4 + hd) * 128 + tid] = win * n0t[i] + wts_e * f[128 + tid];
            if (tid == 0) out[O_MS + bb[i] * 4 + hd] = mt;
            float ss = (part == 0) ? hv[i] * hv[i] : 0.f; ss = wave_sum(ss);
            if (lane == 0) fb[1024 + 8 * i + wid] = ss; }
        LDS_BARRIER();
#pragma unroll
        for (int i = 0; i < NI; ++i) { const LAS float* sr_ = fb + 1024 + 8 * i;
            const float tot = ((sr_[0] + sr_[1]) + (sr_[2] + sr_[3])) + ((sr_[4] + sr_[5]) + (sr_[6] + sr_[7]));
            const float rn = rsqrtf(tot * (1.0f / 128.0f) + EPS);
            if (part == 0) HM[i][hd * 128 + v] = (bf16_t)f2bf(hv[i] * rn * ghv * sigmoidf_(mov[i])); }
    } else {
        const int qc = 2048 + hd * 128, kg = tid >> 5, v4 = tid & 31;
        f32x4 sr[NI][8]; float rin[NI][5], rgv[NI];
#pragma unroll
        for (int i = 0; i < NI; ++i) { const float* S0 = p.in[8] + (size_t)(bb[i] * 4 + hd) * 16384 + (8 * kg) * 128 + 4 * v4;
#pragma unroll
            for (int j = 0; j < 8; ++j) sr[i][j] = *(const f32x4*)(S0 + j * 128);
            rgv[i] = bf2f(ur[i][qc + 1536 + (tid & 127)]);
            const int l6 = tid & 63;
            rin[i][0] = bf2f(ur[i][qc + l6]); rin[i][1] = bf2f(ur[i][qc + 64 + l6]); rin[i][2] = bf2f(ur[i][qc + 512 + l6]); rin[i][3] = bf2f(ur[i][qc + 576 + l6]); rin[i][4] = bf2f(ur[i][qc + 1024 + (tid & 127)]); }
        const float ghr = p.in[16][hd * 128 + (tid & 127)];
        if (tid < 64) { float sn_, cs_; const float inv = exp2f(-(float)tid * 0.20762050593046014f); sincos_red(16384.0f * inv, sn_, cs_);
#pragma unroll
            for (int i = 0; i < NI; ++i) { LAS float* f = fb + 512 * i;
                f[tid] = rin[i][0] * cs_ - rin[i][1] * sn_; f[tid + 64] = rin[i][1] * cs_ + rin[i][0] * sn_;
                f[128 + tid] = (rin[i][2] * cs_ - rin[i][3] * sn_) * 0.08838834764831845f; f[128 + tid + 64] = (rin[i][3] * cs_ + rin[i][2] * sn_) * 0.08838834764831845f; } }
        if (tid >= 128 && tid < 256) {
#pragma unroll
            for (int i = 0; i < NI; ++i) fb[512 * i + 256 + (tid & 127)] = rin[i][4]; }
        LDS_BARRIER();
        const float gamma = 1.0f - exp2f(-5.0f - (float)hd);
        float qk[NI];
#pragma unroll
        for (int i = 0; i < NI; ++i) { const LAS float* f = fb + 512 * i;
            float* S1 = out + O_SS + (size_t)(bb[i] * 4 + hd) * 16384 + (8 * kg) * 128 + 4 * v4;
            float q_ = 0.f;
#pragma unroll
            for (int j = 0; j < 32; ++j) q_ += f[32 * part + j] * f[128 + 32 * part + j];
            q_ += __shfl_xor(q_, 1); q_ += __shfl_xor(q_, 2); qk[i] = q_;
            const f32x4 vv4 = *(const LAS f32x4*)(f + 256 + 4 * v4);
            f32x4 a4 = {0.f, 0.f, 0.f, 0.f};
#pragma unroll
            for (int j = 0; j < 8; ++j) { const float qj = f[8 * kg + j], kj = f[128 + 8 * kg + j]; a4 += sr[i][j] * qj; *(f32x4*)(S1 + j * 128) = sr[i][j] * gamma + vv4 * kj; }
            *(LAS f32x4*)(fb + 2048 + 2048 * i + kg * 128 + 4 * v4) = a4; }
        LDS_BARRIER();
        float o[NI];
#pragma unroll
        for (int i = 0; i < NI; ++i) { float ss = 0.f; o[i] = 0.f;
            if (tid < 128) { float a = 0.f;
#pragma unroll
                for (int g = 0; g < 16; ++g) a += fb[2048 + 2048 * i + g * 128 + tid];
                o[i] = qk[i] * fb[512 * i + 256 + tid] + gamma * a; ss = o[i] * o[i]; }
            ss = wave_sum(ss);
            if (lane == 0) fb[1024 + 8 * i + wid] = ss; }
        LDS_BARRIER();
#pragma unroll
        for (int i = 0; i < NI; ++i) { const float rn = rsqrtf((fb[1024 + 8 * i] + fb[1024 + 8 * i + 1]) * (1.0f / 128.0f) + EPS);
            if (tid < 128) { const float g0 = rgv[i]; HM[i][512 + hd * 128 + tid] = (bf16_t)f2bf(o[i] * rn * ghr * g0 * sigmoidf_(g0)); } }
    }
    LDS_BARRIER();
}
DI void conv_outputs(const Params& p, int idx0, int stride) {
    const bf16_t* U = (const bf16_t*)(p.ws + WS_U); float* out = p.out;
    for (int i = idx0; i < 8 * 3 * 1024; i += stride) { const int b = i / 3072, j = (i / 1024) % 3, c = i & 1023; out[O_CONVP + i] = bf2f(U[((size_t)b * 2048 + 2045 + j) * UC + c]); }
    for (int i = idx0; i < 128 * 3 * 1024; i += stride) { const int b = i / 3072, j = (i / 1024) % 3, c = i & 1023;
        out[O_CONVS + i] = (j < 2) ? p.in[4][(size_t)b * 3072 + (j + 1) * 1024 + c] : bf2f(U[((size_t)NPROMPT + b) * UC + c]); }
}

DI void attn_prompt_unit(const Params& p, LAS unsigned char* lds, int u) {
    const int tid = threadIdx.x, wid = __builtin_amdgcn_readfirstlane(tid >> 6);
    int lane = tid & 63, hh = lane >> 5, l31 = lane & 31;
    const int b = u >> 5, h = (u >> 3) & 3, qt = u & 7;
    unsigned char* ws = p.ws;
    const bf16_t* Q = (const bf16_t*)(ws + WS_BFA); bf16_t* O = (bf16_t*)(ws + WS_BFB);
    const bf16_t* KP = (const bf16_t*)(ws + WS_KP) + (size_t)(b * 4 + h) * 65536; const bf16_t* VP = (const bf16_t*)(ws + WS_VP) + (size_t)(b * 4 + h) * 65536;
    const size_t mrow = (size_t)b * 2048 + qt * 256 + 32 * wid;
    const unsigned la = (unsigned)(uintptr_t)lds;
    int blk = (lane >> 4) & 1, q4 = (lane & 15) >> 2, pp = lane & 3;
#pragma unroll
    for (int i = 0; i < 16; ++i) { const int idx = tid + 512 * i, row = idx >> 5, c8 = idx & 31; *(LAS u32x4*)(lds + (c8 >> 4) * 65536 + off_b(row, c8 & 15)) = *(const u32x4*)(KP + row * 256 + 8 * c8); }
    __syncthreads();
    f32x16 acc[8];
#pragma unroll
    for (int c = 0; c < 8; ++c)
#pragma unroll
        for (int i = 0; i < 16; ++i) acc[c][i] = 0.f;
#pragma unroll 1
    for (int sh = 0; sh < 4; ++sh) {
        lane = tid & 63; asm volatile("" : "+v"(lane)); hh = lane >> 5; l31 = lane & 31;
        bf16x8 bq[4];
#pragma unroll
        for (int s = 0; s < 4; ++s) bq[s] = *(const bf16x8*)(Q + (mrow + l31) * DM + h * 256 + 16 * (4 * sh + s) + 8 * hh);
#pragma unroll
        for (int s = 0; s < 4; ++s) { const int c16 = 2 * (4 * sh + s) + hh;
#pragma unroll
            for (int c = 0; c < 8; ++c) { const bf16x8 A = *(const LAS bf16x8*)(lds + (c16 >> 4) * 65536 + off_b(32 * c + l31, c16 & 15)); acc[c] = MFMA32(A, bq[s], acc[c]); } }
    }
    float mx = -INFINITY;
#pragma unroll
    for (int c = 0; c < 8; ++c)
#pragma unroll
        for (int i = 0; i < 16; ++i) mx = fmaxf(mx, acc[c][i]);
    mx = fmaxf(mx, __shfl_xor(mx, 32));
    float sum = 0.f;
    bf16x8 pf[8][2];
#pragma unroll
    for (int c = 0; c < 8; ++c) {
        float e[16];
#pragma unroll
        for (int i = 0; i < 16; ++i) { e[i] = __expf(acc[c][i] - mx); sum += e[i]; }
#pragma unroll
        for (int s2 = 0; s2 < 2; ++s2) { u32x4 w; w.x = pk2(e[8 * s2], e[8 * s2 + 1]); w.y = pk2(e[8 * s2 + 2], e[8 * s2 + 3]); w.z = pk2(e[8 * s2 + 4], e[8 * s2 + 5]); w.w = pk2(e[8 * s2 + 6], e[8 * s2 + 7]);
            pf[c][s2] = __builtin_bit_cast(bf16x8, w); }
    }
    sum += __shfl_xor(sum, 32);
    float rinv[16];
#pragma unroll
    for (int i = 0; i < 16; ++i) rinv[i] = 1.0f / __shfl(sum, crow(i, hh));
    __syncthreads();
#pragma unroll
    for (int i = 0; i < 16; ++i) { const int idx = tid + 512 * i, row = idx >> 5, c8 = idx & 31; *(LAS u32x4*)(lds + (c8 >> 4) * 65536 + off_b(row, c8 & 15)) = *(const u32x4*)(VP + row * 256 + 8 * c8); }
    __syncthreads();
#pragma unroll 1
    for (int dt = 0; dt < 8; ++dt) {
        lane = tid & 63; asm volatile("" : "+v"(lane)); hh = lane >> 5; l31 = lane & 31; blk = (lane >> 4) & 1; q4 = (lane & 15) >> 2; pp = lane & 3;
        f32x16 o;
#pragma unroll
        for (int i = 0; i < 16; ++i) o[i] = 0.f;
        const unsigned base = la + (dt >> 2) * 65536; const int chk = 4 * (dt & 3) + 2 * blk + (pp >> 1); const unsigned sub8 = 8 * (pp & 1);
#pragma unroll
        for (int c = 0; c < 8; ++c) {
            const int r0 = 32 * c + 4 * hh + q4; s16x4 x0, x1, x2, x3;
            tr_read4(base + off_b(r0, chk) + sub8, base + off_b(r0 + 8, chk) + sub8, base + off_b(r0 + 16, chk) + sub8, base + off_b(r0 + 24, chk) + sub8, x0, x1, x2, x3);
            o = MFMA32(pf[c][0], cat4(x0, x1), o); o = MFMA32(pf[c][1], cat4(x2, x3), o); }
#pragma unroll
        for (int i = 0; i < 16; ++i) O[(mrow + crow(i, hh)) * DM + h * 256 + 32 * dt + l31] = (bf16_t)f2bf(o[i] * rinv[i]);
    }
    __syncthreads();
}
DI void attn_sample_pair(const Params& p, LAS unsigned char* lds, int it0) {
    const int tid = threadIdx.x, lane = tid & 63, wid = tid >> 6, sub = wid >> 2, w4 = wid & 3, g = lane >> 4, i16 = lane & 15;
    const int it = it0 + sub, b = it >> 2, h = it & 3;
    const bf16_t* Q = (const bf16_t*)(p.ws + WS_BFA) + ((size_t)NPROMPT + b) * DM + h * 256;
    LAS float* xm = (LAS float*)(lds + 131072); LAS float* xs = xm + 8; LAS float* part = xm + 16;
    f32x4 q[4];
#pragma unroll
    for (int j = 0; j < 4; ++j) { const u32x2 qw = *(const u32x2*)(Q + 4 * (i16 + 16 * j)); q[j].x = bflo(qw.x); q[j].y = bfhi(qw.x); q[j].z = bflo(qw.y); q[j].w = bfhi(qw.y); }
    const float* ck = p.in[2] + (((size_t)b * 256 + 64 * w4 + g) * 4 + h) * 256 + 4 * i16; const float* cv = p.in[3] + (((size_t)b * 256 + 64 * w4 + g) * 4 + h) * 256 + 4 * i16;
    float sc[16];
#pragma unroll
    for (int s = 0; s < 16; ++s) { float d = 0.f;
#pragma unroll
        for (int j = 0; j < 4; ++j) { const f32x4 kr = *(const f32x4*)(ck + (size_t)s * 4096 + 64 * j); d += (kr.x * q[j].x + kr.y * q[j].y) + (kr.z * q[j].z + kr.w * q[j].w); }
        d += __shfl_xor(d, 1); d += __shfl_xor(d, 2); d += __shfl_xor(d, 4); d += __shfl_xor(d, 8); sc[s] = d; }
    float lm = sc[0];
#pragma unroll
    for (int s = 1; s < 16; ++s) lm = fmaxf(lm, sc[s]);
    lm = fmaxf(lm, __shfl_xor(lm, 16)); lm = fmaxf(lm, __shfl_xor(lm, 32));
    if (lane == 0) xm[sub * 4 + w4] = lm;
    __syncthreads();
    const float gm = fmaxf(fmaxf(xm[sub * 4], xm[sub * 4 + 1]), fmaxf(xm[sub * 4 + 2], xm[sub * 4 + 3]));
    float ls = 0.f;
#pragma unroll
    for (int s = 0; s < 16; ++s) { sc[s] = __expf(sc[s] - gm); ls += sc[s]; }
    ls += __shfl_xor(ls, 16); ls += __shfl_xor(ls, 32);
    if (lane == 0) xs[sub * 4 + w4] = ls;
    f32x4 o[4];
#pragma unroll
    for (int j = 0; j < 4; ++j) o[j] = (f32x4){0.f, 0.f, 0.f, 0.f};
#pragma unroll
    for (int s = 0; s < 16; ++s)
#pragma unroll
        for (int j = 0; j < 4; ++j) { const f32x4 vr = *(const f32x4*)(cv + (size_t)s * 4096 + 64 * j); o[j] += vr * sc[s]; }
#pragma unroll
    for (int j = 0; j < 4; ++j)
#pragma unroll
        for (int e = 0; e < 4; ++e) { float t = o[j][e]; t += __shfl_xor(t, 16); t += __shfl_xor(t, 32); o[j][e] = t; }
    if (g == 0) {
#pragma unroll
        for (int j = 0; j < 4; ++j) *(LAS f32x4*)(part + (sub * 4 + w4) * 256 + 4 * (i16 + 16 * j)) = o[j]; }
    __syncthreads();
    { const int d = tid & 255, s2 = tid >> 8; const float gs = (xs[s2 * 4] + xs[s2 * 4 + 1]) + (xs[s2 * 4 + 2] + xs[s2 * 4 + 3]);
      const float v = (part[(s2 * 4) * 256 + d] + part[(s2 * 4 + 1) * 256 + d]) + (part[(s2 * 4 + 2) * 256 + d] + part[(s2 * 4 + 3) * 256 + d]);
      const int it2 = it0 + s2; bf16_t* O2 = (bf16_t*)(p.ws + WS_BFB) + ((size_t)NPROMPT + (it2 >> 2)) * DM + (it2 & 3) * 256; O2[d] = (bf16_t)f2bf(v / gs); }
    __syncthreads();
}
DI void final_norm(const Params& p) {
    const int lane = threadIdx.x & 63, gw = blockIdx.x * 8 + (threadIdx.x >> 6), NGW = gridDim.x * 8;
    const bf16_t* X3 = (const bf16_t*)(p.ws + WS_BFA); const float* rs3 = (const float*)(p.ws + WS_SMALL) + SM_RS3; const float* gf = p.in[28];
    f32x4 g[4];
#pragma unroll
    for (int j = 0; j < 4; ++j) g[j] = ((const f32x4*)gf)[4 * lane + j];
    constexpr int RB = 9, NGRP = (NVALID + RB - 1) / RB;
#pragma unroll 1
    for (int gi = gw; gi < NGRP; gi += NGW) {
        u32x4 w0[RB], w1[RB]; float rr[RB];
#pragma unroll
        for (int r = 0; r < RB; ++r) { int m = gi * RB + r; if (m >= NVALID) m = NVALID - 1; const u32x4* xr = (const u32x4*)(X3 + (size_t)m * DM) + 2 * lane; w0[r] = xr[0]; w1[r] = xr[1]; rr[r] = rs3[m]; }
#pragma unroll
        for (int r = 0; r < RB; ++r) { const int m = gi * RB + r; if (m >= NVALID) continue;
            const float sc = rsqrtf(rr[r] * (1.0f / 1024.0f) + EPS);
            f32x4* orow = (f32x4*)(p.out + (m < NPROMPT ? O_YP + (size_t)m * DM : O_YS + (size_t)(m - NPROMPT) * DM)) + 4 * lane;
            float x[16]; { float t[8]; unpack8(w0[r], t);
#pragma unroll
                for (int e = 0; e < 8; ++e) x[e] = t[e]; unpack8(w1[r], t);
#pragma unroll
                for (int e = 0; e < 8; ++e) x[8 + e] = t[e]; }
#pragma unroll
            for (int j = 0; j < 4; ++j) { f32x4 o; o.x = x[4 * j] * sc * g[j].x; o.y = x[4 * j + 1] * sc * g[j].y; o.z = x[4 * j + 2] * sc * g[j].z; o.w = x[4 * j + 3] * sc * g[j].w; orow[j] = o; } }
    }
}
struct SkScale { bf16_t* O; int ldc; const float* ss; float post;
    DI void operator()(float v0, float v1, int r, int c, int lane) const { const float sc = rsqrtf(ss[r] * (1.0f / 1024.0f) + EPS) * post; *(unsigned*)(O + (size_t)r * ldc + c) = pk2(v0 * sc, v1 * sc); } };
struct SkRes { const float* resf; const bf16_t* resb; bf16_t* outb; float* rs;
    DI void operator()(float v0, float v1, int r, int c, int lane) const { const size_t o = (size_t)r * 1024 + c;
        if (resf) { v0 += resf[o]; v1 += resf[o + 1]; } else { const unsigned w = *(const unsigned*)(resb + o); v0 += bflo(w); v1 += bfhi(w); }
        *(unsigned*)(outb + o) = pk2(v0, v1);
        float q = v0 * v0 + v1 * v1; q += __shfl_xor(q, 1); q += __shfl_xor(q, 2); q += __shfl_xor(q, 4); q += __shfl_xor(q, 8);
        if ((lane & 15) == 0) atomicAdd(rs + r, q); } };
template <class Epi> DI void skinny_gemm(LAS unsigned char* lds, const bf16_t* A, int lda, const bf16_t* Bt, int K, int N, const Epi& E) {
    const int tid = threadIdx.x, lane = tid & 63, wid = tid >> 6, l31 = lane & 31, hh = lane >> 5, G = gridDim.x;
    const int njobs = 4 * (N / 32), kw = K / 8;
    LAS float* part = (LAS float*)lds;
    for (int j = blockIdx.x; j < njobs; j += G) {
        const int rt = j & 3, ct = j >> 2;
        const bf16_t* ap = A + (size_t)(32 * rt + l31) * lda + wid * kw + 8 * hh; const bf16_t* bp = Bt + (size_t)(32 * ct + l31) * K + wid * kw + 8 * hh;
        f32x16 acc;
#pragma unroll
        for (int i = 0; i < 16; ++i) acc[i] = 0.f;
        int k = 0;
#pragma unroll 1
        for (; k + 128 <= kw; k += 128) { bf16x8 a[8], bb[8];
#pragma unroll
            for (int u = 0; u < 8; ++u) { a[u] = *(const bf16x8*)(ap + k + 16 * u); bb[u] = *(const bf16x8*)(bp + k + 16 * u); }
#pragma unroll
            for (int u = 0; u < 8; ++u) acc = MFMA32(a[u], bb[u], acc); }
#pragma unroll 1
        for (; k < kw; k += 16) { const bf16x8 a = *(const bf16x8*)(ap + k), bb = *(const bf16x8*)(bp + k); acc = MFMA32(a, bb, acc); }
#pragma unroll
        for (int i = 0; i < 16; ++i) part[wid * 1024 + crow(i, hh) * 32 + l31] = acc[i];
        __syncthreads();
        { const int e0 = 2 * tid, r = e0 >> 5, c = e0 & 31; float v0 = 0.f, v1 = 0.f;
#pragma unroll
            for (int w = 0; w < 8; ++w) { const f32x2 t = *(const LAS f32x2*)(part + w * 1024 + e0); v0 += t.x; v1 += t.y; }
            E(v0, v1, 32 * rt + r, 32 * ct + c, lane); }
        __syncthreads();
    }
}
#define XB_TMO      128
#define XB_XCNT(j)  (256  + 64 * (j))
#define XB_XSUB(j)  (1280 + 64 * (j))
#define XB_XGEN(j)  (2304 + 64 * (j))
#define XB_TOP      3328
#define XB_TOPGEN   3392
#define XCD_BAR_WORDS 3456
#define XB_SPIN_CAP (1u << 18)

__device__ __forceinline__ unsigned xb_ld(unsigned* p)              { return __hip_atomic_load(p, __ATOMIC_RELAXED, __HIP_MEMORY_SCOPE_AGENT); }
__device__ __forceinline__ unsigned xb_add(unsigned* p, unsigned v) { return __hip_atomic_fetch_add(p, v, __ATOMIC_RELAXED, __HIP_MEMORY_SCOPE_AGENT); }
__device__ __forceinline__ unsigned xb_xcc_id() { return (unsigned)__builtin_amdgcn_s_getreg((3 << 11) | 20) & 0xFu; }
#define XB_SPIN(cond, bar) do { unsigned _sp = 0; while (cond) { __builtin_amdgcn_s_sleep(1); \
    if ((++_sp & 255u) == 0u) { if (xb_ld(&(bar)[XB_TMO])) break; if (_sp > XB_SPIN_CAP) { atomicAdd(&(bar)[XB_TMO], 1u); break; } } } } while (0)

struct XcdBarrier {
    unsigned* bar; unsigned x;
    volatile LAS unsigned* st;
};

__device__ __forceinline__ XcdBarrier xcd_barrier_post(unsigned* bar, volatile LAS unsigned* st) {
    XcdBarrier b; b.bar = bar; b.x = xb_xcc_id(); b.st = st;
    if (threadIdx.x == 0) (void)xb_add(&bar[XB_XCNT(b.x)], 1u);
    return b;
}
__device__ __forceinline__ void xcd_barrier_complete(unsigned* bar, unsigned x, unsigned& nloc, unsigned& nx) {
    const unsigned G = gridDim.x * gridDim.y * gridDim.z;
    unsigned sum, cnt, mine, sp = 0u;
    for (;;) {
        sum = 0u; cnt = 0u; mine = 0u;
#pragma unroll
        for (unsigned j = 0; j < 16; ++j) { const unsigned c = xb_ld(&bar[XB_XCNT(j)]); sum += c; cnt += (c > 0u) ? 1u : 0u; mine = (j == x) ? c : mine; }
        if (sum == G) break;
        __builtin_amdgcn_s_sleep(1);
        if ((++sp & 255u) == 0u) { if (xb_ld(&bar[XB_TMO])) break; if (sp > XB_SPIN_CAP) { atomicAdd(&bar[XB_TMO], 1u); break; } }
    }
    nloc = mine > 0u ? mine : 1u; nx = cnt > 0u ? cnt : 1u;
}

__device__ __forceinline__ void xcd_barrier(const XcdBarrier& b) {
    asm volatile("s_waitcnt vmcnt(0)" ::: "memory");
    __syncthreads();
    if (threadIdx.x == 0) {
        unsigned* bar = b.bar;
        __builtin_amdgcn_s_waitcnt(0);
        unsigned nloc = b.st[0], nx = b.st[1];
        if (nloc == 0u) { xcd_barrier_complete(bar, b.x, nloc, nx); b.st[0] = nloc; b.st[1] = nx; }
        const unsigned old = xb_add(&bar[XB_XSUB(b.x)], 1u);
        const unsigned gen = old / nloc;
        if (old + 1u == (gen + 1u) * nloc) {
            __builtin_amdgcn_fence(__ATOMIC_RELEASE, "agent");
            asm volatile("s_waitcnt vmcnt(0)" ::: "memory");
            const unsigned og = xb_add(&bar[XB_TOP], 1u);
            const unsigned tg = og / nx;
            if (og + 1u == (tg + 1u) * nx) xb_add(&bar[XB_TOPGEN], 1u);
            else XB_SPIN(xb_ld(&bar[XB_TOPGEN]) == tg, bar);
            __builtin_amdgcn_fence(__ATOMIC_ACQUIRE, "agent");
            xb_add(&bar[XB_XGEN(b.x)], 1u);
            asm volatile("s_waitcnt vmcnt(0)" ::: "memory");
        } else {
            XB_SPIN(xb_ld(&bar[XB_XGEN(b.x)]) == gen, bar);
            __builtin_amdgcn_fence(__ATOMIC_ACQUIRE, "agent");
            asm volatile("s_waitcnt vmcnt(0)" ::: "memory");
        }
    }
    __syncthreads();
}

__global__ void __launch_bounds__(512, 2) fwd_megakernel(Params p) {
    extern __shared__ __attribute__((aligned(16))) unsigned char lds_raw[];
    LAS unsigned char* lds = (LAS unsigned char*)lds_raw;
    cg::grid_group grid = cg::this_grid();
    unsigned char* ws = p.ws;
    float* sm = (float*)(ws + WS_SMALL);
    const int lo = p.ph_lo, hi = p.ph_hi;
    volatile LAS unsigned* bst = (volatile LAS unsigned*)(lds + LDS_BYTES - 64);
    if (threadIdx.x < 2) bst[threadIdx.x] = 0u;
    __syncthreads();
    const XcdBarrier bar = xcd_barrier_post((unsigned*)(ws + WS_BAR), bst);
    if (lo < 0) grid.sync();
#ifndef PHMASK
#define PHMASK 0x7ff
#endif
#define IN(k) (((PHMASK >> (k)) & 1) && lo <= (k) && (k) < hi)
#define SEAM(k) do { if (IN(k) && IN((k) + 1)) xcd_barrier(bar); } while (0)
#ifndef RPT
#define RPT 0
#endif
#define NREP(k) (((RPT >> (k)) & 1) ? 2 : 1)
    const int G = gridDim.x, bx = blockIdx.x;
    if (IN(0)) for (int rep = 0; rep < NREP(0); ++rep) { p0_prologue(p, lds); __syncthreads(); } SEAM(0);
    if (IN(1)) for (int rep = 0; rep < NREP(1); ++rep) {
        pg8::Gemm g{(const bf16_t*)(ws + WS_BFA), (const bf16_t*)(ws + WS_WIN), NPROMPT, UC, DM}; pg8::StaticOrder S; S.init(NPROMPT, UC, G, bx);
        pg8::EpiScaleBf16 E{(bf16_t*)(ws + WS_U), UC, sm + SM_SS0, 1.0f};
        pg8::gemm_phase<pg8::EpiScaleBf16, pg8::StaticOrder, true, true>(lds, g, S, E);
        skinny_gemm(lds, (const bf16_t*)(ws + WS_BFA) + (size_t)NPROMPT * DM, DM, (const bf16_t*)(ws + WS_WIN), DM, UC, SkScale{(bf16_t*)(ws + WS_U) + (size_t)NPROMPT * UC, UC, sm + SM_SS0 + NPROMPT, 1.0f});
    } SEAM(1);
    if (IN(2)) {
        const bool items_first = (G == 256) && (bx < 192) && (((bx >> 3) & 1) != 0);
        if (items_first) { scan_sample_two(p, lds, bx); scan_sample_two(p, lds, bx + 512); }
        if (bx < 192) { scan_prompt<1>(p, lds, bx & 63, bx >> 6); if (RPT & 0x2000) scan_prompt<1>(p, lds, bx & 63, bx >> 6); }
        else {
            pg8::Gemm g{(const bf16_t*)(ws + WS_MEMB), (const bf16_t*)(ws + WS_WCKV), 2048, 2048, DM}; pg8::SubOrder S{bx - 192, 64, 8};
            pg8::EpiKV E{sm + SM_SSM, p.out + O_MK, p.out + O_MV, (bf16_t*)(ws + WS_KP), (bf16_t*)(ws + WS_VP)};
            pg8::gemm_phase<pg8::EpiKV, pg8::SubOrder, false, true>(lds, g, S, E);
        }
        if (items_first) { }
        else if (G == 256) { scan_sample_two(p, lds, bx); scan_sample_two(p, lds, bx + 512); }
        else for (int item = bx; item < 1024; item += G) scan_sample_block(p, lds, item);
        conv_outputs(p, bx * 512 + threadIdx.x, G * 512);
    } SEAM(2);
    if (IN(3)) { scan_prompt<2>(p, lds, bx & 63, bx >> 6); if (RPT & 0x1000) scan_prompt<2>(p, lds, bx & 63, bx >> 6); } SEAM(3);
    if (IN(4)) for (int rep = 0; rep < NREP(4); ++rep) {
        pg8::Gemm g{(const bf16_t*)(ws + WS_BFB), (const bf16_t*)(ws + WS_WOUT), NPROMPT, DM, DM}; pg8::StaticOrder S; S.init(NPROMPT, DM, G, bx);
        pg8::EpiResB<true> E{p.in[0], nullptr, (bf16_t*)(ws + WS_BFC), rep ? nullptr : sm + SM_RS1};
        pg8::gemm_phase<pg8::EpiResB<true>, pg8::StaticOrder, true, true>(lds, g, S, E);
        if (rep == 0) skinny_gemm(lds, (const bf16_t*)(ws + WS_BFB) + (size_t)NPROMPT * DM, DM, (const bf16_t*)(ws + WS_WOUT), DM, DM, SkRes{p.in[1], nullptr, (bf16_t*)(ws + WS_BFC) + (size_t)NPROMPT * DM, sm + SM_RS1 + NPROMPT});
    } SEAM(4);
    if (IN(5)) for (int rep = 0; rep < NREP(5); ++rep) {
        pg8::Gemm g{(const bf16_t*)(ws + WS_BFC), (const bf16_t*)(ws + WS_WCQ), NPROMPT, DM, DM}; pg8::StaticOrder S; S.init(NPROMPT, DM, G, bx);
        pg8::EpiScaleBf16 E{(bf16_t*)(ws + WS_BFA), DM, sm + SM_RS1, 0.0625f};
        pg8::gemm_phase<pg8::EpiScaleBf16, pg8::StaticOrder, true, true>(lds, g, S, E);
        skinny_gemm(lds, (const bf16_t*)(ws + WS_BFC) + (size_t)NPROMPT * DM, DM, (const bf16_t*)(ws + WS_WCQ), DM, DM, SkScale{(bf16_t*)(ws + WS_BFA) + (size_t)NPROMPT * DM, DM, sm + SM_RS1 + NPROMPT, 0.0625f});
    } SEAM(5);
    if (IN(6)) for (int rep = 0; rep < NREP(6); ++rep) {
        const bool early = ((bx >> 3) & 1) != 0;
        if (early) { for (int it0 = bx * 2; it0 < 512; it0 += G * 2) attn_sample_pair(p, lds, it0); }
        for (int u = bx; u < 256; u += G) attn_prompt_unit(p, lds, (((u & 7) * 4 + (u >> 6)) << 3) | ((u >> 3) & 7));
        if (!early) { for (int it0 = bx * 2; it0 < 512; it0 += G * 2) attn_sample_pair(p, lds, it0); }
    } SEAM(6);
    if (IN(7)) for (int rep = 0; rep < NREP(7); ++rep) {
        pg8::Gemm g{(const bf16_t*)(ws + WS_BFB), (const bf16_t*)(ws + WS_WCO), NPROMPT, DM, DM}; pg8::StaticOrder S; S.init(NPROMPT, DM, G, bx);
        pg8::EpiResB<false> E{nullptr, (const bf16_t*)(ws + WS_BFC), (bf16_t*)(ws + WS_BFC), sm + SM_RS2};
        pg8::gemm_phase<pg8::EpiResB<false>, pg8::StaticOrder, true, true>(lds, g, S, E);
        if (rep == 0) skinny_gemm(lds, (const bf16_t*)(ws + WS_BFB) + (size_t)NPROMPT * DM, DM, (const bf16_t*)(ws + WS_WCO), DM, DM, SkRes{nullptr, (const bf16_t*)(ws + WS_BFC) + (size_t)NPROMPT * DM, (bf16_t*)(ws + WS_BFC) + (size_t)NPROMPT * DM, sm + SM_RS2 + NPROMPT});
    } SEAM(7);
    if (IN(8)) for (int rep = 0; rep < NREP(8); ++rep) {
        pg8::Gemm g{(const bf16_t*)(ws + WS_BFC), (const bf16_t*)(ws + WS_WGU), MP, 2 * DFF, DM}; pg8::StaticOrder S; S.init(MP, 2 * DFF, G, bx);
        pg8::EpiGU E{(bf16_t*)(ws + WS_U), sm + SM_RS2};
        pg8::gemm_phase<pg8::EpiGU, pg8::StaticOrder, true, true>(lds, g, S, E);
    } SEAM(8);
    if (IN(9)) for (int rep = 0; rep < NREP(9); ++rep) {
        pg8::Gemm g{(const bf16_t*)(ws + WS_U), (const bf16_t*)(ws + WS_WDN), NPROMPT, DM, DFF}; pg8::StaticOrder S; S.init(NPROMPT, DM, G, bx);
        pg8::EpiResB<false> E{nullptr, (const bf16_t*)(ws + WS_BFC), (bf16_t*)(ws + WS_BFA), rep ? nullptr : sm + SM_RS3};
        pg8::gemm_phase<pg8::EpiResB<false>, pg8::StaticOrder, true, true>(lds, g, S, E);
        if (rep == 0) skinny_gemm(lds, (const bf16_t*)(ws + WS_U) + (size_t)NPROMPT * DFF, DFF, (const bf16_t*)(ws + WS_WDN), DFF, DM, SkRes{nullptr, (const bf16_t*)(ws + WS_BFC) + (size_t)NPROMPT * DM, (bf16_t*)(ws + WS_BFA) + (size_t)NPROMPT * DM, sm + SM_RS3 + NPROMPT});
    } SEAM(9);
    if (IN(10)) for (int rep = 0; rep < NREP(10); ++rep) final_norm(p);
#ifdef XSYNC
    for (int i = 0; i < XSYNC; ++i) xcd_barrier(bar);
#endif
#undef IN
#undef SEAM
}

#ifndef N_LAUNCHES
#define N_LAUNCHES 1
#endif
extern "C" void kernel_launch(void* const* d_in, const int* in_sizes, int n_in, void* d_out, int out_size, void* d_ws, size_t ws_size, hipStream_t stream) {
    static int grid = 0;
    if (grid == 0) {
        if (n_in != 29 || out_size != (int)O_END || ws_size < WS_END) { fprintf(stderr, "kernel_launch: unexpected shapes (n_in %d, out %d, ws %zu)\n", n_in, out_size, ws_size); grid = -1; return; }
        int dev = 0, cus = 0, per_cu = 0;
        hipGetDevice(&dev); hipDeviceGetAttribute(&cus, hipDeviceAttributeMultiprocessorCount, dev);
        if (hipFuncSetAttribute((const void*)fwd_megakernel, hipFuncAttributeMaxDynamicSharedMemorySize, LDS_BYTES) != hipSuccess) { fprintf(stderr, "kernel_launch: hipFuncSetAttribute failed\n"); }
        if (hipOccupancyMaxActiveBlocksPerMultiprocessor(&per_cu, (const void*)fwd_megakernel, 512, LDS_BYTES) != hipSuccess) per_cu = 0;
        (void)hipGetLastError();
        fprintf(stderr, "kernel_launch: %d CUs, %d blocks/CU\n", cus, per_cu);
        if (cus * per_cu < 256) { fprintf(stderr, "kernel_launch: resident capacity %d < 256 blocks\n", cus * per_cu); grid = -1; return; }
        grid = 256;
    }
    if (grid < 0) return;
    if (hipMemsetAsync((char*)d_ws + WS_BAR, 0, XCD_BAR_WORDS * 4, stream) != hipSuccess) { fprintf(stderr, "kernel_launch: memset failed\n"); return; }
    Params p{};
    for (int i = 0; i < 29; ++i) p.in[i] = (const float*)d_in[i];
    p.out = (float*)d_out; p.ws = (unsigned char*)d_ws;
#if N_LAUNCHES == 1
    p.ph_lo = 0; p.ph_hi = 11;
    { void* args[] = {&p}; hipError_t e = hipLaunchCooperativeKernel((const void*)fwd_megakernel, dim3(grid), dim3(512), args, LDS_BYTES, stream);
      if (e != hipSuccess) fprintf(stderr, "cooperative launch failed: %s\n", hipGetErrorString(e)); }
#else
    for (int ph = 0; ph < 11; ++ph) { p.ph_lo = ph; p.ph_hi = ph + 1; void* args[] = {&p};
        hipError_t e = hipLaunchCooperativeKernel((const void*)fwd_megakernel, dim3(grid), dim3(512), args, LDS_BYTES, stream);
        if (e != hipSuccess) fprintf(stderr, "cooperative launch %d failed: %s\n", ph, hipGetErrorString(e)); }
#endif
}
```

```cpp
#include <hip/hip_runtime.h>
#include <hip/hip_cooperative_groups.h>
#include <cstdio>
#include <cstdint>
namespace cg = cooperative_groups;
namespace pg8 {
#define PG8_LAS __attribute__((address_space(3)))
typedef unsigned short bf16_t;
typedef short bf16x8 __attribute__((ext_vector_type(8)));
typedef float f32x4 __attribute__((ext_vector_type(4)));
typedef unsigned u32x4 __attribute__((ext_vector_type(4)));
constexpr int BM = 256, BK = 64, HALF = 128, HTB = HALF * BK * 2  , STAGE_BYTES = 8 * HTB, NXCD = 8, WGM = 8;

__host__ __device__ __forceinline__ int lds_byte(int r, int c) { const int st = (r >> 4) * 2 + (c >> 5), rr = r & 15, cc = c & 31, ob = rr * 64 + cc * 2; return st * 1024 + (ob ^ (((ob >> 9) & 1) << 5)); }
__host__ __device__ __forceinline__ void stage_rc(int b, int& R, int& C) { const int st = b / 1024, sb = b % 1024, swz = sb ^ (((sb >> 9) & 1) << 5); R = (st >> 1) * 16 + swz / 64; C = (st & 1) * 32 + (swz % 64) / 2; }
__host__ __device__ __forceinline__ int perm32(int rho) { const int n = rho >> 4, i = rho & 15; return 8 * (i >> 2) + 4 * n + (i & 3); }

struct Unit { int pm, pn; };
struct Gemm { const bf16_t* A; const bf16_t* Bt; int M, N, K; };

struct StaticOrder {
    int nM, nN, nwg, G, c;
    __host__ __device__ void init(int M, int N, int G_, int c_) { nM = M / BM; nN = N / BM; nwg = nM * nN; G = G_; c = c_; }
    __host__ __device__ bool next(int i, Unit& u) const {
        const long L = (long)i * G + c; if (L >= nwg) return false;
        int wgid = (int)L; { const int q = nwg / NXCD, r = nwg % NXCD, xcd = wgid % NXCD, off = wgid / NXCD; wgid = (xcd < r ? xcd * (q + 1) : r * (q + 1) + (xcd - r) * q) + off; }
        const int nig = WGM * nN, gid = wgid / nig, fm = gid * WGM, gsz = (nM - fm) < WGM ? (nM - fm) : WGM;
        u.pm = fm + ((wgid % nig) % gsz); u.pn = (wgid % nig) / gsz; return true;
    }
    __device__ __forceinline__ void a_ready(const Unit&) const {}
    __device__ __forceinline__ void done(const Unit&) const {}
};

__device__ __forceinline__ unsigned cvt_pk_bf16(float lo, float hi) { unsigned r; asm volatile("v_cvt_pk_bf16_f32 %0, %1, %2" : "=v"(r) : "v"(lo), "v"(hi)); return r; }
typedef unsigned u32x2v __attribute__((ext_vector_type(2)));
constexpr float NORM_EPS = 1e-6f;
struct SubOrder {
    int idx, n, nN;
    __device__ bool next(int i, Unit& u) const { if (i != 0 || idx < 0 || idx >= n) return false; u.pm = idx / nN; u.pn = idx % nN; return true; }
    __device__ __forceinline__ void a_ready(const Unit&) const {}
    __device__ __forceinline__ void done(const Unit&) const {}
};
struct EpiScaleBf16 {
    static constexpr bool PERM = true, AFTER_DRAIN = false;
    bf16_t* O; int ldc; const float* ss; float post;
    __device__ __forceinline__ void operator()(const f32x4 (&acc)[2][2][4][2], const Unit& u, int wr, int wc, int fr, int fq) const {
        const int row0 = u.pm * BM + wr * 64 + fr, col0 = u.pn * BM + wc * 32 + 8 * fq;
#pragma unroll
        for (int ai = 0; ai < 2; ++ai)
#pragma unroll
            for (int m = 0; m < 4; ++m) { const int r = row0 + ai * HALF + m * 16; const float sc = rsqrtf(ss[r] * (1.0f / 1024.0f) + NORM_EPS) * post;
                bf16_t* rowp = O + (size_t)r * ldc + col0;
#pragma unroll
                for (int bj = 0; bj < 2; ++bj) { const f32x4 v0 = acc[ai][bj][m][0] * sc, v1 = acc[ai][bj][m][1] * sc;
                    u32x4 w; w.x = cvt_pk_bf16(v0[0], v0[1]); w.y = cvt_pk_bf16(v0[2], v0[3]); w.z = cvt_pk_bf16(v1[0], v1[1]); w.w = cvt_pk_bf16(v1[2], v1[3]);
                    *(u32x4*)(rowp + bj * HALF) = w; } }
    }
};
struct EpiRes {
    static constexpr bool PERM = false, AFTER_DRAIN = false;
    const float* res0; const float* res1; int split, nvalid; float* outf; bf16_t* outb; float* rs;
    __device__ __forceinline__ void operator()(const f32x4 (&acc)[2][2][4][2], const Unit& u, int wr, int wc, int fr, int fq) const {
        const int row0 = u.pm * BM + wr * 64 + fr, col0 = u.pn * BM + wc * 32 + 4 * fq;
#pragma unroll
        for (int ai = 0; ai < 2; ++ai)
#pragma unroll
            for (int m = 0; m < 4; ++m) { const int r = row0 + ai * HALF + m * 16;
                const float* rp = (r < split) ? res0 + (size_t)r * 1024 : ((r < nvalid) ? res1 + (size_t)(r - split) * 1024 : nullptr);
                float s = 0.f;
#pragma unroll
                for (int bj = 0; bj < 2; ++bj)
#pragma unroll
                    for (int n = 0; n < 2; ++n) { const int c = col0 + bj * HALF + n * 16;
                        f32x4 v = acc[ai][bj][m][n]; if (rp) v += *(const f32x4*)(rp + c);
                        *(f32x4*)(outf + (size_t)r * 1024 + c) = v;
                        if (outb) { u32x2v w; w.x = cvt_pk_bf16(v[0], v[1]); w.y = cvt_pk_bf16(v[2], v[3]); *(u32x2v*)(outb + (size_t)r * 1024 + c) = w; }
                        s += (v[0] * v[0] + v[1] * v[1]) + (v[2] * v[2] + v[3] * v[3]); }
                s += __shfl_xor(s, 16); s += __shfl_xor(s, 32);
                if (rs && fq == 0) atomicAdd(rs + r, s); }
    }
};
template <bool RES_F32> struct EpiResB {
    static constexpr bool PERM = true, AFTER_DRAIN = false;
    const float* resf; const bf16_t* resb; bf16_t* outb; float* rs;
    __device__ __forceinline__ void operator()(const f32x4 (&acc)[2][2][4][2], const Unit& u, int wr, int wc, int fr, int fq) const {
        const int row0 = u.pm * BM + wr * 64 + fr, col0 = u.pn * BM + wc * 32 + 8 * fq;
#pragma unroll
        for (int ai = 0; ai < 2; ++ai)
#pragma unroll
            for (int m = 0; m < 4; ++m) { const int r = row0 + ai * HALF + m * 16; float s = 0.f;
#pragma unroll
                for (int bj = 0; bj < 2; ++bj) { const size_t o = (size_t)r * 1024 + col0 + bj * HALF;
                    f32x4 v0 = acc[ai][bj][m][0], v1 = acc[ai][bj][m][1];
                    if (RES_F32) { v0 += *(const f32x4*)(resf + o); v1 += *(const f32x4*)(resf + o + 4); }
                    else { const u32x4 w = *(const u32x4*)(resb + o);
                        v0[0] += __builtin_bit_cast(float, w.x << 16); v0[1] += __builtin_bit_cast(float, w.x & 0xffff0000u); v0[2] += __builtin_bit_cast(float, w.y << 16); v0[3] += __builtin_bit_cast(float, w.y & 0xffff0000u);
                        v1[0] += __builtin_bit_cast(float, w.z << 16); v1[1] += __builtin_bit_cast(float, w.z & 0xffff0000u); v1[2] += __builtin_bit_cast(float, w.w << 16); v1[3] += __builtin_bit_cast(float, w.w & 0xffff0000u); }
                    u32x4 w2; w2.x = cvt_pk_bf16(v0[0], v0[1]); w2.y = cvt_pk_bf16(v0[2], v0[3]); w2.z = cvt_pk_bf16(v1[0], v1[1]); w2.w = cvt_pk_bf16(v1[2], v1[3]);
                    *(u32x4*)(outb + o) = w2;
                    s += ((v0[0] * v0[0] + v0[1] * v0[1]) + (v0[2] * v0[2] + v0[3] * v0[3])) + ((v1[0] * v1[0] + v1[1] * v1[1]) + (v1[2] * v1[2] + v1[3] * v1[3])); }
                s += __shfl_xor(s, 16); s += __shfl_xor(s, 32);
                if (rs && fq == 0) atomicAdd(rs + r, s); }
    }
};
struct EpiKV {
    static constexpr bool PERM = false, AFTER_DRAIN = false;
    const float* ss; float* outk; float* outv; bf16_t* kp; bf16_t* vp;
    __device__ __forceinline__ void operator()(const f32x4 (&acc)[2][2][4][2], const Unit& u, int wr, int wc, int fr, int fq) const {
        const int row0 = u.pm * BM + wr * 64 + fr, col0 = u.pn * BM + wc * 32 + 4 * fq;
#pragma unroll
        for (int ai = 0; ai < 2; ++ai)
#pragma unroll
            for (int m = 0; m < 4; ++m) { const int r = row0 + ai * HALF + m * 16; const float sc = rsqrtf(ss[r] * (1.0f / 1024.0f) + NORM_EPS);
                const int b = r >> 8, key = r & 255;
#pragma unroll
                for (int bj = 0; bj < 2; ++bj)
#pragma unroll
                    for (int n = 0; n < 2; ++n) { const int c = col0 + bj * HALF + n * 16; const f32x4 v = acc[ai][bj][m][n] * sc;
                        const int cc = c & 1023, hd = cc >> 8, dim = cc & 255; const bool isv = c >= 1024;
                        *(f32x4*)((isv ? outv : outk) + (size_t)r * 1024 + cc) = v;
                        u32x2v w; w.x = cvt_pk_bf16(v[0], v[1]); w.y = cvt_pk_bf16(v[2], v[3]);
                        *(u32x2v*)((isv ? vp : kp) + ((size_t)((b * 4 + hd) * 256 + key)) * 256 + dim) = w; } }
    }
};
struct EpiGU {
    static constexpr bool PERM = true, AFTER_DRAIN = false;
    bf16_t* O; const float* ss;
    __device__ __forceinline__ void operator()(const f32x4 (&acc)[2][2][4][2], const Unit& u, int wr, int wc, int fr, int fq) const {
        const int row0 = u.pm * BM + wr * 64 + fr, col0 = u.pn * HALF + wc * 32 + 8 * fq;
#pragma unroll
        for (int ai = 0; ai < 2; ++ai)
#pragma unroll
            for (int m = 0; m < 4; ++m) { const int r = row0 + ai * HALF + m * 16; const float sc = rsqrtf(ss[r] * (1.0f / 1024.0f) + NORM_EPS);
                float a[8];
#pragma unroll
                for (int n = 0; n < 2; ++n)
#pragma unroll
                    for (int e = 0; e < 4; ++e) { const float g = acc[ai][0][m][n][e] * sc, up = acc[ai][1][m][n][e] * sc; a[4 * n + e] = g * __builtin_amdgcn_rcpf(1.0f + __expf(-g)) * up; }
                u32x4 w; w.x = cvt_pk_bf16(a[0], a[1]); w.y = cvt_pk_bf16(a[2], a[3]); w.z = cvt_pk_bf16(a[4], a[5]); w.w = cvt_pk_bf16(a[6], a[7]);
                *(u32x4*)(O + (size_t)r * 2816 + col0) = w; }
    }
};
template <class Epi, class Sched, bool ALIGN_EPI = false, bool SP2 = false>
__device__ __forceinline__ void gemm_phase(PG8_LAS unsigned char* lds, const Gemm g, const Sched& S, const Epi& E) {
    const int tid = threadIdx.x, wid = __builtin_amdgcn_readfirstlane(tid >> 6), lane = tid & 63, wr = wid >> 2, wc = wid & 3, fr = lane & 15, fq = lane >> 4;
    const int K = g.K, nt = K / BK;
    unsigned voffA[2], voffB[2];
#pragma unroll
    for (int i = 0; i < 2; ++i) { int R, C; stage_rc(tid * 16 + i * 8192, R, C); const int Rb = Epi::PERM ? ((R & ~31) + perm32(R & 31)) : R;
        voffA[i] = (unsigned)(R * K + C) * 2u; voffB[i] = (unsigned)(Rb * K + C) * 2u; }
    const size_t kstep = (size_t)(BK * 2);
    const size_t hstep = (size_t)HALF * K * 2;
    const size_t tstep = 2 * hstep;
    const unsigned ldsw = (unsigned)wid * 1024u;
    const int aoff = lds_byte(wr * 64 + fr, fq * 8), boff = lds_byte(wc * 32 + fr, fq * 8);
#define PG8_SA(b, h) (((b) * 2 + (h)) * HTB)
#define PG8_SB(b, h) ((4 + (b) * 2 + (h)) * HTB)
#define PG8_STAGE(bufoff, gbase, voff) do { _Pragma("unroll") for (int _i = 0; _i < 2; ++_i) \
        __builtin_amdgcn_global_load_lds((const unsigned*)((const char*)(gbase) + (voff)[_i]), (PG8_LAS unsigned*)(lds + (bufoff) + ldsw + _i * 8192), 16, 0, 0); } while (0)
#define PG8_LDA(dst, b, h) do { _Pragma("unroll") for (int m = 0; m < 4; ++m) _Pragma("unroll") for (int k = 0; k < 2; ++k) dst[m][k] = *(const PG8_LAS bf16x8*)(lds + PG8_SA(b, h) + aoff + m * 2048 + k * 1024); } while (0)
#define PG8_LDB(dst, b, h) do { _Pragma("unroll") for (int n = 0; n < 2; ++n) _Pragma("unroll") for (int k = 0; k < 2; ++k) dst[n][k] = *(const PG8_LAS bf16x8*)(lds + PG8_SB(b, h) + boff + n * 2048 + k * 1024); } while (0)
#define PG8_MMA(ai, bj, At, Bt) do { __builtin_amdgcn_s_setprio(1); _Pragma("unroll") for (int m = 0; m < 4; ++m) _Pragma("unroll") for (int n = 0; n < 2; ++n) _Pragma("unroll") for (int k = 0; k < 2; ++k) \
        acc[ai][bj][m][n] = __builtin_amdgcn_mfma_f32_16x16x32_bf16(Bt[n][k], At[m][k], acc[ai][bj][m][n], 0, 0, 0); __builtin_amdgcn_s_setprio(0); } while (0)
#define PG8_WAIT_V(n) asm volatile("s_waitcnt vmcnt(" #n ")" ::: "memory")
#define PG8_WAIT_L(n) asm volatile("s_waitcnt lgkmcnt(" #n ")" ::: "memory")
#define PG8_BAR __builtin_amdgcn_s_barrier()
#define PG8_SCHED __builtin_amdgcn_sched_barrier(0)
    Unit cur, nxt; int ui = 0;
    if (!S.next(0, cur)) return;
    f32x4 acc[2][2][4][2];
#pragma unroll
    for (int a = 0; a < 2; ++a)
#pragma unroll
        for (int b = 0; b < 2; ++b)
#pragma unroll
            for (int m = 0; m < 4; ++m)
#pragma unroll
                for (int n = 0; n < 2; ++n) acc[a][b][m][n] = (f32x4){0.f, 0.f, 0.f, 0.f};
    bf16x8 At[4][2], B0[2][2], B1[2][2];
    const char* cA = (const char*)g.A + (size_t)cur.pm * tstep; const char* cB = (const char*)g.Bt + (size_t)cur.pn * tstep;
    S.a_ready(cur);
    if constexpr (SP2) {
        PG8_STAGE(PG8_SB(0, 0), cB, voffB); PG8_STAGE(PG8_SB(0, 1), cB + hstep, voffB); PG8_STAGE(PG8_SA(0, 0), cA, voffA); PG8_STAGE(PG8_SA(0, 1), cA + hstep, voffA);
        if (wr == 1) PG8_BAR;
        PG8_WAIT_V(2); PG8_BAR;
        PG8_STAGE(PG8_SB(1, 0), cB + kstep, voffB); PG8_STAGE(PG8_SA(1, 0), cA + kstep, voffA); PG8_STAGE(PG8_SB(1, 1), cB + hstep + kstep, voffB);
        PG8_WAIT_V(6); PG8_BAR;
    } else {
        PG8_STAGE(PG8_SB(0, 0), cB, voffB); PG8_STAGE(PG8_SA(0, 0), cA, voffA); PG8_STAGE(PG8_SB(0, 1), cB + hstep, voffB); PG8_STAGE(PG8_SA(0, 1), cA + hstep, voffA);
        if (wr == 1) PG8_BAR;
        PG8_WAIT_V(4); PG8_BAR;
        PG8_STAGE(PG8_SB(1, 0), cB + kstep, voffB); PG8_STAGE(PG8_SA(1, 0), cA + kstep, voffA); PG8_STAGE(PG8_SB(1, 1), cB + hstep + kstep, voffB);
        PG8_WAIT_V(6); PG8_BAR;
    }
    for (;;) {
        const bool has_next = S.next(ui + 1, nxt);
        const char* nA = has_next ? (const char*)g.A + (size_t)nxt.pm * tstep : cA; const char* nB = has_next ? (const char*)g.Bt + (size_t)nxt.pn * tstep : cB;
        for (int t = 0; t < nt; t += 2) {
            const bool last = (t == nt - 2);
            const char* a1 = cA + (size_t)(t + 1) * kstep;
            const char* a2 = last ? nA : cA + (size_t)(t + 2) * kstep; const char* b2 = last ? nB : cB + (size_t)(t + 2) * kstep;
            const char* a3 = a2 + kstep; const char* b3 = b2 + kstep;
            if (last && has_next) S.a_ready(nxt);
            if constexpr (SP2) {
            PG8_LDB(B0, 0, 0); PG8_LDB(B1, 0, 1); PG8_SCHED; PG8_LDA(At, 0, 0); PG8_STAGE(PG8_SA(1, 1), a1 + hstep, voffA);
            PG8_WAIT_V(8); PG8_WAIT_L(0); PG8_BAR; PG8_MMA(0, 0, At, B0); PG8_MMA(0, 1, At, B1); PG8_BAR; PG8_SCHED;
            PG8_LDA(At, 0, 1); PG8_STAGE(PG8_SB(0, 0), b2, voffB); PG8_STAGE(PG8_SB(0, 1), b2 + hstep, voffB); PG8_STAGE(PG8_SA(0, 0), a2, voffA);
            PG8_WAIT_V(8); PG8_WAIT_L(0); PG8_BAR; PG8_MMA(1, 0, At, B0); PG8_MMA(1, 1, At, B1); PG8_BAR; PG8_SCHED;
            PG8_LDB(B0, 1, 0); PG8_LDB(B1, 1, 1); PG8_SCHED; PG8_LDA(At, 1, 0); PG8_STAGE(PG8_SA(0, 1), a2 + hstep, voffA);
            PG8_WAIT_V(8); PG8_WAIT_L(0); PG8_BAR; PG8_MMA(0, 0, At, B0); PG8_MMA(0, 1, At, B1); PG8_BAR; PG8_SCHED;
            PG8_LDA(At, 1, 1); PG8_STAGE(PG8_SB(1, 0), b3, voffB); PG8_STAGE(PG8_SB(1, 1), b3 + hstep, voffB); PG8_STAGE(PG8_SA(1, 0), a3, voffA);
            PG8_WAIT_V(8); PG8_WAIT_L(0); PG8_BAR; PG8_MMA(1, 0, At, B0); PG8_MMA(1, 1, At, B1); PG8_BAR; PG8_SCHED;
            } else {
            PG8_LDB(B0, 0, 0); PG8_SCHED; PG8_LDA(At, 0, 0); PG8_STAGE(PG8_SA(1, 1), a1 + hstep, voffA);
            PG8_WAIT_L(8); PG8_BAR; PG8_WAIT_L(0); PG8_MMA(0, 0, At, B0); PG8_BAR; PG8_SCHED;
            PG8_LDB(B1, 0, 1); PG8_STAGE(PG8_SB(0, 0), b2, voffB);
            PG8_BAR; PG8_WAIT_L(0); PG8_MMA(0, 1, At, B1); PG8_BAR;
            PG8_LDA(At, 0, 1); PG8_STAGE(PG8_SA(0, 0), a2, voffA);
            PG8_BAR; PG8_WAIT_L(0); PG8_MMA(1, 0, At, B0); PG8_BAR; PG8_SCHED;
            PG8_STAGE(PG8_SB(0, 1), b2 + hstep, voffB);
            PG8_WAIT_V(6); PG8_BAR; PG8_MMA(1, 1, At, B1); PG8_BAR;
            PG8_LDB(B0, 1, 0); PG8_SCHED; PG8_LDA(At, 1, 0); PG8_STAGE(PG8_SA(0, 1), a2 + hstep, voffA);
            PG8_WAIT_L(8); PG8_BAR; PG8_WAIT_L(0); PG8_MMA(0, 0, At, B0); PG8_BAR; PG8_SCHED;
            PG8_LDB(B1, 1, 1); PG8_STAGE(PG8_SB(1, 0), b3, voffB);
            PG8_BAR; PG8_WAIT_L(0); PG8_MMA(0, 1, At, B1); PG8_BAR;
            PG8_LDA(At, 1, 1); PG8_STAGE(PG8_SA(1, 0), a3, voffA);
            PG8_BAR; PG8_WAIT_L(0); PG8_MMA(1, 0, At, B0); PG8_BAR; PG8_SCHED;
            PG8_STAGE(PG8_SB(1, 1), b3 + hstep, voffB);
            PG8_WAIT_V(6); PG8_BAR; PG8_MMA(1, 1, At, B1); PG8_BAR;
            }
        }
        if constexpr (ALIGN_EPI) { if (wr == 0) PG8_BAR; }
        if constexpr (!Epi::AFTER_DRAIN) { E(acc, cur, wr, wc, fr, fq); S.done(cur); }
        if (!has_next) break;
#pragma unroll
        for (int a = 0; a < 2; ++a)
#pragma unroll
            for (int b = 0; b < 2; ++b)
#pragma unroll
                for (int m = 0; m < 4; ++m)
#pragma unroll
                    for (int n = 0; n < 2; ++n) acc[a][b][m][n] = (f32x4){0.f, 0.f, 0.f, 0.f};
        cur = nxt; cA = nA; cB = nB; ++ui;
        if constexpr (ALIGN_EPI) { if (wr == 1) PG8_BAR; }
    }
    PG8_WAIT_V(0);
    if constexpr (!ALIGN_EPI) { if (wr == 0) PG8_BAR; }
    PG8_BAR;
    if constexpr (Epi::AFTER_DRAIN) { E.fused(acc, cur, wr, wc, fr, fq, lds, wid, lane); S.done(cur); }
#undef PG8_SA
#undef PG8_SB
#undef PG8_STAGE
#undef PG8_LDA
#undef PG8_LDB
#undef PG8_MMA
#undef PG8_WAIT_V
#undef PG8_WAIT_L
#undef PG8_BAR
#undef PG8_SCHED
}
}
#define LAS __attribute__((address_space(3)))
#define DI __device__ __forceinline__
typedef unsigned short bf16_t;
typedef short bf16x8 __attribute__((ext_vector_type(8)));
typedef short s16x4 __attribute__((ext_vector_type(4)));
typedef float f32x2 __attribute__((ext_vector_type(2)));
typedef float f32x4 __attribute__((ext_vector_type(4)));
typedef float f32x16 __attribute__((ext_vector_type(16)));
typedef unsigned u32x4 __attribute__((ext_vector_type(4)));
typedef unsigned u32x2 __attribute__((ext_vector_type(2)));
#define MFMA32(a, b, c) __builtin_amdgcn_mfma_f32_32x32x16_bf16((a), (b), (c), 0, 0, 0)

constexpr int NPROMPT = 16384, NSAMP = 128, NVALID = NPROMPT + NSAMP, MP = 16640;
constexpr int DM = 1024, UC = 4096, DFF = 2816, INC = 4104;
constexpr float EPS = 1e-6f;
constexpr int LDS_BYTES = 147456;

constexpr size_t MiB = 1u << 20;
constexpr size_t WS_WIN = 0;
constexpr size_t WS_WOUT = 8 * MiB;
constexpr size_t WS_WCKV = 10 * MiB;
constexpr size_t WS_WCQ = 14 * MiB;
constexpr size_t WS_WCO = 16 * MiB;
constexpr size_t WS_WGU = 18 * MiB;
constexpr size_t WS_WDN = 29 * MiB;
constexpr size_t WS_MEMB = 35 * MiB;
constexpr size_t WS_KP = 39 * MiB;
constexpr size_t WS_VP = 43 * MiB;
constexpr size_t WS_SMALL = 47 * MiB; constexpr size_t WS_BAR = WS_SMALL + 896 * 1024;
constexpr size_t WS_BFA = 48 * MiB;
constexpr size_t WS_BFB = 81 * MiB;
constexpr size_t WS_BFC = 114 * MiB;
constexpr size_t WS_FA = 147 * MiB;
constexpr size_t WS_FB = 212 * MiB;
constexpr size_t WS_U = 277 * MiB;
constexpr size_t WS_END = 408 * MiB;
constexpr int SM_SS0 = 0, SM_RS1 = MP, SM_RS2 = 2 * MP, SM_RS3 = 3 * MP, SM_SSM = 4 * MP, SM_GATES = 4 * MP + 2048;

constexpr size_t O_YP = 0, O_YS = 16777216, O_MK = 16908288, O_MV = 19005440, O_CONVP = 21102592, O_CP = 21127168, O_NP = 21651456, O_MP = 21655552, O_SP = 21655584,
                 O_CONVS = 22179872, O_CS = 22573088, O_NS = 30961696, O_MS = 31027232, O_SS = 31027744, O_END = 39416352;

struct Params { const float* in[29]; float* out; unsigned char* ws; int ph_lo, ph_hi; };

DI unsigned f2bf(float f) { unsigned u = __builtin_bit_cast(unsigned, f); return (u + 0x7fffu + ((u >> 16) & 1u)) >> 16; }
DI unsigned pk2(float lo, float hi) { return f2bf(lo) | (f2bf(hi) << 16); }
DI float bf2f(unsigned h) { return __builtin_bit_cast(float, h << 16); }
DI float bflo(unsigned w) { return __builtin_bit_cast(float, w << 16); }
DI float bfhi(unsigned w) { return __builtin_bit_cast(float, w & 0xffff0000u); }
DI void unpack8(u32x4 w, float (&f)[8]) { f[0] = bflo(w.x); f[1] = bfhi(w.x); f[2] = bflo(w.y); f[3] = bfhi(w.y); f[4] = bflo(w.z); f[5] = bfhi(w.z); f[6] = bflo(w.w); f[7] = bfhi(w.w); }
DI u32x4 pack8(const float (&f)[8]) { u32x4 w; w.x = pk2(f[0], f[1]); w.y = pk2(f[2], f[3]); w.z = pk2(f[4], f[5]); w.w = pk2(f[6], f[7]); return w; }
DI float wave_sum(float v) {
#pragma unroll
    for (int o = 1; o < 64; o <<= 1) v += __shfl_xor(v, o);
    return v;
}
DI float wave_max(float v) {
#pragma unroll
    for (int o = 1; o < 64; o <<= 1) v = fmaxf(v, __shfl_xor(v, o));
    return v;
}
DI unsigned off_b(unsigned row, unsigned ch) { return 256u * row + 16u * (ch ^ (((row & 3u) << 2) | ((row >> 2) & 3u))); }
DI int crow(int i, int h) { return (i & 3) + 8 * (i >> 2) + 4 * h; }
DI void tr_read4(unsigned a0, unsigned a1, unsigned a2, unsigned a3, s16x4& r0, s16x4& r1, s16x4& r2, s16x4& r3) {
    asm volatile("ds_read_b64_tr_b16 %0, %4\n\tds_read_b64_tr_b16 %1, %5\n\tds_read_b64_tr_b16 %2, %6\n\tds_read_b64_tr_b16 %3, %7\n\ts_waitcnt lgkmcnt(0)"
                 : "=&v"(r0), "=&v"(r1), "=&v"(r2), "=&v"(r3) : "v"(a0), "v"(a1), "v"(a2), "v"(a3) : "memory");
}
DI bf16x8 cat4(s16x4 lo, s16x4 hi) { return __builtin_shufflevector(lo, hi, 0, 1, 2, 3, 4, 5, 6, 7); }
DI float sigmoidf_(float x) { return __builtin_amdgcn_rcpf(1.0f + __expf(-x)); }
DI float logsigmoidf_(float x) { return fminf(x, 0.f) - log1pf(__expf(-fabsf(x))); }
DI void sincos_red(float a, float& s, float& c) {
    const float n = rintf(a * 0.15915494309189535f);
    float r = fmaf(-n, 6.28125f, a); r = fmaf(-n, 1.9353071795864769e-3f, r);
    s = __sinf(r); c = __cosf(r);
}

struct TItem { const float* W; int ldw, K, c0, k0; bf16_t* WT; int r0; const float* gs; };
DI TItem p0_decode(const Params& p, int it) {
    unsigned char* ws = p.ws; TItem t;
    constexpr int I_IN = 16 * 64, I_SQ = 16 * 32, I_FF = 16 * 88;
    int r = it;
    if (r < 2 * I_IN) { const int half = r / I_IN; r -= half * I_IN; const int kb = r / 64, nb = r % 64;
        t.W = p.in[10]; t.ldw = INC; t.K = 1024; t.c0 = (half ? 2056 : 0) + 32 * nb; t.k0 = 64 * kb; t.WT = (bf16_t*)(ws + WS_WIN); t.r0 = half * 2048 + 32 * nb; t.gs = p.in[14]; return t; }
    r -= 2 * I_IN;
    if (r < 5 * I_SQ) { const int which = r / I_SQ; r -= which * I_SQ; const int kb = r / 32, nb = r % 32;
        t.ldw = 1024; t.K = 1024; t.c0 = 32 * nb; t.k0 = 64 * kb; t.r0 = 32 * nb;
        if (which == 0) { t.W = p.in[17]; t.WT = (bf16_t*)(ws + WS_WOUT); t.gs = nullptr; }
        else if (which == 1) { t.W = p.in[20]; t.WT = (bf16_t*)(ws + WS_WCKV); t.gs = p.in[19]; }
        else if (which == 2) { t.W = p.in[21]; t.WT = (bf16_t*)(ws + WS_WCKV); t.gs = p.in[19]; t.r0 += 1024; }
        else if (which == 3) { t.W = p.in[22]; t.WT = (bf16_t*)(ws + WS_WCQ); t.gs = p.in[18]; }
        else { t.W = p.in[23]; t.WT = (bf16_t*)(ws + WS_WCO); t.gs = nullptr; }
        return t; }
    r -= 5 * I_SQ;
    if (r < 2 * I_FF) { const int which = r / I_FF; r -= which * I_FF; const int kb = r / 88, nb = r % 88; const int n0 = 32 * nb;
        t.W = which ? p.in[26] : p.in[25]; t.ldw = DFF; t.K = 1024; t.c0 = n0; t.k0 = 64 * kb; t.WT = (bf16_t*)(ws + WS_WGU); t.r0 = 256 * (n0 >> 7) + (n0 & 127) + (which ? 128 : 0); t.gs = p.in[24]; return t; }
    r -= 2 * I_FF;
    { const int kb = r / 32, nb = r % 32; t.W = p.in[27]; t.ldw = 1024; t.K = DFF; t.c0 = 32 * nb; t.k0 = 64 * kb; t.WT = (bf16_t*)(ws + WS_WDN); t.r0 = 32 * nb; t.gs = nullptr; }
    return t;
}
DI void p0_item_load(const TItem& t, float (&v)[32], int lane) {
#pragma unroll
    for (int i = 0; i < 32; ++i) { const int kk = 2 * i + (lane >> 5); v[i] = t.W[(size_t)(t.k0 + kk) * t.ldw + t.c0 + (lane & 31)]; }
}
DI void p0_item_finish(const TItem& t, const float (&v)[32], LAS float* scr, int lane) {
#pragma unroll
    for (int i = 0; i < 32; ++i) { const int kk = 2 * i + (lane >> 5); float x = v[i]; if (t.gs) x *= t.gs[t.k0 + kk]; scr[kk * 33 + (lane & 31)] = x; }
    asm volatile("s_waitcnt lgkmcnt(0)" ::: "memory");
    const int c = lane & 7;
#pragma unroll
    for (int j = 0; j < 4; ++j) { const int n = (lane >> 3) + 8 * j; const LAS float* s = scr + (8 * c) * 33 + n;
        u32x4 o; o.x = pk2(s[0 * 33], s[1 * 33]); o.y = pk2(s[2 * 33], s[3 * 33]); o.z = pk2(s[4 * 33], s[5 * 33]); o.w = pk2(s[6 * 33], s[7 * 33]);
        *(u32x4*)(t.WT + (size_t)(t.r0 + n) * t.K + t.k0 + 8 * c) = o; }
    asm volatile("s_waitcnt lgkmcnt(0)" ::: "memory");
}
DI void p0_prologue(const Params& p, LAS unsigned char* lds) {
    const int tid = threadIdx.x, lane = tid & 63, wave = tid >> 6;
    unsigned char* ws = p.ws;
    float* sm = (float*)(ws + WS_SMALL);
    const float* w_in = p.in[10];
    const float* g_mix = p.in[14];
    LAS float* GW = (LAS float*)(lds + 69632);
    for (int i = tid; i < 8192; i += 512) { const int k = i >> 3, j = i & 7; GW[i] = g_mix[k] * w_in[(size_t)k * INC + 2048 + j]; }
    for (int i = blockIdx.x * 512 + tid; i < 3 * MP; i += gridDim.x * 512) sm[SM_RS1 + i] = 0.f;
    __syncthreads();
    const int gw = blockIdx.x * 8 + wave, NGW = gridDim.x * 8;
    LAS float* scr = (LAS float*)(lds + wave * 8448);
    constexpr int NITEMS = 2 * (16 * 64) + 5 * (16 * 32) + 2 * (16 * 88) + 44 * 32;
#pragma unroll 1
    for (int it = gw; it < NITEMS; it += 2 * NGW) {
        const bool hasB = it + NGW < NITEMS;
        const TItem ta = p0_decode(p, it), tb = p0_decode(p, hasB ? it + NGW : it);
        float va[32], vb[32];
        p0_item_load(ta, va, lane); p0_item_load(tb, vb, lane);
        p0_item_finish(ta, va, scr, lane);
        if (hasB) p0_item_finish(tb, vb, scr, lane);
    }
    const float* b_gate = p.in[11];
    constexpr int RB = 5, NROWS = NVALID + 2048, NGRP = (NROWS + RB - 1) / RB;
#pragma unroll 1
    for (int gi = gw; gi < NGRP; gi += NGW) {
        f32x4 v[RB][4];
#pragma unroll
        for (int r = 0; r < RB; ++r) { int m = gi * RB + r; if (m >= NROWS) m = NROWS - 1;
            const float* xr = (m >= NVALID) ? p.in[9] + (size_t)(m - NVALID) * DM : (m < NPROMPT ? p.in[0] + (size_t)m * DM : p.in[1] + (size_t)(m - NPROMPT) * DM);
#pragma unroll
            for (int j = 0; j < 4; ++j) v[r][j] = ((const f32x4*)xr)[64 * j + lane]; }
#pragma unroll
        for (int r = 0; r < RB; ++r) { const int m = gi * RB + r; if (m >= NROWS) continue;
            const bool ismem = m >= NVALID;
            bf16_t* orow = ismem ? (bf16_t*)(ws + WS_MEMB) + (size_t)(m - NVALID) * DM : (bf16_t*)(ws + WS_BFA) + (size_t)m * DM;
            float s = 0.f;
#pragma unroll
            for (int j = 0; j < 4; ++j) { s += (v[r][j].x * v[r][j].x + v[r][j].y * v[r][j].y) + (v[r][j].z * v[r][j].z + v[r][j].w * v[r][j].w);
                u32x2 w; w.x = pk2(v[r][j].x, v[r][j].y); w.y = pk2(v[r][j].z, v[r][j].w); ((u32x2*)orow)[64 * j + lane] = w; }
            s = wave_sum(s);
            if (ismem) { if (lane == 0) sm[SM_SSM + (m - NVALID)] = s; continue; }
            float g[8];
#pragma unroll
            for (int e = 0; e < 8; ++e) g[e] = 0.f;
#pragma unroll
            for (int j = 0; j < 4; ++j)
#pragma unroll
                for (int e = 0; e < 4; ++e) { const int k = 4 * (64 * j + lane) + e; const f32x4 a = *(const LAS f32x4*)(GW + 8 * k), bq = *(const LAS f32x4*)(GW + 8 * k + 4); const float xv = v[r][j][e];
                    g[0] += xv * a.x; g[1] += xv * a.y; g[2] += xv * a.z; g[3] += xv * a.w; g[4] += xv * bq.x; g[5] += xv * bq.y; g[6] += xv * bq.z; g[7] += xv * bq.w; }
#pragma unroll
            for (int e = 0; e < 8; ++e) g[e] = wave_sum(g[e]);
            const float rr = rsqrtf(s * (1.0f / 1024.0f) + EPS);
            if (lane == 0) { sm[SM_SS0 + m] = s;
#pragma unroll
                for (int e = 0; e < 8; ++e) sm[SM_GATES + (size_t)m * 8 + e] = g[e] * rr + b_gate[e]; }
        }
    }
}
#define LDS_BARRIER() do { asm volatile("s_waitcnt lgkmcnt(0)" ::: "memory"); __builtin_amdgcn_s_barrier(); asm volatile("" ::: "memory"); } while (0)
template <int PASS> DI void scan_prompt(const Params& p, LAS unsigned char* lds, int bh, int seg) {
    const int tid0 = threadIdx.x, wid = __builtin_amdgcn_readfirstlane(tid0 >> 6), wr = wid >> 1, wc = wid & 1;
    int tid = tid0, lane = tid & 63, hh = lane >> 5, l31 = lane & 31;
    const int b = bh >> 3, head8 = bh & 7, hd = head8 & 3; const bool ret = head8 >= 4;
    unsigned char* ws = p.ws;
    const bf16_t* U = (const bf16_t*)(ws + WS_U);
    bf16_t* HM = (bf16_t*)(ws + WS_BFB);
    const float* gates = (const float*)(ws + WS_SMALL) + SM_GATES;
    const int qcol = (ret ? 2048 : 0) + hd * 128, kcol = qcol + 512, vcol = qcol + 1024, gcol = qcol + 1536, ocol = head8 * 128;
    const float* ghead = (ret ? p.in[16] : p.in[15]) + hd * 128;
    LAS unsigned char* T0 = lds; LAS unsigned char* T1 = lds + 32768; LAS unsigned char* T2 = lds + 65536; LAS unsigned char* T3 = lds + 98304;
    LAS float* sb = (LAS float*)(lds + 131072);
    LAS float* sa = sb + 128;
    LAS float* sbm = sb + 256;
    LAS float* swin = sb + 384;
    LAS float* sem = sb + 512;
    LAS float* snq = sb + 640;
    LAS float* sws = sb + 768;
    LAS float* sn = sb + 896;
    LAS float* sinv = sb + 1024;
    LAS float* smisc = sb + 1152;
    const unsigned t1a = (unsigned)(uintptr_t)T1, t2a = (unsigned)(uintptr_t)T2;
    const float lg = log1pf(-exp2f(-5.0f - (float)hd));
    int blk = (lane >> 4) & 1, q4 = (lane & 15) >> 2, pp = lane & 3;
    for (int i = tid; i < 8192; i += 512) ((LAS unsigned*)T3)[i] = 0u;
    if (tid < 128) sn[tid] = 0.f;
    LAS float* scw = sb + 1344;
    if (!ret) for (int i = tid; i < 1280; i += 512) { const int which = i / 640, r = i % 640, j = r >> 7, c = r & 127, ci = which * 512 + hd * 128 + c; scw[i] = (j < 4) ? p.in[12][j * 1024 + ci] : p.in[13][ci]; }
    f32x16 accC[2];
#pragma unroll
    for (int c = 0; c < 2; ++c)
#pragma unroll
        for (int i = 0; i < 16; ++i) accC[c][i] = 0.f;
    float m_state = 0.f;
    LAS float* sbl = sb + 1280; LAS float* spm = sb + 1296; LAS float* smq = sb + 1312; LAS float* scf = sb + 1336;
    float* Lws = (float*)(ws + WS_FA); float* NLws = Lws + (size_t)64 * 3 * 16384;
    if (!ret) {
        for (int c = wid; c < 16; c += 8) { const float* gp = gates + ((size_t)b * 2048 + c * 128 + 2 * lane) * 8;
            const float i0 = gp[hd], i1 = gp[8 + hd], lf0 = logsigmoidf_(gp[4 + hd]), lf1 = logsigmoidf_(gp[12 + hd]);
            float incl = lf0 + lf1;
#pragma unroll
            for (int o = 1; o < 64; o <<= 1) { const float t = __shfl_up(incl, o); if (lane >= o) incl += t; }
            const float b1 = incl, b0 = incl - lf1, a0 = i0 - b0, a1 = i1 - b1;
            float pin = fmaxf(a0, a1);
#pragma unroll
            for (int o = 1; o < 64; o <<= 1) { const float t = __shfl_up(pin, o); if (lane >= o) pin = fmaxf(pin, t); }
            if (lane == 63) { sbl[c] = incl; spm[c] = pin; } }
    } else if (tid < 16) { sbl[tid] = 128.0f * lg; spm[tid] = 0.f; }
    __syncthreads();
    if (tid == 0) {
        float m = 0.f; smq[0] = 0.f;
        for (int c = 0; c < 16; ++c) { m = ret ? 0.f : sbl[c] + fmaxf(m, spm[c]); smq[c + 1] = m; }
        float run = 1.f;
        for (int i = seg - 1; i >= 0; --i) { scf[i] = run; const float sB = ret ? 512.0f * lg : (sbl[4 * i] + sbl[4 * i + 1]) + (sbl[4 * i + 2] + sbl[4 * i + 3]); run *= __expf(sB + smq[4 * i] - smq[4 * i + 4]); }
    }
    __syncthreads();
    m_state = smq[4 * seg];
    if constexpr (PASS == 2) {
        for (int i = 0; i < seg; ++i) { const float cf = scf[i]; const float* L = Lws + (size_t)(bh * 3 + i) * 16384;
#pragma unroll
            for (int c = 0; c < 2; ++c)
#pragma unroll
                for (int ii = 0; ii < 16; ++ii) accC[c][ii] += cf * L[(32 * wr + crow(ii, hh)) * 128 + 64 * wc + 32 * c + l31];
            if (tid < 128) sn[tid] += cf * NLws[(size_t)(bh * 3 + i) * 128 + tid]; }
#pragma unroll
        for (int c = 0; c < 2; ++c) { const int k_idx = 64 * wc + 32 * c + l31;
#pragma unroll
            for (int i = 0; i < 16; ++i) { const int v = 32 * wr + crow(i, hh); *(LAS unsigned short*)(T3 + off_b(v, k_idx >> 3) + 2 * (k_idx & 7)) = (unsigned short)f2bf(accC[c][i]); } }
    }
    __syncthreads();
    for (int ch = 4 * seg; ch < 4 * seg + 4; ++ch) {
        const int t0 = ch * 128; const size_t m0 = (size_t)b * 2048 + t0;
        tid = tid0; asm volatile("" : "+v"(tid)); lane = tid & 63; hh = lane >> 5; l31 = lane & 31; blk = (lane >> 4) & 1; q4 = (lane & 15) >> 2; pp = lane & 3;
        if (wid == 0) {
            float lf0, lf1, i0, i1;
            if (!ret) { const float* gp = gates + (m0 + 2 * lane) * 8; i0 = gp[hd]; i1 = gp[8 + hd]; lf0 = logsigmoidf_(gp[4 + hd]); lf1 = logsigmoidf_(gp[12 + hd]); }
            else { lf0 = lg; lf1 = lg; i0 = 0.f; i1 = 0.f; }
            float incl = lf0 + lf1;
#pragma unroll
            for (int o = 1; o < 64; o <<= 1) { const float t = __shfl_up(incl, o); if (lane >= o) incl += t; }
            const float b1 = incl, b0 = incl - lf1, a0 = i0 - b0, a1 = i1 - b1;
            float pin = fmaxf(a0, a1);
#pragma unroll
            for (int o = 1; o < 64; o <<= 1) { const float t = __shfl_up(pin, o); if (lane >= o) pin = fmaxf(pin, t); }
            float pex = __shfl_up(pin, 1); if (lane == 0) pex = -INFINITY;
            const float pm0 = fmaxf(pex, a0), pm1 = pin;
            const float mt0 = ret ? 0.f : b0 + fmaxf(m_state, pm0), mt1 = ret ? 0.f : b1 + fmaxf(m_state, pm1);
            const float bL = __shfl(incl, 63), pmL = __shfl(pin, 63);
            const float m_new = ret ? 0.f : bL + fmaxf(m_state, pmL);
            sb[2 * lane] = b0; sb[2 * lane + 1] = b1; sa[2 * lane] = a0; sa[2 * lane + 1] = a1;
            sbm[2 * lane] = b0 - mt0; sbm[2 * lane + 1] = b1 - mt1;
            swin[2 * lane] = __expf(b0 + m_state - mt0); swin[2 * lane + 1] = __expf(b1 + m_state - mt1);
            sem[2 * lane] = __expf(-mt0); sem[2 * lane + 1] = __expf(-mt1);
            sws[2 * lane] = __expf(bL + a0 - m_new); sws[2 * lane + 1] = __expf(bL + a1 - m_new);
            if (lane == 0) { smisc[0] = m_new; smisc[1] = __expf(bL + m_state - m_new); }
        }
        u32x4 vv[4];
#pragma unroll
        for (int i = 0; i < 4; ++i) { const int idx = tid + 512 * i, t = idx >> 4, c8 = idx & 15; vv[i] = *(const u32x4*)(U + (m0 + t) * UC + vcol + 8 * c8); }
        if (!ret) {
            const int c8 = tid & 15, tq = tid >> 4;
            u32x4 xq[7], xk[7];
#pragma unroll
            for (int j = 0; j < 7; ++j) { const int rr = 4 * tq - 3 + j; const size_t row = (t0 + rr >= 0) ? (m0 + rr) : m0;
                if constexpr (PASS == 2) xq[j] = *(const u32x4*)(U + row * UC + qcol + 8 * c8);
                xk[j] = *(const u32x4*)(U + row * UC + kcol + 8 * c8); }
#pragma unroll
            for (int which = (PASS == 1 ? 1 : 0); which < 2; ++which) {
                const float scl = which ? 0.08838834764831845f : 1.0f; LAS unsigned char* T = which ? T1 : T0;
                const LAS float* cw = scw + which * 640 + 8 * c8;
                float wv[4][8], bc[8];
#pragma unroll
                for (int j = 0; j < 4; ++j) { const f32x4 a = *(const LAS f32x4*)(cw + j * 128), bq = *(const LAS f32x4*)(cw + j * 128 + 4);
                    wv[j][0] = a.x; wv[j][1] = a.y; wv[j][2] = a.z; wv[j][3] = a.w; wv[j][4] = bq.x; wv[j][5] = bq.y; wv[j][6] = bq.z; wv[j][7] = bq.w; }
                { const f32x4 a = *(const LAS f32x4*)(cw + 512), bq = *(const LAS f32x4*)(cw + 516); bc[0] = a.x; bc[1] = a.y; bc[2] = a.z; bc[3] = a.w; bc[4] = bq.x; bc[5] = bq.y; bc[6] = bq.z; bc[7] = bq.w; }
#pragma unroll
                for (int i = 0; i < 4; ++i) { const int t = 4 * tq + i;
                    float o[8];
#pragma unroll
                    for (int e = 0; e < 8; ++e) o[e] = bc[e];
#pragma unroll
                    for (int j = 0; j < 4; ++j) { const float msk = (t0 + t - 3 + j >= 0) ? 1.0f : 0.0f; float x[8]; unpack8(which ? xk[i + j] : xq[i + j], x);
#pragma unroll
                        for (int e = 0; e < 8; ++e) o[e] += (wv[j][e] * msk) * x[e]; }
#pragma unroll
                    for (int e = 0; e < 8; ++e) o[e] = o[e] * sigmoidf_(o[e]) * scl;
                    *(LAS u32x4*)(T + off_b(t, c8)) = pack8(o); }
            }
        } else {
            u32x4 rl[2][2], rh[2][2];
#pragma unroll
            for (int which = (PASS == 1 ? 1 : 0); which < 2; ++which)
#pragma unroll
                for (int i = 0; i < 2; ++i) { const int idx = tid + 512 * i, t = idx >> 3, c8 = idx & 7; const int ucol = which ? kcol : qcol;
                    rl[which][i] = *(const u32x4*)(U + (m0 + t) * UC + ucol + 8 * c8); rh[which][i] = *(const u32x4*)(U + (m0 + t) * UC + ucol + 64 + 8 * c8); }
#pragma unroll
            for (int which = (PASS == 1 ? 1 : 0); which < 2; ++which) {
                const float scl = which ? 0.08838834764831845f : 1.0f; LAS unsigned char* T = which ? T1 : T0;
#pragma unroll
                for (int i = 0; i < 2; ++i) { const int idx = tid + 512 * i, t = idx >> 3, c8 = idx & 7;
                    float x1[8], x2[8], o1[8], o2[8]; unpack8(rl[which][i], x1); unpack8(rh[which][i], x2); const float pos = (float)(t0 + t);
#pragma unroll
                    for (int e = 0; e < 8; ++e) { const float inv = exp2f(-(float)(8 * c8 + e) * 0.20762050593046014f); float sn_, cs_; sincos_red(pos * inv, sn_, cs_);
                        o1[e] = (x1[e] * cs_ - x2[e] * sn_) * scl; o2[e] = (x2[e] * cs_ + x1[e] * sn_) * scl; }
                    *(LAS u32x4*)(T + off_b(t, c8)) = pack8(o1); *(LAS u32x4*)(T + off_b(t, c8 + 8)) = pack8(o2); }
            }
        }
#pragma unroll
        for (int i = 0; i < 4; ++i) { const int idx = tid + 512 * i, t = idx >> 4, c8 = idx & 15; *(LAS u32x4*)(T2 + off_b(t, c8)) = vv[i]; }
        LDS_BARRIER();
        const float m_new = smisc[0], carry = smisc[1];
        if constexpr (PASS == 2) {
        { const int t = tid >> 2, part = tid & 3; float d = 0.f;
#pragma unroll
            for (int cc = 0; cc < 4; ++cc) { const int c8 = 4 * part + cc; float x[8]; unpack8(*(const LAS u32x4*)(T0 + off_b(t, c8)), x);
#pragma unroll
                for (int e = 0; e < 8; ++e) d += x[e] * sn[8 * c8 + e]; }
            d += __shfl_xor(d, 1); d += __shfl_xor(d, 2); if (part == 0) snq[t] = d; }
        f32x16 aS[2], aN[2];
#pragma unroll
        for (int c = 0; c < 2; ++c)
#pragma unroll
            for (int i = 0; i < 16; ++i) { aS[c][i] = 0.f; aN[c][i] = 0.f; }
#pragma unroll
        for (int s = 0; s < 8; ++s) { const bf16x8 A = *(const LAS bf16x8*)(T0 + off_b(32 * wr + l31, 2 * s + hh));
#pragma unroll
            for (int c = 0; c < 2; ++c) { const bf16x8 B = *(const LAS bf16x8*)(T1 + off_b(64 * wc + 32 * c + l31, 2 * s + hh)); aS[c] = MFMA32(A, B, aS[c]);
                const bf16x8 B2 = *(const LAS bf16x8*)(T3 + off_b(64 * wc + 32 * c + l31, 2 * s + hh)); aN[c] = MFMA32(A, B2, aN[c]); } }
#pragma unroll
        for (int c = 0; c < 2; ++c) { const int s_idx = 64 * wc + 32 * c + l31; const float a_s = sa[s_idx];
#pragma unroll
            for (int i = 0; i < 16; ++i) { const int t = 32 * wr + crow(i, hh); const float w = __expf(fminf(sbm[t] + a_s, 0.f)) * aS[c][i]; aS[c][i] = (s_idx <= t) ? w : 0.f; aN[c][i] *= swin[t]; } }
        LDS_BARRIER();
#pragma unroll
        for (int c = 0; c < 2; ++c) { const int s_idx = 64 * wc + 32 * c + l31;
#pragma unroll
            for (int i = 0; i < 16; ++i) { const int t = 32 * wr + crow(i, hh); *(LAS unsigned short*)(T0 + off_b(t, s_idx >> 3) + 2 * (s_idx & 7)) = (unsigned short)f2bf(aS[c][i]); } }
        LDS_BARRIER();
#pragma unroll
        for (int ks = 0; ks < 8; ++ks) { const bf16x8 A = *(const LAS bf16x8*)(T0 + off_b(32 * wr + l31, 2 * ks + hh));
            s16x4 r0, r1, r2, r3; const int rowb = 16 * ks + 8 * hh + q4; const int cg0 = 2 * wc, cg1 = 2 * wc + 1;
            tr_read4(t2a + off_b(rowb, 4 * cg0 + 2 * blk + (pp >> 1)) + 8 * (pp & 1), t2a + off_b(rowb + 4, 4 * cg0 + 2 * blk + (pp >> 1)) + 8 * (pp & 1),
                     t2a + off_b(rowb, 4 * cg1 + 2 * blk + (pp >> 1)) + 8 * (pp & 1), t2a + off_b(rowb + 4, 4 * cg1 + 2 * blk + (pp >> 1)) + 8 * (pp & 1), r0, r1, r2, r3);
            aN[0] = MFMA32(A, cat4(r0, r1), aN[0]); aN[1] = MFMA32(A, cat4(r2, r3), aN[1]); }
        { const int t = tid >> 2, part = tid & 3; float d = 0.f;
#pragma unroll
            for (int cc = 0; cc < 4; ++cc) { float x[8]; unpack8(*(const LAS u32x4*)(T0 + off_b(t, 4 * part + cc)), x);
#pragma unroll
                for (int e = 0; e < 8; ++e) d += x[e]; }
            d += __shfl_xor(d, 1); d += __shfl_xor(d, 2);
            if (part == 0) { const float den = d + swin[t] * snq[t]; sinv[t] = ret ? 1.0f : __builtin_amdgcn_rcpf(fmaxf(fabsf(den), sem[t])); } }
        LDS_BARRIER();
#pragma unroll
        for (int c = 0; c < 2; ++c) { const int v_idx = 64 * wc + 32 * c + l31;
#pragma unroll
            for (int i = 0; i < 16; ++i) { const int t = 32 * wr + crow(i, hh); *(LAS unsigned short*)(T0 + off_b(t, v_idx >> 3) + 2 * (v_idx & 7)) = (unsigned short)f2bf(aN[c][i] * sinv[t]); } }
        LDS_BARRIER();
        { const int t = tid >> 2, part = tid & 3; float ss = 0.f;
#pragma unroll
            for (int cc = 0; cc < 4; ++cc) { float x[8]; unpack8(*(const LAS u32x4*)(T0 + off_b(t, 4 * part + cc)), x);
#pragma unroll
                for (int e = 0; e < 8; ++e) ss += x[e] * x[e]; }
            ss += __shfl_xor(ss, 1); ss += __shfl_xor(ss, 2);
            const float rn = rsqrtf(ss * (1.0f / 128.0f) + EPS);
#pragma unroll
            for (int cc = 0; cc < 4; ++cc) { const int c8 = 4 * part + cc; float x[8], gt[8], o[8]; unpack8(*(const LAS u32x4*)(T0 + off_b(t, c8)), x);
                unpack8(*(const u32x4*)(U + (m0 + t) * UC + gcol + 8 * c8), gt);
#pragma unroll
                for (int e = 0; e < 8; ++e) { const float sg = sigmoidf_(gt[e]); o[e] = x[e] * rn * ghead[8 * c8 + e] * (ret ? gt[e] * sg : sg); }
                *(u32x4*)(HM + (m0 + t) * DM + ocol + 8 * c8) = pack8(o); } }
        }
        { const int s = tid >> 2, part = tid & 3; const float w = sws[s];
#pragma unroll
            for (int cc = 0; cc < 4; ++cc) { LAS u32x4* ptr = (LAS u32x4*)(T1 + off_b(s, 4 * part + cc)); float x[8]; unpack8(*ptr, x);
#pragma unroll
                for (int e = 0; e < 8; ++e) x[e] *= w;
                *ptr = pack8(x); } }
        if (!ret && tid < 128) sn[tid] *= carry;
        LDS_BARRIER();
#pragma unroll
        for (int c = 0; c < 2; ++c)
#pragma unroll
            for (int i = 0; i < 16; ++i) accC[c][i] *= carry;
#pragma unroll
        for (int ks = 0; ks < 8; ++ks) { const int rowb = 16 * ks + 8 * hh + q4; const int cg0 = 2 * wc, cg1 = 2 * wc + 1;
            s16x4 a0, a1, d0, d1, r0, r1, r2, r3;
            tr_read4(t2a + off_b(rowb, 4 * wr + 2 * blk + (pp >> 1)) + 8 * (pp & 1), t2a + off_b(rowb + 4, 4 * wr + 2 * blk + (pp >> 1)) + 8 * (pp & 1),
                     t1a + off_b(rowb, 4 * cg0 + 2 * blk + (pp >> 1)) + 8 * (pp & 1), t1a + off_b(rowb + 4, 4 * cg0 + 2 * blk + (pp >> 1)) + 8 * (pp & 1), a0, a1, r0, r1);
            tr_read4(t1a + off_b(rowb, 4 * cg1 + 2 * blk + (pp >> 1)) + 8 * (pp & 1), t1a + off_b(rowb + 4, 4 * cg1 + 2 * blk + (pp >> 1)) + 8 * (pp & 1),
                     t1a + off_b(rowb, 4 * cg1 + 2 * blk + (pp >> 1)) + 8 * (pp & 1), t1a + off_b(rowb + 4, 4 * cg1 + 2 * blk + (pp >> 1)) + 8 * (pp & 1), r2, r3, d0, d1);
            const bf16x8 A = cat4(a0, a1);
            accC[0] = MFMA32(A, cat4(r0, r1), accC[0]); accC[1] = MFMA32(A, cat4(r2, r3), accC[1]); }
        if (!ret) { const int kcol_ = tid & 127, r0 = 32 * (tid >> 7); float s = 0.f;
#pragma unroll 8
            for (int r = 0; r < 32; ++r) s += bf2f(*(const LAS unsigned short*)(T1 + off_b(r0 + r, kcol_ >> 3) + 2 * (kcol_ & 7)));
            atomicAdd((float*)(sn + kcol_), s); }
        if constexpr (PASS == 2) {
#pragma unroll
        for (int c = 0; c < 2; ++c) { const int k_idx = 64 * wc + 32 * c + l31;
#pragma unroll
            for (int i = 0; i < 16; ++i) { const int v = 32 * wr + crow(i, hh); *(LAS unsigned short*)(T3 + off_b(v, k_idx >> 3) + 2 * (k_idx & 7)) = (unsigned short)f2bf(accC[c][i]); } }
        }
        m_state = m_new;
        LDS_BARRIER();
    }
    float* out = p.out;
    if constexpr (PASS == 1) {
        float* L = Lws + (size_t)(bh * 3 + seg) * 16384;
#pragma unroll
        for (int c = 0; c < 2; ++c)
#pragma unroll
            for (int ii = 0; ii < 16; ++ii) L[(32 * wr + crow(ii, hh)) * 128 + 64 * wc + 32 * c + l31] = accC[c][ii];
        if (tid < 128) NLws[(size_t)(bh * 3 + seg) * 128 + tid] = sn[tid];
        __syncthreads();
        return;
    }
    if (seg != 3) { __syncthreads(); return; }
#pragma unroll
    for (int c = 0; c < 2; ++c) { const int k_idx = 64 * wc + 32 * c + l31;
#pragma unroll
        for (int i = 0; i < 16; ++i) { const int v = 32 * wr + crow(i, hh);
            if (!ret) out[O_CP + ((size_t)(b * 4 + hd) * 128 + v) * 128 + k_idx] = accC[c][i];
            else out[O_SP + ((size_t)(b * 4 + hd) * 128 + k_idx) * 128 + v] = accC[c][i]; } }
    if (!ret) { if (tid < 128) out[O_NP + (size_t)(b * 4 + hd) * 128 + tid] = sn[tid]; if (tid == 0) out[O_MP + b * 4 + hd] = m_state; }
    __syncthreads();
}
DI void scan_sample_block(const Params& p, LAS unsigned char* lds, int item) {
    const int tid = threadIdx.x, lane = tid & 63, wid = tid >> 6;
    const int b = item >> 3, head8 = item & 7, hd = head8 & 3; const bool ret = head8 >= 4;
    unsigned char* ws = p.ws; float* out = p.out;
    const size_t m = (size_t)NPROMPT + b;
    const bf16_t* ur = (const bf16_t*)(ws + WS_U) + m * UC;
    bf16_t* HM = (bf16_t*)(ws + WS_BFB) + m * DM;
    const float* gates = (const float*)(ws + WS_SMALL) + SM_GATES + m * 8;
    LAS float* sq = (LAS float*)lds; LAS float* sk = sq + 128; LAS float* sv = sq + 256; LAS float* sred = sq + 384; LAS float* spart = sq + 1024;
    const int part = tid & 3;
    if (!ret) {
        const float* C0 = p.in[5] + (size_t)(b * 4 + hd) * 16384 + (tid >> 2) * 128 + 32 * part;
        f32x4 cr[8];
#pragma unroll
        for (int j = 0; j < 8; ++j) cr[j] = ((const f32x4*)C0)[j];
        if (tid < 128) { const float* w_conv = p.in[12]; const float* b_conv = p.in[13]; const float* cst = p.in[4] + (size_t)b * 3 * 1024;
            const int cq = hd * 128 + tid, ck = 512 + cq;
            const float aq = b_conv[cq] + w_conv[cq] * cst[cq] + w_conv[1024 + cq] * cst[1024 + cq] + w_conv[2048 + cq] * cst[2048 + cq] + w_conv[3072 + cq] * bf2f(ur[cq]);
            const float ak = b_conv[ck] + w_conv[ck] * cst[ck] + w_conv[1024 + ck] * cst[1024 + ck] + w_conv[2048 + ck] * cst[2048 + ck] + w_conv[3072 + ck] * bf2f(ur[ck]);
            sq[tid] = aq * sigmoidf_(aq); sk[tid] = ak * sigmoidf_(ak) * 0.08838834764831845f; sv[tid] = bf2f(ur[1024 + hd * 128 + tid]); }
        __syncthreads();
        const int v = tid >> 2;
        float* C1 = out + O_CS + (size_t)(b * 4 + hd) * 16384 + v * 128 + 32 * part;
        const float* n0 = p.in[6] + (size_t)(b * 4 + hd) * 128;
        float qk = 0.f, nq = 0.f, cq = 0.f;
        f32x4 qv[8], kv[8];
#pragma unroll
        for (int j = 0; j < 8; ++j) { qv[j] = *(const LAS f32x4*)(sq + 32 * part + 4 * j); kv[j] = *(const LAS f32x4*)(sk + 32 * part + 4 * j); const f32x4 nn = *(const f32x4*)(n0 + 32 * part + 4 * j);
            qk += (qv[j].x * kv[j].x + qv[j].y * kv[j].y) + (qv[j].z * kv[j].z + qv[j].w * kv[j].w); nq += (qv[j].x * nn.x + qv[j].y * nn.y) + (qv[j].z * nn.z + qv[j].w * nn.w);
            cq += (qv[j].x * cr[j].x + qv[j].y * cr[j].y) + (qv[j].z * cr[j].z + qv[j].w * cr[j].w); }
        qk += __shfl_xor(qk, 1); qk += __shfl_xor(qk, 2); nq += __shfl_xor(nq, 1); nq += __shfl_xor(nq, 2); cq += __shfl_xor(cq, 1); cq += __shfl_xor(cq, 2);
        const float ig = gates[hd], lf = logsigmoidf_(gates[4 + hd]), m0s = p.in[7][b * 4 + hd];
        const float mt = fmaxf(lf + m0s, ig), wts_e = __expf(ig - mt), win = __expf(lf + m0s - mt);
        const float wts = wts_e * qk, den = wts + win * nq, dinv = 1.0f / fmaxf(fabsf(den), __expf(-mt));
        const float vv = sv[v], hv = (wts * vv + win * cq) * dinv, wv = wts_e * vv;
#pragma unroll
        for (int j = 0; j < 8; ++j) ((f32x4*)C1)[j] = cr[j] * win + kv[j] * wv;
        if (tid < 128) out[O_NS + (size_t)(b * 4 + hd) * 128 + tid] = win * n0[tid] + wts_e * sk[tid];
        if (tid == 0) out[O_MS + b * 4 + hd] = mt;
        float ss = (part == 0) ? hv * hv : 0.f; ss = wave_sum(ss);
        if (lane == 0) sred[wid] = ss;
        __syncthreads();
        const float tot = ((sred[0] + sred[1]) + (sred[2] + sred[3])) + ((sred[4] + sred[5]) + (sred[6] + sred[7]));
        const float rn = rsqrtf(tot * (1.0f / 128.0f) + EPS);
        if (part == 0) HM[hd * 128 + v] = (bf16_t)f2bf(hv * rn * p.in[15][hd * 128 + v] * sigmoidf_(bf2f(ur[1536 + hd * 128 + v])));
    } else {
        const int qc = 2048 + hd * 128;
        const float* S0 = p.in[8] + (size_t)(b * 4 + hd) * 16384 + (8 * (tid >> 5)) * 128 + 4 * (tid & 31);
        f32x4 sr[8];
#pragma unroll
        for (int j = 0; j < 8; ++j) sr[j] = *(const f32x4*)(S0 + j * 128);
        if (tid < 64) { float sn_, cs_; const float inv = exp2f(-(float)tid * 0.20762050593046014f); sincos_red(16384.0f * inv, sn_, cs_);
            const float xq1 = bf2f(ur[qc + tid]), xq2 = bf2f(ur[qc + 64 + tid]), xk1 = bf2f(ur[qc + 512 + tid]), xk2 = bf2f(ur[qc + 576 + tid]);
            sq[tid] = xq1 * cs_ - xq2 * sn_; sq[tid + 64] = xq2 * cs_ + xq1 * sn_;
            sk[tid] = (xk1 * cs_ - xk2 * sn_) * 0.08838834764831845f; sk[tid + 64] = (xk2 * cs_ + xk1 * sn_) * 0.08838834764831845f; }
        else if (tid < 192) sv[tid - 64] = bf2f(ur[qc + 1024 + tid - 64]);
        __syncthreads();
        const int kg = tid >> 5, v4 = tid & 31;
        float* S1 = out + O_SS + (size_t)(b * 4 + hd) * 16384 + (8 * kg) * 128 + 4 * v4;
        float qk = 0.f;
#pragma unroll
        for (int j = 0; j < 32; ++j) qk += sq[32 * part + j] * sk[32 * part + j];
        qk += __shfl_xor(qk, 1); qk += __shfl_xor(qk, 2);
        const float gamma = 1.0f - exp2f(-5.0f - (float)hd);
        const f32x4 vv4 = *(const LAS f32x4*)(sv + 4 * v4);
        f32x4 a4 = {0.f, 0.f, 0.f, 0.f};
#pragma unroll
        for (int j = 0; j < 8; ++j) { const float qj = sq[8 * kg + j], kj = sk[8 * kg + j]; a4 += sr[j] * qj; *(f32x4*)(S1 + j * 128) = sr[j] * gamma + vv4 * kj; }
        *(LAS f32x4*)(spart + kg * 128 + 4 * v4) = a4;
        __syncthreads();
        float o = 0.f, ss = 0.f;
        if (tid < 128) { float a = 0.f;
#pragma unroll
            for (int g = 0; g < 16; ++g) a += spart[g * 128 + tid];
            o = qk * sv[tid] + gamma * a; ss = o * o; }
        ss = wave_sum(ss);
        if (lane == 0) sred[wid] = ss;
        __syncthreads();
        const float rn = rsqrtf((sred[0] + sred[1]) * (1.0f / 128.0f) + EPS);
        if (tid < 128) { const float g0 = bf2f(ur[qc + 1536 + tid]); HM[512 + hd * 128 + tid] = (bf16_t)f2bf(o * rn * p.in[16][hd * 128 + tid] * g0 * sigmoidf_(g0)); }
    }
    __syncthreads();
}
DI void scan_sample_two(const Params& p, LAS unsigned char* lds, int item0) {
    constexpr int NI = 2;
    const int tid = threadIdx.x, lane = tid & 63, wid = tid >> 6, part = tid & 3;
    const int head8 = item0 & 7, hd = head8 & 3; const bool ret = head8 >= 4;
    unsigned char* ws = p.ws; float* out = p.out;
    LAS float* fb = (LAS float*)lds;
    int bb[NI]; const bf16_t* ur[NI]; bf16_t* HM[NI];
#pragma unroll
    for (int i = 0; i < NI; ++i) { bb[i] = (item0 >> 3) + 32 * i; const size_t m = (size_t)NPROMPT + bb[i]; ur[i] = (const bf16_t*)(ws + WS_U) + m * UC; HM[i] = (bf16_t*)(ws + WS_BFB) + m * DM; }
    if (!ret) {
        f32x4 cr[NI][8]; float g_i[NI], g_f[NI], m0s[NI], n0t[NI], mov[NI];
        float cin[NI][9];
        const int cq = hd * 128 + (tid & 127), ck = 512 + cq;
#pragma unroll
        for (int i = 0; i < NI; ++i) { const float* C0 = p.in[5] + (size_t)(bb[i] * 4 + hd) * 16384 + (tid >> 2) * 128 + 32 * part;
#pragma unroll
            for (int j = 0; j < 8; ++j) cr[i][j] = ((const f32x4*)C0)[j];
            const float* gates = (const float*)(ws + WS_SMALL) + SM_GATES + ((size_t)NPROMPT + bb[i]) * 8;
            g_i[i] = gates[hd]; g_f[i] = gates[4 + hd]; m0s[i] = p.in[7][bb[i] * 4 + hd]; n0t[i] = p.in[6][(size_t)(bb[i] * 4 + hd) * 128 + (tid & 127)];
            mov[i] = bf2f(ur[i][1536 + hd * 128 + (tid >> 2)]);
            const float* cst = p.in[4] + (size_t)bb[i] * 3 * 1024;
            cin[i][0] = cst[cq]; cin[i][1] = cst[1024 + cq]; cin[i][2] = cst[2048 + cq]; cin[i][3] = bf2f(ur[i][cq]);
            cin[i][4] = cst[ck]; cin[i][5] = cst[1024 + ck]; cin[i][6] = cst[2048 + ck]; cin[i][7] = bf2f(ur[i][ck]); cin[i][8] = bf2f(ur[i][1024 + hd * 128 + (tid & 127)]); }
        const float* w_conv = p.in[12]; const float* b_conv = p.in[13];
        const float wq0 = w_conv[cq], wq1 = w_conv[1024 + cq], wq2 = w_conv[2048 + cq], wq3 = w_conv[3072 + cq], bq_ = b_conv[cq];
        const float wk0 = w_conv[ck], wk1 = w_conv[1024 + ck], wk2 = w_conv[2048 + ck], wk3 = w_conv[3072 + ck], bk_ = b_conv[ck];
        const float ghv = p.in[15][hd * 128 + (tid >> 2)];
        if (tid < 128) {
#pragma unroll
            for (int i = 0; i < NI; ++i) { LAS float* f = fb + 512 * i;
                const float aq = bq_ + wq0 * cin[i][0] + wq1 * cin[i][1] + wq2 * cin[i][2] + wq3 * cin[i][3];
                const float ak = bk_ + wk0 * cin[i][4] + wk1 * cin[i][5] + wk2 * cin[i][6] + wk3 * cin[i][7];
                f[tid] = aq * sigmoidf_(aq); f[128 + tid] = ak * sigmoidf_(ak) * 0.08838834764831845f; f[256 + tid] = cin[i][8]; f[384 + tid] = n0t[i]; } }
        LDS_BARRIER();
        const int v = tid >> 2; float hv[NI];
#pragma unroll
        for (int i = 0; i < NI; ++i) { const LAS float* f = fb + 512 * i;
            float* C1 = out + O_CS + (size_t)(bb[i] * 4 + hd) * 16384 + v * 128 + 32 * part;
            float qk = 0.f, nq = 0.f, cqs = 0.f; f32x4 kv[8];
#pragma unroll
            for (int j = 0; j < 8; ++j) { const f32x4 qv = *(const LAS f32x4*)(f + 32 * part + 4 * j); kv[j] = *(const LAS f32x4*)(f + 128 + 32 * part + 4 * j); const f32x4 nn = *(const LAS f32x4*)(f + 384 + 32 * part + 4 * j);
                qk += (qv.x * kv[j].x + qv.y * kv[j].y) + (qv.z * kv[j].z + qv.w * kv[j].w); nq += (qv.x * nn.x + qv.y * nn.y) + (qv.z * nn.z + qv.w * nn.w);
                cqs += (qv.x * cr[i][j].x + qv.y * cr[i][j].y) + (qv.z * cr[i][j].z + qv.w * cr[i][j].w); }
            qk += __shfl_xor(qk, 1); qk += __shfl_xor(qk, 2); nq += __shfl_xor(nq, 1); nq += __shfl_xor(nq, 2); cqs += __shfl_xor(cqs, 1); cqs += __shfl_xor(cqs, 2);
            const float ig = g_i[i], lf = logsigmoidf_(g_f[i]);
            const float mt = fmaxf(lf + m0s[i], ig), wts_e = __expf(ig - mt), win = __expf(lf + m0s[i] - mt);
            const float wts = wts_e * qk, den = wts + win * nq, dinv = 1.0f / fmaxf(fabsf(den), __expf(-mt));
            const float vv = f[256 + v], wv = wts_e * vv; hv[i] = (wts * vv + win * cqs) * dinv;
#pragma unroll
            for (int j = 0; j < 8; ++j) ((f32x4*)C1)[j] = cr[i][j] * win + kv[j] * wv;
            if (tid < 128) out[O_NS + (size_t)(bb[i] * 4 + hd) * 128 + tid] = win * n0t[i] + wts_e * f[128 + tid];
            if (tid == 0) out[O_MS + bb[i] * 4 + hd] = mt;
            float ss = (part == 0) ? hv[i] * hv[i] : 0.f; ss = wave_sum(ss);
            if (lane == 0) fb[1024 + 8 * i + wid] = ss; }
        LDS_BARRIER();
#pragma unroll
        for (int i = 0; i < NI; ++i) { const LAS float* sr_ = fb + 1024 + 8 * i;
            const float tot = ((sr_[0] + sr_[1]) + (sr_[2] + sr_[3])) + ((sr_[4] + sr_[5]) + (sr_[6] + sr_[7]));
            const float rn = rsqrtf(tot * (1.0f / 128.0f) + EPS);
            if (part == 0) HM[i][hd * 128 + v] = (bf16_t)f2bf(hv[i] * rn * ghv * sigmoidf_(mov[i])); }
    } else {
        const int qc = 2048 + hd * 128, kg = tid >> 5, v4 = tid & 31;
        f32x4 sr[NI][8]; float rin[NI][5], rgv[NI];
#pragma unroll
        for (int i = 0; i < NI; ++i) { const float* S0 = p.in[8] + (size_t)(bb[i] * 4 + hd) * 16384 + (8 * kg) * 128 + 4 * v4;
#pragma unroll
            for (int j = 0; j < 8; ++j) sr[i][j] = *(const f32x4*)(S0 + j * 128);
            rgv[i] = bf2f(ur[i][qc + 1536 + (tid & 127)]);
            const int l6 = tid & 63;
            rin[i][0] = bf2f(ur[i][qc + l6]); rin[i][1] = bf2f(ur[i][qc + 64 + l6]); rin[i][2] = bf2f(ur[i][qc + 512 + l6]); rin[i][3] = bf2f(ur[i][qc + 576 + l6]); rin[i][4] = bf2f(ur[i][qc + 1024 + (tid & 127)]); }
        const float ghr = p.in[16][hd * 128 + (tid & 127)];
        if (tid < 64) { float sn_, cs_; const float inv = exp2f(-(float)tid * 0.20762050593046014f); sincos_red(16384.0f * inv, sn_, cs_);
#pragma unroll
            for (int i = 0; i < NI; ++i) { LAS float* f = fb + 512 * i;
                f[tid] = rin[i][0] * cs_ - rin[i][1] * sn_; f[tid + 64] = rin[i][1] * cs_ + rin[i][0] * sn_;
                f[128 + tid] = (rin[i][2] * cs_ - rin[i][3] * sn_) * 0.08838834764831845f; f[128 + tid + 64] = (rin[i][3] * cs_ + rin[i][2] * sn_) * 0.08838834764831845f; } }
        if (tid >= 128 && tid < 256) {
#pragma unroll
            for (int i = 0; i < NI; ++i) fb[512 * i + 256 + (tid & 127)] = rin[i][4]; }
        LDS_BARRIER();
        const float gamma = 1.0f - exp2f(-5.0f - (float)hd);
        float qk[NI];
#pragma unroll
        for (int i = 0; i < NI; ++i) { const LAS float* f = fb + 512 * i;
            float* S1 = out + O_SS + (size_t)(bb[i] * 4 + hd) * 16384 + (8 * kg) * 128 + 4 * v4;
            float q_ = 0.f;
#pragma unroll
            for (int j = 0; j < 32; ++j) q_ += f[32 * part + j] * f[128 + 32 * part + j];
            q_ += __shfl_xor(q_, 1); q_ += __shfl_xor(q_, 2); qk[i] = q_;
            const f32x4 vv4 = *(const LAS f32x4*)(f + 256 + 4 * v4);
            f32x4 a4 = {0.f, 0.f, 0.f, 0.f};
#pragma unroll
            for (int j = 0; j < 8; ++j) { const float qj = f[8 * kg + j], kj = f[128 + 8 * kg + j]; a4 += sr[i][j] * qj; *(f32x4*)(S1 + j * 128) = sr[i][j] * gamma + vv4 * kj; }
            *(LAS f32x4*)(fb + 2048 + 2048 * i + kg * 128 + 4 * v4) = a4; }
        LDS_BARRIER();
        float o[NI];
#pragma unroll
        for (int i = 0; i < NI; ++i) { float ss = 0.f; o[i] = 0.f;
            if (tid < 128) { float a = 0.f;
#pragma unroll
                for (int g = 0; g < 16; ++g) a += fb[2048 + 2048 * i + g * 128 + tid];
                o[i] = qk[i] * fb[512 * i + 256 + tid] + gamma * a; ss = o[i] * o[i]; }
            ss = wave_sum(ss);
            if (lane == 0) fb[1024 + 8 * i + wid] = ss; }
        LDS_BARRIER();
#pragma unroll
        for (int i = 0; i < NI; ++i) { const float rn = rsqrtf((fb[1024 + 8 * i] + fb[1024 + 8 * i + 1]) * (1.0f / 128.0f) + EPS);
            if (tid < 128) { const float g0 = rgv[i]; HM[i][512 + hd * 128 + tid] = (bf16_t)f2bf(o[i] * rn * ghr * g0 * sigmoidf_(g0)); } }
    }
    LDS_BARRIER();
}
DI void conv_outputs(const Params& p, int idx0, int stride) {
    const bf16_t* U = (const bf16_t*)(p.ws + WS_U); float* out = p.out;
    for (int i = idx0; i < 8 * 3 * 1024; i += stride) { const int b = i / 3072, j = (i / 1024) % 3, c = i & 1023; out[O_CONVP + i] = bf2f(U[((size_t)b * 2048 + 2045 + j) * UC + c]); }
    for (int i = idx0; i < 128 * 3 * 1024; i += stride) { const int b = i / 3072, j = (i / 1024) % 3, c = i & 1023;
        out[O_CONVS + i] = (j < 2) ? p.in[4][(size_t)b * 3072 + (j + 1) * 1024 + c] : bf2f(U[((size_t)NPROMPT + b) * UC + c]); }
}

DI void attn_prompt_unit(const Params& p, LAS unsigned char* lds, int u) {
    const int tid = threadIdx.x, wid = __builtin_amdgcn_readfirstlane(tid >> 6);
    int lane = tid & 63, hh = lane >> 5, l31 = lane & 31;
    const int b = u >> 5, h = (u >> 3) & 3, qt = u & 7;
    unsigned char* ws = p.ws;
    const bf16_t* Q = (const bf16_t*)(ws + WS_BFA); bf16_t* O = (bf16_t*)(ws + WS_BFB);
    const bf16_t* KP = (const bf16_t*)(ws + WS_KP) + (size_t)(b * 4 + h) * 65536; const bf16_t* VP = (const bf16_t*)(ws + WS_VP) + (size_t)(b * 4 + h) * 65536;
    const size_t mrow = (size_t)b * 2048 + qt * 256 + 32 * wid;
    const unsigned la = (unsigned)(uintptr_t)lds;
    int blk = (lane >> 4) & 1, q4 = (lane & 15) >> 2, pp = lane & 3;
#pragma unroll
    for (int i = 0; i < 16; ++i) { const int idx = tid + 512 * i, row = idx >> 5, c8 = idx & 31; *(LAS u32x4*)(lds + (c8 >> 4) * 65536 + off_b(row, c8 & 15)) = *(const u32x4*)(KP + row * 256 + 8 * c8); }
    __syncthreads();
    f32x16 acc[8];
#pragma unroll
    for (int c = 0; c < 8; ++c)
#pragma unroll
        for (int i = 0; i < 16; ++i) acc[c][i] = 0.f;
#pragma unroll 1
    for (int sh = 0; sh < 4; ++sh) {
        lane = tid & 63; asm volatile("" : "+v"(lane)); hh = lane >> 5; l31 = lane & 31;
        bf16x8 bq[4];
#pragma unroll
        for (int s = 0; s < 4; ++s) bq[s] = *(const bf16x8*)(Q + (mrow + l31) * DM + h * 256 + 16 * (4 * sh + s) + 8 * hh);
#pragma unroll
        for (int s = 0; s < 4; ++s) { const int c16 = 2 * (4 * sh + s) + hh;
#pragma unroll
            for (int c = 0; c < 8; ++c) { const bf16x8 A = *(const LAS bf16x8*)(lds + (c16 >> 4) * 65536 + off_b(32 * c + l31, c16 & 15)); acc[c] = MFMA32(A, bq[s], acc[c]); } }
    }
    float mx = -INFINITY;
#pragma unroll
    for (int c = 0; c < 8; ++c)
#pragma unroll
        for (int i = 0; i < 16; ++i) mx = fmaxf(mx, acc[c][i]);
    mx = fmaxf(mx, __shfl_xor(mx, 32));
    float sum = 0.f;
    bf16x8 pf[8][2];
#pragma unroll
    for (int c = 0; c < 8; ++c) {
        float e[16];
#pragma unroll
        for (int i = 0; i < 16; ++i) { e[i] = __expf(acc[c][i] - mx); sum += e[i]; }
#pragma unroll
        for (int s2 = 0; s2 < 2; ++s2) { u32x4 w; w.x = pk2(e[8 * s2], e[8 * s2 + 1]); w.y = pk2(e[8 * s2 + 2], e[8 * s2 + 3]); w.z = pk2(e[8 * s2 + 4], e[8 * s2 + 5]); w.w = pk2(e[8 * s2 + 6], e[8 * s2 + 7]);
            pf[c][s2] = __builtin_bit_cast(bf16x8, w); }
    }
    sum += __shfl_xor(sum, 32);
    float rinv[16];
#pragma unroll
    for (int i = 0; i < 16; ++i) rinv[i] = 1.0f / __shfl(sum, crow(i, hh));
    __syncthreads();
#pragma unroll
    for (int i = 0; i < 16; ++i) { const int idx = tid + 512 * i, row = idx >> 5, c8 = idx & 31; *(LAS u32x4*)(lds + (c8 >> 4) * 65536 + off_b(row, c8 & 15)) = *(const u32x4*)(VP + row * 256 + 8 * c8); }
    __syncthreads();
#pragma unroll 1
    for (int dt = 0; dt < 8; ++dt) {
        lane = tid & 63; asm volatile("" : "+v"(lane)); hh = lane >> 5; l31 = lane & 31; blk = (lane >> 4) & 1; q4 = (lane & 15) >> 2; pp = lane & 3;
        f32x16 o;
#pragma unroll
        for (int i = 0; i < 16; ++i) o[i] = 0.f;
        const unsigned base = la + (dt >> 2) * 65536; const int chk = 4 * (dt & 3) + 2 * blk + (pp >> 1); const unsigned sub8 = 8 * (pp & 1);
#pragma unroll
        for (int c = 0; c < 8; ++c) {
            const int r0 = 32 * c + 4 * hh + q4; s16x4 x0, x1, x2, x3;
            tr_read4(base + off_b(r0, chk) + sub8, base + off_b(r0 + 8, chk) + sub8, base + off_b(r0 + 16, chk) + sub8, base + off_b(r0 + 24, chk) + sub8, x0, x1, x2, x3);
            o = MFMA32(pf[c][0], cat4(x0, x1), o); o = MFMA32(pf[c][1], cat4(x2, x3), o); }
#pragma unroll
        for (int i = 0; i < 16; ++i) O[(mrow + crow(i, hh)) * DM + h * 256 + 32 * dt + l31] = (bf16_t)f2bf(o[i] * rinv[i]);
    }
    __syncthreads();
}
DI void attn_sample_pair(const Params& p, LAS unsigned char* lds, int it0) {
    const int tid = threadIdx.x, lane = tid & 63, wid = tid >> 6, sub = wid >> 2, w4 = wid & 3, g = lane >> 4, i16 = lane & 15;
    const int it = it0 + sub, b = it >> 2, h = it & 3;
    const bf16_t* Q = (const bf16_t*)(p.ws + WS_BFA) + ((size_t)NPROMPT + b) * DM + h * 256;
    LAS float* xm = (LAS float*)(lds + 131072); LAS float* xs = xm + 8; LAS float* part = xm + 16;
    f32x4 q[4];
#pragma unroll
    for (int j = 0; j < 4; ++j) { const u32x2 qw = *(const u32x2*)(Q + 4 * (i16 + 16 * j)); q[j].x = bflo(qw.x); q[j].y = bfhi(qw.x); q[j].z = bflo(qw.y); q[j].w = bfhi(qw.y); }
    const float* ck = p.in[2] + (((size_t)b * 256 + 64 * w4 + g) * 4 + h) * 256 + 4 * i16; const float* cv = p.in[3] + (((size_t)b * 256 + 64 * w4 + g) * 4 + h) * 256 + 4 * i16;
    float sc[16];
#pragma unroll
    for (int s = 0; s < 16; ++s) { float d = 0.f;
#pragma unroll
        for (int j = 0; j < 4; ++j) { const f32x4 kr = __builtin_nontemporal_load((const f32x4*)(ck + (size_t)s * 4096 + 64 * j)); d += (kr.x * q[j].x + kr.y * q[j].y) + (kr.z * q[j].z + kr.w * q[j].w); }
        d += __shfl_xor(d, 1); d += __shfl_xor(d, 2); d += __shfl_xor(d, 4); d += __shfl_xor(d, 8); sc[s] = d; }
    float lm = sc[0];
#pragma unroll
    for (int s = 1; s < 16; ++s) lm = fmaxf(lm, sc[s]);
    lm = fmaxf(lm, __shfl_xor(lm, 16)); lm = fmaxf(lm, __shfl_xor(lm, 32));
    if (lane == 0) xm[sub * 4 + w4] = lm;
    __syncthreads();
    const float gm = fmaxf(fmaxf(xm[sub * 4], xm[sub * 4 + 1]), fmaxf(xm[sub * 4 + 2], xm[sub * 4 + 3]));
    float ls = 0.f;
#pragma unroll
    for (int s = 0; s < 16; ++s) { sc[s] = __expf(sc[s] - gm); ls += sc[s]; }
    ls += __shfl_xor(ls, 16); ls += __shfl_xor(ls, 32);
    if (lane == 0) xs[sub * 4 + w4] = ls;
    f32x4 o[4];
#pragma unroll
    for (int j = 0; j < 4; ++j) o[j] = (f32x4){0.f, 0.f, 0.f, 0.f};
#pragma unroll
    for (int s = 0; s < 16; ++s)
#pragma unroll
        for (int j = 0; j < 4; ++j) { const f32x4 vr = __builtin_nontemporal_load((const f32x4*)(cv + (size_t)s * 4096 + 64 * j)); o[j] += vr * sc[s]; }
#pragma unroll
    for (int j = 0; j < 4; ++j)
#pragma unroll
        for (int e = 0; e < 4; ++e) { float t = o[j][e]; t += __shfl_xor(t, 16); t += __shfl_xor(t, 32); o[j][e] = t; }
    if (g == 0) {
#pragma unroll
        for (int j = 0; j < 4; ++j) *(LAS f32x4*)(part + (sub * 4 + w4) * 256 + 4 * (i16 + 16 * j)) = o[j]; }
    __syncthreads();
    { const int d = tid & 255, s2 = tid >> 8; const float gs = (xs[s2 * 4] + xs[s2 * 4 + 1]) + (xs[s2 * 4 + 2] + xs[s2 * 4 + 3]);
      const float v = (part[(s2 * 4) * 256 + d] + part[(s2 * 4 + 1) * 256 + d]) + (part[(s2 * 4 + 2) * 256 + d] + part[(s2 * 4 + 3) * 256 + d]);
      const int it2 = it0 + s2; bf16_t* O2 = (bf16_t*)(p.ws + WS_BFB) + ((size_t)NPROMPT + (it2 >> 2)) * DM + (it2 & 3) * 256; O2[d] = (bf16_t)f2bf(v / gs); }
    __syncthreads();
}
DI void final_norm(const Params& p) {
    const int lane = threadIdx.x & 63, gw = blockIdx.x * 8 + (threadIdx.x >> 6), NGW = gridDim.x * 8;
    const bf16_t* X3 = (const bf16_t*)(p.ws + WS_BFA); const float* rs3 = (const float*)(p.ws + WS_SMALL) + SM_RS3; const float* gf = p.in[28];
    f32x4 g[4];
#pragma unroll
    for (int j = 0; j < 4; ++j) g[j] = ((const f32x4*)gf)[4 * lane + j];
    constexpr int RB = 9, NGRP = (NVALID + RB - 1) / RB;
#pragma unroll 1
    for (int gi = gw; gi < NGRP; gi += NGW) {
        u32x4 w0[RB], w1[RB]; float rr[RB];
#pragma unroll
        for (int r = 0; r < RB; ++r) { int m = gi * RB + r; if (m >= NVALID) m = NVALID - 1; const u32x4* xr = (const u32x4*)(X3 + (size_t)m * DM) + 2 * lane; w0[r] = xr[0]; w1[r] = xr[1]; rr[r] = rs3[m]; }
#pragma unroll
        for (int r = 0; r < RB; ++r) { const int m = gi * RB + r; if (m >= NVALID) continue;
            const float sc = rsqrtf(rr[r] * (1.0f / 1024.0f) + EPS);
            f32x4* orow = (f32x4*)(p.out + (m < NPROMPT ? O_YP + (size_t)m * DM : O_YS + (size_t)(m - NPROMPT) * DM)) + 4 * lane;
            float x[16]; { float t[8]; unpack8(w0[r], t);
#pragma unroll
                for (int e = 0; e < 8; ++e) x[e] = t[e]; unpack8(w1[r], t);
#pragma unroll
                for (int e = 0; e < 8; ++e) x[8 + e] = t[e]; }
#pragma unroll
            for (int j = 0; j < 4; ++j) { f32x4 o; o.x = x[4 * j] * sc * g[j].x; o.y = x[4 * j + 1] * sc * g[j].y; o.z = x[4 * j + 2] * sc * g[j].z; o.w = x[4 * j + 3] * sc * g[j].w; orow[j] = o; } }
    }
}
struct SkScale { bf16_t* O; int ldc; const float* ss; float post;
    DI void operator()(float v0, float v1, int r, int c, int lane) const { const float sc = rsqrtf(ss[r] * (1.0f / 1024.0f) + EPS) * post; *(unsigned*)(O + (size_t)r * ldc + c) = pk2(v0 * sc, v1 * sc); } };
struct SkRes { const float* resf; const bf16_t* resb; bf16_t* outb; float* rs;
    DI void operator()(float v0, float v1, int r, int c, int lane) const { const size_t o = (size_t)r * 1024 + c;
        if (resf) { v0 += resf[o]; v1 += resf[o + 1]; } else { const unsigned w = *(const unsigned*)(resb + o); v0 += bflo(w); v1 += bfhi(w); }
        *(unsigned*)(outb + o) = pk2(v0, v1);
        float q = v0 * v0 + v1 * v1; q += __shfl_xor(q, 1); q += __shfl_xor(q, 2); q += __shfl_xor(q, 4); q += __shfl_xor(q, 8);
        if ((lane & 15) == 0) atomicAdd(rs + r, q); } };
template <class Epi> DI void skinny_gemm(LAS unsigned char* lds, const bf16_t* A, int lda, const bf16_t* Bt, int K, int N, const Epi& E) {
    const int tid = threadIdx.x, lane = tid & 63, wid = tid >> 6, l31 = lane & 31, hh = lane >> 5, G = gridDim.x;
    const int njobs = 4 * (N / 32), kw = K / 8;
    LAS float* part = (LAS float*)lds;
    for (int j = blockIdx.x; j < njobs; j += G) {
        const int rt = j & 3, ct = j >> 2;
        const bf16_t* ap = A + (size_t)(32 * rt + l31) * lda + wid * kw + 8 * hh; const bf16_t* bp = Bt + (size_t)(32 * ct + l31) * K + wid * kw + 8 * hh;
        f32x16 acc;
#pragma unroll
        for (int i = 0; i < 16; ++i) acc[i] = 0.f;
        int k = 0;
#pragma unroll 1
        for (; k + 128 <= kw; k += 128) { bf16x8 a[8], bb[8];
#pragma unroll
            for (int u = 0; u < 8; ++u) { a[u] = *(const bf16x8*)(ap + k + 16 * u); bb[u] = *(const bf16x8*)(bp + k + 16 * u); }
#pragma unroll
            for (int u = 0; u < 8; ++u) acc = MFMA32(a[u], bb[u], acc); }
#pragma unroll 1
        for (; k < kw; k += 16) { const bf16x8 a = *(const bf16x8*)(ap + k), bb = *(const bf16x8*)(bp + k); acc = MFMA32(a, bb, acc); }
#pragma unroll
        for (int i = 0; i < 16; ++i) part[wid * 1024 + crow(i, hh) * 32 + l31] = acc[i];
        __syncthreads();
        { const int e0 = 2 * tid, r = e0 >> 5, c = e0 & 31; float v0 = 0.f, v1 = 0.f;
#pragma unroll
            for (int w = 0; w < 8; ++w) { const f32x2 t = *(const LAS f32x2*)(part + w * 1024 + e0); v0 += t.x; v1 += t.y; }
            E(v0, v1, 32 * rt + r, 32 * ct + c, lane); }
        __syncthreads();
    }
}
#define XB_TMO      128
#define XB_XCNT(j)  (256  + 64 * (j))
#define XB_XSUB(j)  (1280 + 64 * (j))
#define XB_XGEN(j)  (2304 + 64 * (j))
#define XB_TOP      3328
#define XB_TOPGEN   3392
#define XCD_BAR_WORDS 3456
#define XB_SPIN_CAP (1u << 18)

__device__ __forceinline__ unsigned xb_ld(unsigned* p)              { return __hip_atomic_load(p, __ATOMIC_RELAXED, __HIP_MEMORY_SCOPE_AGENT); }
__device__ __forceinline__ unsigned xb_add(unsigned* p, unsigned v) { return __hip_atomic_fetch_add(p, v, __ATOMIC_RELAXED, __HIP_MEMORY_SCOPE_AGENT); }
__device__ __forceinline__ unsigned xb_xcc_id() { return (unsigned)__builtin_amdgcn_s_getreg((3 << 11) | 20) & 0xFu; }
#define XB_SPIN(cond, bar) do { unsigned _sp = 0; while (cond) { __builtin_amdgcn_s_sleep(1); \
    if ((++_sp & 255u) == 0u) { if (xb_ld(&(bar)[XB_TMO])) break; if (_sp > XB_SPIN_CAP) { atomicAdd(&(bar)[XB_TMO], 1u); break; } } } } while (0)

struct XcdBarrier {
    unsigned* bar; unsigned x;
    volatile LAS unsigned* st;
};

__device__ __forceinline__ XcdBarrier xcd_barrier_post(unsigned* bar, volatile LAS unsigned* st) {
    XcdBarrier b; b.bar = bar; b.x = xb_xcc_id(); b.st = st;
    if (threadIdx.x == 0) (void)xb_add(&bar[XB_XCNT(b.x)], 1u);
    return b;
}
__device__ __forceinline__ void xcd_barrier_complete(unsigned* bar, unsigned x, unsigned& nloc, unsigned& nx) {
    const unsigned G = gridDim.x * gridDim.y * gridDim.z;
    unsigned sum, cnt, mine, sp = 0u;
    for (;;) {
        sum = 0u; cnt = 0u; mine = 0u;
#pragma unroll
        for (unsigned j = 0; j < 16; ++j) { const unsigned c = xb_ld(&bar[XB_XCNT(j)]); sum += c; cnt += (c > 0u) ? 1u : 0u; mine = (j == x) ? c : mine; }
        if (sum == G) break;
        __builtin_amdgcn_s_sleep(1);
        if ((++sp & 255u) == 0u) { if (xb_ld(&bar[XB_TMO])) break; if (sp > XB_SPIN_CAP) { atomicAdd(&bar[XB_TMO], 1u); break; } }
    }
    nloc = mine > 0u ? mine : 1u; nx = cnt > 0u ? cnt : 1u;
}

__device__ __forceinline__ void xcd_barrier(const XcdBarrier& b) {
    asm volatile("s_waitcnt vmcnt(0)" ::: "memory");
    __syncthreads();
    if (threadIdx.x == 0) {
        unsigned* bar = b.bar;
        __builtin_amdgcn_s_waitcnt(0);
        unsigned nloc = b.st[0], nx = b.st[1];
        if (nloc == 0u) { xcd_barrier_complete(bar, b.x, nloc, nx); b.st[0] = nloc; b.st[1] = nx; }
        const unsigned old = xb_add(&bar[XB_XSUB(b.x)], 1u);
        const unsigned gen = old / nloc;
        if (old + 1u == (gen + 1u) * nloc) {
            __builtin_amdgcn_fence(__ATOMIC_RELEASE, "agent");
            asm volatile("s_waitcnt vmcnt(0)" ::: "memory");
            const unsigned og = xb_add(&bar[XB_TOP], 1u);
            const unsigned tg = og / nx;
            if (og + 1u == (tg + 1u) * nx) xb_add(&bar[XB_TOPGEN], 1u);
            else XB_SPIN(xb_ld(&bar[XB_TOPGEN]) == tg, bar);
            __builtin_amdgcn_fence(__ATOMIC_ACQUIRE, "agent");
            xb_add(&bar[XB_XGEN(b.x)], 1u);
            asm volatile("s_waitcnt vmcnt(0)" ::: "memory");
        } else {
            XB_SPIN(xb_ld(&bar[XB_XGEN(b.x)]) == gen, bar);
            __builtin_amdgcn_fence(__ATOMIC_ACQUIRE, "agent");
            asm volatile("s_waitcnt vmcnt(0)" ::: "memory");
        }
    }
    __syncthreads();
}

__global__ void __launch_bounds__(512, 2) fwd_megakernel(Params p) {
    extern __shared__ __attribute__((aligned(16))) unsigned char lds_raw[];
    LAS unsigned char* lds = (LAS unsigned char*)lds_raw;
    cg::grid_group grid = cg::this_grid();
    unsigned char* ws = p.ws;
    float* sm = (float*)(ws + WS_SMALL);
    const int lo = p.ph_lo, hi = p.ph_hi;
    volatile LAS unsigned* bst = (volatile LAS unsigned*)(lds + LDS_BYTES - 64);
    if (threadIdx.x < 2) bst[threadIdx.x] = 0u;
    __syncthreads();
    const XcdBarrier bar = xcd_barrier_post((unsigned*)(ws + WS_BAR), bst);
    if (lo < 0) grid.sync();
#ifndef PHMASK
#define PHMASK 0x7ff
#endif
#define IN(k) (((PHMASK >> (k)) & 1) && lo <= (k) && (k) < hi)
#define SEAM(k) do { if (IN(k) && IN((k) + 1)) xcd_barrier(bar); } while (0)
#ifndef RPT
#define RPT 0
#endif
#define NREP(k) (((RPT >> (k)) & 1) ? 2 : 1)
    const int G = gridDim.x, bx = blockIdx.x;
    if (IN(0)) for (int rep = 0; rep < NREP(0); ++rep) { p0_prologue(p, lds); __syncthreads(); } SEAM(0);
    if (IN(1)) for (int rep = 0; rep < NREP(1); ++rep) {
        pg8::Gemm g{(const bf16_t*)(ws + WS_BFA), (const bf16_t*)(ws + WS_WIN), NPROMPT, UC, DM}; pg8::StaticOrder S; S.init(NPROMPT, UC, G, bx);
        pg8::EpiScaleBf16 E{(bf16_t*)(ws + WS_U), UC, sm + SM_SS0, 1.0f};
        pg8::gemm_phase<pg8::EpiScaleBf16, pg8::StaticOrder, true, true>(lds, g, S, E);
        skinny_gemm(lds, (const bf16_t*)(ws + WS_BFA) + (size_t)NPROMPT * DM, DM, (const bf16_t*)(ws + WS_WIN), DM, UC, SkScale{(bf16_t*)(ws + WS_U) + (size_t)NPROMPT * UC, UC, sm + SM_SS0 + NPROMPT, 1.0f});
    } SEAM(1);
    if (IN(2)) {
        const bool items_first = (G == 256) && (bx < 192) && (((bx >> 3) & 1) != 0);
        if (items_first) { scan_sample_two(p, lds, bx); scan_sample_two(p, lds, bx + 512); }
        if (bx < 192) { scan_prompt<1>(p, lds, bx & 63, bx >> 6); if (RPT & 0x2000) scan_prompt<1>(p, lds, bx & 63, bx >> 6); }
        else {
            pg8::Gemm g{(const bf16_t*)(ws + WS_MEMB), (const bf16_t*)(ws + WS_WCKV), 2048, 2048, DM}; pg8::SubOrder S{bx - 192, 64, 8};
            pg8::EpiKV E{sm + SM_SSM, p.out + O_MK, p.out + O_MV, (bf16_t*)(ws + WS_KP), (bf16_t*)(ws + WS_VP)};
            pg8::gemm_phase<pg8::EpiKV, pg8::SubOrder, false, true>(lds, g, S, E);
        }
        if (items_first) { }
        else if (G == 256) { scan_sample_two(p, lds, bx); scan_sample_two(p, lds, bx + 512); }
        else for (int item = bx; item < 1024; item += G) scan_sample_block(p, lds, item);
        conv_outputs(p, bx * 512 + threadIdx.x, G * 512);
    } SEAM(2);
    if (IN(3)) { scan_prompt<2>(p, lds, bx & 63, bx >> 6); if (RPT & 0x1000) scan_prompt<2>(p, lds, bx & 63, bx >> 6); } SEAM(3);
    if (IN(4)) for (int rep = 0; rep < NREP(4); ++rep) {
        pg8::Gemm g{(const bf16_t*)(ws + WS_BFB), (const bf16_t*)(ws + WS_WOUT), NPROMPT, DM, DM}; pg8::StaticOrder S; S.init(NPROMPT, DM, G, bx);
        pg8::EpiResB<true> E{p.in[0], nullptr, (bf16_t*)(ws + WS_BFC), rep ? nullptr : sm + SM_RS1};
        pg8::gemm_phase<pg8::EpiResB<true>, pg8::StaticOrder, true, true>(lds, g, S, E);
        if (rep == 0) skinny_gemm(lds, (const bf16_t*)(ws + WS_BFB) + (size_t)NPROMPT * DM, DM, (const bf16_t*)(ws + WS_WOUT), DM, DM, SkRes{p.in[1], nullptr, (bf16_t*)(ws + WS_BFC) + (size_t)NPROMPT * DM, sm + SM_RS1 + NPROMPT});
    } SEAM(4);
    if (IN(5)) for (int rep = 0; rep < NREP(5); ++rep) {
        pg8::Gemm g{(const bf16_t*)(ws + WS_BFC), (const bf16_t*)(ws + WS_WCQ), NPROMPT, DM, DM}; pg8::StaticOrder S; S.init(NPROMPT, DM, G, bx);
        pg8::EpiScaleBf16 E{(bf16_t*)(ws + WS_BFA), DM, sm + SM_RS1, 0.0625f};
        pg8::gemm_phase<pg8::EpiScaleBf16, pg8::StaticOrder, true, true>(lds, g, S, E);
        skinny_gemm(lds, (const bf16_t*)(ws + WS_BFC) + (size_t)NPROMPT * DM, DM, (const bf16_t*)(ws + WS_WCQ), DM, DM, SkScale{(bf16_t*)(ws + WS_BFA) + (size_t)NPROMPT * DM, DM, sm + SM_RS1 + NPROMPT, 0.0625f});
    } SEAM(5);
    if (IN(6)) for (int rep = 0; rep < NREP(6); ++rep) {
        const bool early = ((bx >> 3) & 1) != 0;
        if (early) { for (int it0 = bx * 2; it0 < 512; it0 += G * 2) attn_sample_pair(p, lds, it0); }
        for (int u = bx; u < 256; u += G) attn_prompt_unit(p, lds, (((u & 7) * 4 + (u >> 6)) << 3) | ((u >> 3) & 7));
        if (!early) { for (int it0 = bx * 2; it0 < 512; it0 += G * 2) attn_sample_pair(p, lds, it0); }
    } SEAM(6);
    if (IN(7)) for (int rep = 0; rep < NREP(7); ++rep) {
        pg8::Gemm g{(const bf16_t*)(ws + WS_BFB), (const bf16_t*)(ws + WS_WCO), NPROMPT, DM, DM}; pg8::StaticOrder S; S.init(NPROMPT, DM, G, bx);
        pg8::EpiResB<false> E{nullptr, (const bf16_t*)(ws + WS_BFC), (bf16_t*)(ws + WS_BFC), sm + SM_RS2};
        pg8::gemm_phase<pg8::EpiResB<false>, pg8::StaticOrder, true, true>(lds, g, S, E);
        if (rep == 0) skinny_gemm(lds, (const bf16_t*)(ws + WS_BFB) + (size_t)NPROMPT * DM, DM, (const bf16_t*)(ws + WS_WCO), DM, DM, SkRes{nullptr, (const bf16_t*)(ws + WS_BFC) + (size_t)NPROMPT * DM, (bf16_t*)(ws + WS_BFC) + (size_t)NPROMPT * DM, sm + SM_RS2 + NPROMPT});
    } SEAM(7);
    if (IN(8)) for (int rep = 0; rep < NREP(8); ++rep) {
        pg8::Gemm g{(const bf16_t*)(ws + WS_BFC), (const bf16_t*)(ws + WS_WGU), MP, 2 * DFF, DM}; pg8::StaticOrder S; S.init(MP, 2 * DFF, G, bx);
        pg8::EpiGU E{(bf16_t*)(ws + WS_U), sm + SM_RS2};
        pg8::gemm_phase<pg8::EpiGU, pg8::StaticOrder, true, true>(lds, g, S, E);
    } SEAM(8);
    if (IN(9)) for (int rep = 0; rep < NREP(9); ++rep) {
        pg8::Gemm g{(const bf16_t*)(ws + WS_U), (const bf16_t*)(ws + WS_WDN), NPROMPT, DM, DFF}; pg8::StaticOrder S; S.init(NPROMPT, DM, G, bx);
        pg8::EpiResB<false> E{nullptr, (const bf16_t*)(ws + WS_BFC), (bf16_t*)(ws + WS_BFA), rep ? nullptr : sm + SM_RS3};
        pg8::gemm_phase<pg8::EpiResB<false>, pg8::StaticOrder, true, true>(lds, g, S, E);
        if (rep == 0) skinny_gemm(lds, (const bf16_t*)(ws + WS_U) + (size_t)NPROMPT * DFF, DFF, (const bf16_t*)(ws + WS_WDN), DFF, DM, SkRes{nullptr, (const bf16_t*)(ws + WS_BFC) + (size_t)NPROMPT * DM, (bf16_t*)(ws + WS_BFA) + (size_t)NPROMPT * DM, sm + SM_RS3 + NPROMPT});
    } SEAM(9);
    if (IN(10)) for (int rep = 0; rep < NREP(10); ++rep) final_norm(p);
#ifdef XSYNC
    for (int i = 0; i < XSYNC; ++i) xcd_barrier(bar);
#endif
#undef IN
#undef SEAM
}

#ifndef N_LAUNCHES
#define N_LAUNCHES 1
#endif
extern "C" void kernel_launch(void* const* d_in, const int* in_sizes, int n_in, void* d_out, int out_size, void* d_ws, size_t ws_size, hipStream_t stream) {
    static int grid = 0;
    if (grid == 0) {
        if (n_in != 29 || out_size != (int)O_END || ws_size < WS_END) { fprintf(stderr, "kernel_launch: unexpected shapes (n_in %d, out %d, ws %zu)\n", n_in, out_size, ws_size); grid = -1; return; }
        int dev = 0, cus = 0, per_cu = 0;
        hipGetDevice(&dev); hipDeviceGetAttribute(&cus, hipDeviceAttributeMultiprocessorCount, dev);
        if (hipFuncSetAttribute((const void*)fwd_megakernel, hipFuncAttributeMaxDynamicSharedMemorySize, LDS_BYTES) != hipSuccess) { fprintf(stderr, "kernel_launch: hipFuncSetAttribute failed\n"); }
        if (hipOccupancyMaxActiveBlocksPerMultiprocessor(&per_cu, (const void*)fwd_megakernel, 512, LDS_BYTES) != hipSuccess) per_cu = 0;
        (void)hipGetLastError();
        fprintf(stderr, "kernel_launch: %d CUs, %d blocks/CU\n", cus, per_cu);
        if (cus * per_cu < 256) { fprintf(stderr, "kernel_launch: resident capacity %d < 256 blocks\n", cus * per_cu); grid = -1; return; }
        grid = 256;
    }
    if (grid < 0) return;
    if (hipMemsetAsync((char*)d_ws + WS_BAR, 0, XCD_BAR_WORDS * 4, stream) != hipSuccess) { fprintf(stderr, "kernel_launch: memset failed\n"); return; }
    Params p{};
    for (int i = 0; i < 29; ++i) p.in[i] = (const float*)d_in[i];
    p.out = (float*)d_out; p.ws = (unsigned char*)d_ws;
#if N_LAUNCHES == 1
    p.ph_lo = 0; p.ph_hi = 11;
    { void* args[] = {&p}; hipError_t e = hipLaunchCooperativeKernel((const void*)fwd_megakernel, dim3(grid), dim3(512), args, LDS_BYTES, stream);
      if (e != hipSuccess) fprintf(stderr, "cooperative launch failed: %s\n", hipGetErrorString(e)); }
#else
    for (int ph = 0; ph < 11; ++ph) { p.ph_lo = ph; p.ph_hi = ph + 1; void* args[] = {&p};
        hipError_t e = hipLaunchCooperativeKernel((const void*)fwd_megakernel, dim3(grid), dim3(512), args, LDS_BYTES, stream);
        if (e != hipSuccess) fprintf(stderr, "cooperative launch %d failed: %s\n", ph, hipGetErrorString(e)); }
#endif
}
```
